# Optimizing an MI355X kernel written in HIP

```python
import math
import jax
import jax.numpy as jnp
from jax import lax
import numpy as np

D_MODEL = 1024
BATCH = 4
SEQ = 4096
DEPTH = 1

DN_HEADS = 4
DN_HEAD_DIM = 128
DN_WIDTH = DN_HEADS * DN_HEAD_DIM
CONV_WIDTH = 4
CHUNK = 64
SWA_HEADS = 8
SWA_KV_HEADS = 2
SWA_GROUP = SWA_HEADS // SWA_KV_HEADS
SWA_HEAD_DIM = 64
SWA_WIDTH = SWA_HEADS * SWA_HEAD_DIM
SWA_KV_WIDTH = SWA_KV_HEADS * SWA_HEAD_DIM
WINDOW = 128
MIX_WIDTH = DN_WIDTH + SWA_WIDTH
IN_SIZES = (3 * DN_WIDTH, DN_WIDTH, DN_HEADS, DN_HEADS, SWA_WIDTH, SWA_KV_WIDTH, SWA_KV_WIDTH)
IN_COLS = sum(IN_SIZES)
N_EXPERTS = 32
TOP_K = 4
D_FF = D_MODEL
SWIGLU_ALPHA = 1.702
SWIGLU_LIMIT = 7.0
MOE_BLOCK = 128
EPS = 1e-6
NEG = -1e30

kernel_name = 'hybrid_deltanet_swa_moe_adaln'


def _rmsnorm(x, w):
    xf = x.astype(jnp.float32)
    y = xf * lax.rsqrt(jnp.mean(xf * xf, axis=-1, keepdims=True) + EPS)
    return (y * w.astype(jnp.float32)).astype(x.dtype)


def _l2norm(x):
    xf = x.astype(jnp.float32)
    return xf * lax.rsqrt(jnp.sum(xf * xf, axis=-1, keepdims=True) + EPS)


def _causal_conv_silu(u, w):
    n_ch = u.shape[-1]
    y = lax.conv_general_dilated(u, w[:, None, :].astype(u.dtype), window_strides=(1,),
                                 padding=[(CONV_WIDTH - 1, 0)],
                                 dimension_numbers=('NWC', 'WIO', 'NWC'),
                                 feature_group_count=n_ch)
    return jax.nn.silu(y)


def _chunk_gated_delta_rule(q, k, v, g, beta):
    Bn, Sn, H, Dk = q.shape
    Dv = v.shape[-1]
    N = Sn // CHUNK

    def to_chunks(t):
        t = t.astype(jnp.float32).reshape(Bn, N, CHUNK, *t.shape[2:])
        return jnp.moveaxis(t, 3, 2)

    qc = to_chunks(q) * (Dk ** -0.5)
    kc, vc, gc, bc = to_chunks(k), to_chunks(v), to_chunks(g), to_chunks(beta)
    gcum = jnp.cumsum(gc, axis=-1)
    incl = jnp.tril(jnp.ones((CHUNK, CHUNK), bool))
    strict = jnp.tril(jnp.ones((CHUNK, CHUNK), bool), -1)
    diff = gcum[..., :, None] - gcum[..., None, :]
    decay = jnp.where(incl, jnp.exp(jnp.where(incl, diff, 0.0)), 0.0)
    k_beta = kc * bc[..., None]
    a_kk = jnp.where(strict, jnp.einsum('bnhcd,bnhsd->bnhcs', k_beta, kc) * decay, 0.0)
    t_mat = a_kk + jnp.eye(CHUNK, dtype=jnp.float32)
    rhs = jnp.concatenate([vc * bc[..., None], k_beta * jnp.exp(gcum)[..., None]], axis=-1)
    sol = jax.lax.linalg.triangular_solve(t_mat, rhs, left_side=True, lower=True,
                                          unit_diagonal=True)
    u, w = sol[..., :Dv], sol[..., Dv:]
    a_qk = jnp.where(incl, jnp.einsum('bnhcd,bnhsd->bnhcs', qc, kc) * decay, 0.0)
    q_dec = qc * jnp.exp(gcum)[..., None]
    g_last = gcum[..., -1]
    k_dec = kc * jnp.exp(g_last[..., None] - gcum)[..., None]
    chunk_decay = jnp.exp(g_last)
    xs = tuple(jnp.moveaxis(t, 1, 0) for t in (q_dec, k_dec, u, w, a_qk, chunk_decay))

    def step(state, inp):
        q_i, k_i, u_i, w_i, a_i, d_i = inp
        v_new = u_i - jnp.einsum('bhcd,bhde->bhce', w_i, state)
        o_i = (jnp.einsum('bhcd,bhde->bhce', q_i, state)
               + jnp.einsum('bhcs,bhse->bhce', a_i, v_new))
        state = state * d_i[..., None, None] + jnp.einsum('bhcd,bhce->bhde', k_i, v_new)
        return state, o_i

    state0 = jnp.zeros((Bn, H, Dk, Dv), jnp.float32)
    _, o = lax.scan(step, state0, xs)
    return jnp.transpose(o, (1, 0, 3, 2, 4)).reshape(Bn, Sn, H, Dv)


def _sliding_window_attention(q, k, v, q_norm_w, k_norm_w, sinks):
    Bn, Sn, _ = q.shape
    NB = Sn // WINDOW
    q = _rmsnorm(q.reshape(Bn, Sn, SWA_HEADS, SWA_HEAD_DIM), q_norm_w).astype(jnp.float32)
    k = _rmsnorm(k.reshape(Bn, Sn, SWA_KV_HEADS, SWA_HEAD_DIM), k_norm_w).astype(jnp.float32)
    v = v.reshape(Bn, Sn, SWA_KV_HEADS, SWA_HEAD_DIM).astype(jnp.float32)
    pad = jnp.zeros((Bn, WINDOW, SWA_KV_HEADS, SWA_HEAD_DIM), jnp.float32)

    def band(t):
        tp = jnp.concatenate([pad, t], axis=1).reshape(Bn, NB + 1, WINDOW, SWA_KV_HEADS, SWA_HEAD_DIM)
        return jnp.concatenate([tp[:, :-1], tp[:, 1:]], axis=2)

    kw, vw = band(k), band(v)
    qb = q.reshape(Bn, NB, WINDOW, SWA_KV_HEADS, SWA_GROUP, SWA_HEAD_DIM)
    s = jnp.einsum('bnqkgd,bnskd->bnkgqs', qb, kw) * (SWA_HEAD_DIM ** -0.5)
    qi = jnp.arange(WINDOW)[:, None]
    kj = jnp.arange(2 * WINDOW)[None, :]
    rel = (qi + WINDOW - kj).astype(jnp.float32)
    key_pos = jnp.arange(NB)[:, None, None] * WINDOW - WINDOW + kj[None]
    valid = (rel[None] >= 0) & (rel[None] < WINDOW) & (key_pos >= 0)
    slopes = (2.0 ** (-8.0 * jnp.arange(1, SWA_HEADS + 1, dtype=jnp.float32) / SWA_HEADS))
    slopes = slopes.reshape(SWA_KV_HEADS, SWA_GROUP)
    logits = s - slopes[None, None, :, :, None, None] * rel
    logits = jnp.where(valid[None, :, None, None], logits, NEG)
    sink = sinks.astype(jnp.float32).reshape(SWA_KV_HEADS, SWA_GROUP)[None, None, :, :, None]
    m = jnp.maximum(jnp.max(logits, axis=-1), sink)
    p = jnp.exp(logits - m[..., None])
    denom = jnp.sum(p, axis=-1) + jnp.exp(sink - m)
    o = jnp.einsum('bnkgqs,bnskd->bnqkgd', p / denom[..., None], vw)
    return o.reshape(Bn, Sn, SWA_WIDTH)


def _mixer(h, w_in, conv_w, a_log, dt_bias, dn_norm_w, q_norm_w, k_norm_w, sinks, w_out):
    Bn, Sn, _ = h.shape
    proj = h @ w_in
    split_idx = np.cumsum(IN_SIZES)[:-1].tolist()
    dn_qkv, dn_z, dn_a, dn_b, sw_q, sw_k, sw_v = jnp.split(proj, split_idx, axis=-1)
    qkv = _causal_conv_silu(dn_qkv, conv_w)
    q, k, v = jnp.split(qkv, 3, axis=-1)
    q = _l2norm(q.reshape(Bn, Sn, DN_HEADS, DN_HEAD_DIM))
    k = _l2norm(k.reshape(Bn, Sn, DN_HEADS, DN_HEAD_DIM))
    v = v.reshape(Bn, Sn, DN_HEADS, DN_HEAD_DIM)
    beta = jax.nn.sigmoid(dn_b.astype(jnp.float32))
    g = -jnp.exp(a_log.astype(jnp.float32)) * jax.nn.softplus(
        dn_a.astype(jnp.float32) + dt_bias.astype(jnp.float32))
    o_dn = _chunk_gated_delta_rule(q, k, v, g, beta)
    o_dn = _rmsnorm(o_dn, dn_norm_w) * jax.nn.silu(
        dn_z.reshape(Bn, Sn, DN_HEADS, DN_HEAD_DIM).astype(jnp.float32))
    o_dn = o_dn.reshape(Bn, Sn, DN_WIDTH)
    o_sw = _sliding_window_attention(sw_q, sw_k, sw_v, q_norm_w, k_norm_w, sinks)
    mixed = jnp.concatenate([o_dn.astype(h.dtype), o_sw.astype(h.dtype)], axis=-1)
    return mixed @ w_out


def _moe(h, w_router, b_router, w_up, b_up, w_down, b_down):
    Bn, Sn, D = h.shape
    T = Bn * Sn
    xf = h.reshape(T, D)
    logits = (xf @ w_router).astype(jnp.float32) + b_router.astype(jnp.float32)
    top_val, top_idx = lax.top_k(logits, TOP_K)
    gates = jax.nn.softmax(top_val, axis=-1)
    n_assign = T * TOP_K
    flat_e = top_idx.reshape(-1)
    flat_tok = jnp.arange(n_assign, dtype=jnp.int32) // TOP_K
    flat_gate = gates.reshape(-1)
    order = jnp.argsort(flat_e)
    se, stok, sgate = flat_e[order], flat_tok[order], flat_gate[order]
    counts = jnp.bincount(flat_e, length=N_EXPERTS)
    padded = (counts + MOE_BLOCK - 1) // MOE_BLOCK * MOE_BLOCK
    start = jnp.cumsum(counts) - counts
    pend = jnp.cumsum(padded)
    pstart = pend - padded
    dest = pstart[se] + (jnp.arange(n_assign) - start[se])
    n_pad = n_assign + N_EXPERTS * MOE_BLOCK
    n_blocks = n_pad // MOE_BLOCK
    row_tok = jnp.zeros((n_pad,), jnp.int32).at[dest].set(stok)
    row_gate = jnp.zeros((n_pad,), jnp.float32).at[dest].set(sgate)
    block_e = jnp.minimum(jnp.searchsorted(pend, jnp.arange(n_blocks) * MOE_BLOCK, side='right'),
                          N_EXPERTS - 1)
    xs = xf[row_tok].reshape(n_blocks, MOE_BLOCK, D)

    def expert_block(args):
        xb, e = args
        hu = xb @ w_up[e] + b_up[e]
        x_glu = jnp.minimum(hu[:, :D_FF], SWIGLU_LIMIT)
        x_lin = jnp.clip(hu[:, D_FF:], -SWIGLU_LIMIT, SWIGLU_LIMIT)
        act = x_glu * jax.nn.sigmoid(SWIGLU_ALPHA * x_glu) * (x_lin + 1.0)
        return act @ w_down[e] + b_down[e]

    ys = lax.map(expert_block, (xs, block_e)).reshape(n_pad, D)
    ys = ys.astype(jnp.float32) * row_gate[:, None]
    out = jax.ops.segment_sum(ys, row_tok, num_segments=T)
    return out.reshape(Bn, Sn, D).astype(h.dtype)


def setup_inputs(seed: int = 0) -> dict:
    key = jax.random.key(seed)
    ks = jax.random.split(key, 24)
    L = DEPTH

    def nrm(k, shape, scale):
        return jax.random.normal(k, shape, jnp.float32) * scale

    dt = jnp.exp(jax.random.uniform(ks[8], (L, DN_HEADS), jnp.float32,
                                    math.log(1e-3), math.log(1e-1)))
    return {
        'x': nrm(ks[0], (BATCH, SEQ, D_MODEL), 1.0),
        'c': nrm(ks[1], (BATCH, D_MODEL), 1.0),
        'w_ada': nrm(ks[2], (L, D_MODEL, 6 * D_MODEL), 0.5 * D_MODEL ** -0.5),
        'b_ada': nrm(ks[3], (L, 6 * D_MODEL), 0.02),
        'norm1_w': 1.0 + nrm(ks[4], (L, D_MODEL), 0.02),
        'w_in': nrm(ks[5], (L, D_MODEL, IN_COLS), D_MODEL ** -0.5),
        'conv_w': nrm(ks[6], (L, CONV_WIDTH, 3 * DN_WIDTH), CONV_WIDTH ** -0.5),
        'a_log': jnp.log(jax.random.uniform(ks[7], (L, DN_HEADS), jnp.float32, 1.0, 16.0)),
        'dt_bias': dt + jnp.log(-jnp.expm1(-dt)),
        'dn_norm_w': 1.0 + nrm(ks[9], (L, DN_HEAD_DIM), 0.02),
        'q_norm_w': 1.0 + nrm(ks[10], (L, SWA_HEAD_DIM), 0.02),
        'k_norm_w': 1.0 + nrm(ks[11], (L, SWA_HEAD_DIM), 0.02),
        'sinks': nrm(ks[12], (L, SWA_HEADS), 1.0),
        'w_out': nrm(ks[13], (L, MIX_WIDTH, D_MODEL), MIX_WIDTH ** -0.5),
        'norm2_w': 1.0 + nrm(ks[14], (L, D_MODEL), 0.02),
        'w_router': nrm(ks[15], (L, D_MODEL, N_EXPERTS), D_MODEL ** -0.5),
        'b_router': nrm(ks[16], (L, N_EXPERTS), 0.01),
        'w_up': nrm(ks[17], (L, N_EXPERTS, D_MODEL, 2 * D_FF), D_MODEL ** -0.5),
        'b_up': nrm(ks[18], (L, N_EXPERTS, 2 * D_FF), 0.01),
        'w_down': nrm(ks[19], (L, N_EXPERTS, D_FF, D_MODEL), D_FF ** -0.5),
        'b_down': nrm(ks[20], (L, N_EXPERTS, D_MODEL), 0.01),
    }


def reference(x, c, w_ada, b_ada, norm1_w, w_in, conv_w, a_log, dt_bias, dn_norm_w,
              q_norm_w, k_norm_w, sinks, w_out, norm2_w, w_router, b_router,
              w_up, b_up, w_down, b_down):
    out_dtype = x.dtype
    c_act = jax.nn.silu(c)
    for l in range(DEPTH):
        mod = (c_act @ w_ada[l] + b_ada[l])[:, None, :]
        shift1, scale1, gate1, shift2, scale2, gate2 = jnp.split(mod, 6, axis=-1)
        h = _rmsnorm(x, norm1_w[l]) * (1.0 + scale1) + shift1
        y = _mixer(h, w_in[l], conv_w[l], a_log[l], dt_bias[l], dn_norm_w[l],
                   q_norm_w[l], k_norm_w[l], sinks[l], w_out[l])
        x = x + gate1 * y
        h = _rmsnorm(x, norm2_w[l]) * (1.0 + scale2) + shift2
        x = x + gate2 * _moe(h, w_router[l], b_router[l], w_up[l], b_up[l], w_down[l], b_down[l])
    return x.astype(out_dtype)
```

```cpp
#include <hip/hip_runtime.h>
#include <cstdio>
#include <cstdint>

namespace pg8 {
#define PG8_LAS __attribute__((address_space(3)))
typedef unsigned short bf16_t;
typedef short bf16x8 __attribute__((ext_vector_type(8)));
typedef float f32x4 __attribute__((ext_vector_type(4)));
typedef unsigned u32x4 __attribute__((ext_vector_type(4)));
constexpr int BM = 256, BK = 64, HALF = 128, HTB = HALF * BK * 2  , STAGE_BYTES = 8 * HTB, NXCD = 8, WGM = 8;

__host__ __device__ __forceinline__ int lds_byte(int r, int c) { const int st = (r >> 4) * 2 + (c >> 5), rr = r & 15, cc = c & 31, ob = rr * 64 + cc * 2; return st * 1024 + (ob ^ (((ob >> 9) & 1) << 5)); }
__host__ __device__ __forceinline__ void stage_rc(int b, int& R, int& C) { const int st = b / 1024, sb = b % 1024, swz = sb ^ (((sb >> 9) & 1) << 5); R = (st >> 1) * 16 + swz / 64; C = (st & 1) * 32 + (swz % 64) / 2; }
__host__ __device__ __forceinline__ int perm32(int rho) { const int n = rho >> 4, i = rho & 15; return 8 * (i >> 2) + 4 * n + (i & 3); }

struct Unit { int pm, pn, e; };
struct Gemm { const bf16_t* A; const bf16_t* Bt; int M, N, K; };

__device__ __forceinline__ unsigned cvt_pk_bf16(float lo, float hi) { unsigned r; asm volatile("v_cvt_pk_bf16_f32 %0, %1, %2" : "=v"(r) : "v"(lo), "v"(hi)); return r; }
typedef float f32x2 __attribute__((ext_vector_type(2)));
__device__ __forceinline__ f32x2 gelu_pk(f32x2 v) {
    const f32x2 av = __builtin_elementwise_abs(v), d = av * 0.2316418882f + 1.0f;
    f32x2 t; t.x = __builtin_amdgcn_rcpf(d.x); t.y = __builtin_amdgcn_rcpf(d.y);
    f32x2 q = t * 0.5307027145f + (-0.7265760135f); q = q * t + 0.7107068705f; q = q * t + (-0.142248368f); q = q * t + 0.127414796f; q = q * t;
    const f32x2 s = (v * v) * (-0.72134752044f);
    f32x2 e; e.x = __builtin_amdgcn_exp2f(s.x); e.y = __builtin_amdgcn_exp2f(s.y);
    const f32x2 m = v * (q * e), r = v - m;
    f32x2 o; o.x = v.x < 0.f ? m.x : r.x; o.y = v.y < 0.f ? m.y : r.y; return o;
}

template <int ACT  > struct EpiBf16 {
    static constexpr bool PERM = true, AFTER_DRAIN = false; static_assert(ACT == 0 || ACT == 1, "EpiBf16: ACT is 0 (none) or 1 (gelu_pk)");
    bf16_t* O; int ldc; const float* bias; int split_cols; size_t split_stride; float scale0;
    __device__ __forceinline__ void operator()(const f32x4 (&acc)[2][2][4][2], const Unit& u, int wr, int wc, int fr, int fq) const {
        const int row0 = u.pm * BM + wr * 64 + fr; int colt = u.pn * BM; bf16_t* base = O;
        float sc = 1.f; if (split_cols) { const int t = colt / split_cols; base += (size_t)t * split_stride; colt -= t * split_cols; if (t == 0) sc = scale0; }
        const int col0 = colt + wc * 32 + 8 * fq, bcol0 = u.pn * BM + wc * 32 + 8 * fq;
        f32x4 bv[2][2];
#pragma unroll
        for (int bj = 0; bj < 2; ++bj)
#pragma unroll
            for (int n = 0; n < 2; ++n) bv[bj][n] = bias ? *(const f32x4*)(bias + bcol0 + bj * HALF + 4 * n) : (f32x4){0.f, 0.f, 0.f, 0.f};
#pragma unroll
        for (int ai = 0; ai < 2; ++ai)
#pragma unroll
            for (int m = 0; m < 4; ++m) { bf16_t* rowp = base + (size_t)(row0 + ai * HALF + m * 16) * ldc + col0;
#pragma unroll
                for (int bj = 0; bj < 2; ++bj) { f32x4 v0 = acc[ai][bj][m][0] + bv[bj][0], v1 = acc[ai][bj][m][1] + bv[bj][1];
                    if (ACT == 1) { f32x2 a = gelu_pk((f32x2){v0[0], v0[1]}), b = gelu_pk((f32x2){v0[2], v0[3]}), c = gelu_pk((f32x2){v1[0], v1[1]}), d = gelu_pk((f32x2){v1[2], v1[3]});
                        v0 = (f32x4){a.x, a.y, b.x, b.y}; v1 = (f32x4){c.x, c.y, d.x, d.y}; }
                    v0 = v0 * sc; v1 = v1 * sc; u32x4 w; w.x = cvt_pk_bf16(v0[0], v0[1]); w.y = cvt_pk_bf16(v0[2], v0[3]); w.z = cvt_pk_bf16(v1[0], v1[1]); w.w = cvt_pk_bf16(v1[2], v1[3]);
                    *(u32x4*)(rowp + bj * HALF) = w; } }
    }
};

template <class Epi, class Sched, bool ALIGN_EPI = false, bool SP2 = false>
__device__ __forceinline__ void gemm_phase(PG8_LAS unsigned char* lds, const Gemm g, const Sched& S, const Epi& E) {
    const int tid = threadIdx.x, wid = __builtin_amdgcn_readfirstlane(tid >> 6), lane = tid & 63, wr = wid >> 2, wc = wid & 3, fr = lane & 15, fq = lane >> 4;
    const int K = g.K, nt = K / BK;
    unsigned voffA[2], voffB[2];
#pragma unroll
    for (int i = 0; i < 2; ++i) { int R, C; stage_rc(tid * 16 + i * 8192, R, C); const int Rb = Epi::PERM ? ((R & ~31) + perm32(R & 31)) : R;
        voffA[i] = (unsigned)(R * K + C) * 2u; voffB[i] = (unsigned)(Rb * K + C) * 2u; }
    const size_t kstep = (size_t)(BK * 2);
    const size_t hstep = (size_t)HALF * K * 2;
    const unsigned ldsw = (unsigned)wid * 1024u;
    const int aoff = lds_byte(wr * 64 + fr, fq * 8), boff = lds_byte(wc * 32 + fr, fq * 8);
#define PG8_SA(b, h) (((b) * 2 + (h)) * HTB)
#define PG8_SB(b, h) ((4 + (b) * 2 + (h)) * HTB)
#define PG8_STAGE(bufoff, gbase, voff) do { _Pragma("unroll") for (int _i = 0; _i < 2; ++_i) \
        __builtin_amdgcn_global_load_lds((const unsigned*)((const char*)(gbase) + (voff)[_i]), (PG8_LAS unsigned*)(lds + (bufoff) + ldsw + _i * 8192), 16, 0, 0); } while (0)
#define PG8_LDA(dst, b, h) do { _Pragma("unroll") for (int m = 0; m < 4; ++m) _Pragma("unroll") for (int k = 0; k < 2; ++k) dst[m][k] = *(const PG8_LAS bf16x8*)(lds + PG8_SA(b, h) + aoff + m * 2048 + k * 1024); } while (0)
#define PG8_LDB(dst, b, h) do { _Pragma("unroll") for (int n = 0; n < 2; ++n) _Pragma("unroll") for (int k = 0; k < 2; ++k) dst[n][k] = *(const PG8_LAS bf16x8*)(lds + PG8_SB(b, h) + boff + n * 2048 + k * 1024); } while (0)
#define PG8_MMA(ai, bj, At, Bt) do { __builtin_amdgcn_s_setprio(1); _Pragma("unroll") for (int m = 0; m < 4; ++m) _Pragma("unroll") for (int n = 0; n < 2; ++n) _Pragma("unroll") for (int k = 0; k < 2; ++k) \
        acc[ai][bj][m][n] = __builtin_amdgcn_mfma_f32_16x16x32_bf16(Bt[n][k], At[m][k], acc[ai][bj][m][n], 0, 0, 0); __builtin_amdgcn_s_setprio(0); } while (0)
#define PG8_WAIT_V(n) asm volatile("s_waitcnt vmcnt(" #n ")" ::: "memory")
#define PG8_WAIT_L(n) asm volatile("s_waitcnt lgkmcnt(" #n ")" ::: "memory")
#define PG8_BAR __builtin_amdgcn_s_barrier()
#define PG8_SCHED __builtin_amdgcn_sched_barrier(0)
    Unit cur, nxt; int ui = 0;
    if (!S.next(0, cur)) return;
    f32x4 acc[2][2][4][2];
#pragma unroll
    for (int a = 0; a < 2; ++a)
#pragma unroll
        for (int b = 0; b < 2; ++b)
#pragma unroll
            for (int m = 0; m < 4; ++m)
#pragma unroll
                for (int n = 0; n < 2; ++n) acc[a][b][m][n] = (f32x4){0.f, 0.f, 0.f, 0.f};
    bf16x8 At[4][2], B0[2][2], B1[2][2];
    const char* cA = (const char*)g.A + S.aoff(cur); const char* cB = (const char*)g.Bt + S.boff(cur);
    S.a_ready(cur);
    if constexpr (SP2) {
        PG8_STAGE(PG8_SB(0, 0), cB, voffB); PG8_STAGE(PG8_SB(0, 1), cB + hstep, voffB); PG8_STAGE(PG8_SA(0, 0), cA, voffA); PG8_STAGE(PG8_SA(0, 1), cA + hstep, voffA);
        if (wr == 1) PG8_BAR;
        PG8_WAIT_V(2); PG8_BAR;
        PG8_STAGE(PG8_SB(1, 0), cB + kstep, voffB); PG8_STAGE(PG8_SA(1, 0), cA + kstep, voffA); PG8_STAGE(PG8_SB(1, 1), cB + hstep + kstep, voffB);
        PG8_WAIT_V(6); PG8_BAR;
    } else {
        PG8_STAGE(PG8_SB(0, 0), cB, voffB); PG8_STAGE(PG8_SA(0, 0), cA, voffA); PG8_STAGE(PG8_SB(0, 1), cB + hstep, voffB); PG8_STAGE(PG8_SA(0, 1), cA + hstep, voffA);
        if (wr == 1) PG8_BAR;
        PG8_WAIT_V(4); PG8_BAR;
        PG8_STAGE(PG8_SB(1, 0), cB + kstep, voffB); PG8_STAGE(PG8_SA(1, 0), cA + kstep, voffA); PG8_STAGE(PG8_SB(1, 1), cB + hstep + kstep, voffB);
        PG8_WAIT_V(6); PG8_BAR;
    }
    for (;;) {
        const bool has_next = S.next(ui + 1, nxt);
        const char* nA = has_next ? (const char*)g.A + S.aoff(nxt) : cA; const char* nB = has_next ? (const char*)g.Bt + S.boff(nxt) : cB;
        for (int t = 0; t < nt; t += 2) {
            const bool last = (t == nt - 2);
            const char* a1 = cA + (size_t)(t + 1) * kstep;
            const char* a2 = last ? nA : cA + (size_t)(t + 2) * kstep; const char* b2 = last ? nB : cB + (size_t)(t + 2) * kstep;
            const char* a3 = a2 + kstep; const char* b3 = b2 + kstep;
            if (last && has_next) S.a_ready(nxt);
            if constexpr (SP2) {
            PG8_LDB(B0, 0, 0); PG8_LDB(B1, 0, 1); PG8_SCHED; PG8_LDA(At, 0, 0); PG8_STAGE(PG8_SA(1, 1), a1 + hstep, voffA);
            PG8_WAIT_V(8); PG8_WAIT_L(0); PG8_BAR; PG8_MMA(0, 0, At, B0); PG8_MMA(0, 1, At, B1); PG8_BAR; PG8_SCHED;
            PG8_LDA(At, 0, 1); PG8_STAGE(PG8_SB(0, 0), b2, voffB); PG8_STAGE(PG8_SB(0, 1), b2 + hstep, voffB); PG8_STAGE(PG8_SA(0, 0), a2, voffA);
            PG8_WAIT_V(8); PG8_WAIT_L(0); PG8_BAR; PG8_MMA(1, 0, At, B0); PG8_MMA(1, 1, At, B1); PG8_BAR; PG8_SCHED;
            PG8_LDB(B0, 1, 0); PG8_LDB(B1, 1, 1); PG8_SCHED; PG8_LDA(At, 1, 0); PG8_STAGE(PG8_SA(0, 1), a2 + hstep, voffA);
            PG8_WAIT_V(8); PG8_WAIT_L(0); PG8_BAR; PG8_MMA(0, 0, At, B0); PG8_MMA(0, 1, At, B1); PG8_BAR; PG8_SCHED;
            PG8_LDA(At, 1, 1); PG8_STAGE(PG8_SB(1, 0), b3, voffB); PG8_STAGE(PG8_SB(1, 1), b3 + hstep, voffB); PG8_STAGE(PG8_SA(1, 0), a3, voffA);
            PG8_WAIT_V(8); PG8_WAIT_L(0); PG8_BAR; PG8_MMA(1, 0, At, B0); PG8_MMA(1, 1, At, B1); PG8_BAR; PG8_SCHED;
            } else {
            PG8_LDB(B0, 0, 0); PG8_SCHED; PG8_LDA(At, 0, 0); PG8_STAGE(PG8_SA(1, 1), a1 + hstep, voffA);
            PG8_WAIT_L(8); PG8_BAR; PG8_WAIT_L(0); PG8_MMA(0, 0, At, B0); PG8_BAR; PG8_SCHED;
            PG8_LDB(B1, 0, 1); PG8_STAGE(PG8_SB(0, 0), b2, voffB);
            PG8_BAR; PG8_WAIT_L(0); PG8_MMA(0, 1, At, B1); PG8_BAR;
            PG8_LDA(At, 0, 1); PG8_STAGE(PG8_SA(0, 0), a2, voffA);
            PG8_BAR; PG8_WAIT_L(0); PG8_MMA(1, 0, At, B0); PG8_BAR; PG8_SCHED;
            PG8_STAGE(PG8_SB(0, 1), b2 + hstep, voffB);
            PG8_WAIT_V(6); PG8_BAR; PG8_MMA(1, 1, At, B1); PG8_BAR;
            PG8_LDB(B0, 1, 0); PG8_SCHED; PG8_LDA(At, 1, 0); PG8_STAGE(PG8_SA(0, 1), a2 + hstep, voffA);
            PG8_WAIT_L(8); PG8_BAR; PG8_WAIT_L(0); PG8_MMA(0, 0, At, B0); PG8_BAR; PG8_SCHED;
            PG8_LDB(B1, 1, 1); PG8_STAGE(PG8_SB(1, 0), b3, voffB);
            PG8_BAR; PG8_WAIT_L(0); PG8_MMA(0, 1, At, B1); PG8_BAR;
            PG8_LDA(At, 1, 1); PG8_STAGE(PG8_SA(1, 0), a3, voffA);
            PG8_BAR; PG8_WAIT_L(0); PG8_MMA(1, 0, At, B0); PG8_BAR; PG8_SCHED;
            PG8_STAGE(PG8_SB(1, 1), b3 + hstep, voffB);
            PG8_WAIT_V(6); PG8_BAR; PG8_MMA(1, 1, At, B1); PG8_BAR;
            }
        }
        if constexpr (ALIGN_EPI) { if (wr == 0) PG8_BAR; }
        if constexpr (!Epi::AFTER_DRAIN) { E(acc, cur, wr, wc, fr, fq); S.done(cur); }
        if (!has_next) break;
#pragma unroll
        for (int a = 0; a < 2; ++a)
#pragma unroll
            for (int b = 0; b < 2; ++b)
#pragma unroll
                for (int m = 0; m < 4; ++m)
#pragma unroll
                    for (int n = 0; n < 2; ++n) acc[a][b][m][n] = (f32x4){0.f, 0.f, 0.f, 0.f};
        cur = nxt; cA = nA; cB = nB; ++ui;
        if constexpr (ALIGN_EPI) { if (wr == 1) PG8_BAR; }
    }
    PG8_WAIT_V(0);
    if constexpr (!ALIGN_EPI) { if (wr == 0) PG8_BAR; }
    PG8_BAR;
    if constexpr (Epi::AFTER_DRAIN) { E.fused(acc, cur, wr, wc, fr, fq, lds, wid, lane); S.done(cur); }
#undef PG8_SA
#undef PG8_SB
#undef PG8_STAGE
#undef PG8_LDA
#undef PG8_LDB
#undef PG8_MMA
#undef PG8_WAIT_V
#undef PG8_WAIT_L
#undef PG8_BAR
#undef PG8_SCHED
}
}

#define GAS __attribute__((address_space(1)))
#define LAS __attribute__((address_space(3)))
typedef unsigned short bf16;
typedef unsigned v4u __attribute__((ext_vector_type(4)));
typedef float f32x4 __attribute__((ext_vector_type(4)));
typedef short bf16x8 __attribute__((ext_vector_type(8)));
typedef GAS unsigned gu32;
typedef GAS unsigned long long gu64;
#define RLX_AGENT __ATOMIC_RELAXED, __HIP_MEMORY_SCOPE_AGENT
#define LDS_WAIT() asm volatile("s_waitcnt lgkmcnt(0)" ::: "memory")
#define VM_WAIT() asm volatile("s_waitcnt vmcnt(0)" ::: "memory")
__device__ __forceinline__ unsigned long long rt() { return __builtin_amdgcn_s_memrealtime(); }
__device__ __forceinline__ unsigned f2bf(float f) { unsigned u = __builtin_bit_cast(unsigned, f); return (u + 0x7fffu + ((u >> 16) & 1u)) >> 16; }
__device__ __forceinline__ unsigned pk2(float lo, float hi) { return f2bf(lo) | (f2bf(hi) << 16); }

#define XB_TMO      128
#define XB_XCNT(j)  (256  + 64 * (j))
#define XB_XSUB(j)  (1280 + 64 * (j))
#define XB_XGEN(j)  (2304 + 64 * (j))
#define XB_TOP      3328
#define XB_TOPGEN   3392
#define XCD_BAR_WORDS 3456
#define XB_SPIN_CAP (1u << 18)

__device__ __forceinline__ unsigned xb_ld(unsigned* p)              { return __hip_atomic_load(p, __ATOMIC_RELAXED, __HIP_MEMORY_SCOPE_AGENT); }
__device__ __forceinline__ unsigned xb_add(unsigned* p, unsigned v) { return __hip_atomic_fetch_add(p, v, __ATOMIC_RELAXED, __HIP_MEMORY_SCOPE_AGENT); }
__device__ __forceinline__ unsigned xb_xcc_id() { return (unsigned)__builtin_amdgcn_s_getreg((3 << 11) | 20) & 0xFu; }
#define XB_SPIN(cond, bar) do { unsigned _sp = 0; while (cond) { __builtin_amdgcn_s_sleep(1); \
    if ((++_sp & 255u) == 0u) { if (xb_ld(&(bar)[XB_TMO])) break; if (_sp > XB_SPIN_CAP) { atomicAdd(&(bar)[XB_TMO], 1u); break; } } } } while (0)

struct XcdBarrier {
    unsigned* bar; unsigned x;
    volatile LAS unsigned* st;
};

__device__ __forceinline__ XcdBarrier xcd_barrier_post(unsigned* bar, volatile LAS unsigned* st) {
    XcdBarrier b; b.bar = bar; b.x = xb_xcc_id(); b.st = st;
    if (threadIdx.x == 0) (void)xb_add(&bar[XB_XCNT(b.x)], 1u);
    return b;
}
__device__ __forceinline__ void xcd_barrier_complete(unsigned* bar, unsigned x, unsigned& nloc, unsigned& nx) {
    const unsigned G = gridDim.x * gridDim.y * gridDim.z;
    unsigned sum, cnt, mine, sp = 0u;
    for (;;) {
        sum = 0u; cnt = 0u; mine = 0u;
#pragma unroll
        for (unsigned j = 0; j < 16; ++j) { const unsigned c = xb_ld(&bar[XB_XCNT(j)]); sum += c; cnt += (c > 0u) ? 1u : 0u; mine = (j == x) ? c : mine; }
        if (sum == G) break;
        __builtin_amdgcn_s_sleep(1);
        if ((++sp & 255u) == 0u) { if (xb_ld(&bar[XB_TMO])) break; if (sp > XB_SPIN_CAP) { atomicAdd(&bar[XB_TMO], 1u); break; } }
    }
    nloc = mine > 0u ? mine : 1u; nx = cnt > 0u ? cnt : 1u;
}

__device__ __forceinline__ void xcd_barrier(const XcdBarrier& b) {
    asm volatile("s_waitcnt vmcnt(0)" ::: "memory");
    __syncthreads();
    if (threadIdx.x == 0) {
        unsigned* bar = b.bar;
        __builtin_amdgcn_s_waitcnt(0);
        unsigned nloc = b.st[0], nx = b.st[1];
        if (nloc == 0u) { xcd_barrier_complete(bar, b.x, nloc, nx); b.st[0] = nloc; b.st[1] = nx; }
        const unsigned old = xb_add(&bar[XB_XSUB(b.x)], 1u);
        const unsigned gen = old / nloc;
        if (old + 1u == (gen + 1u) * nloc) {
            __builtin_amdgcn_fence(__ATOMIC_RELEASE, "agent");
            asm volatile("s_waitcnt vmcnt(0)" ::: "memory");
            const unsigned og = xb_add(&bar[XB_TOP], 1u);
            const unsigned tg = og / nx;
            if (og + 1u == (tg + 1u) * nx) xb_add(&bar[XB_TOPGEN], 1u);
            else XB_SPIN(xb_ld(&bar[XB_TOPGEN]) == tg, bar);
            __builtin_amdgcn_fence(__ATOMIC_ACQUIRE, "agent");
            xb_add(&bar[XB_XGEN(b.x)], 1u);
            asm volatile("s_waitcnt vmcnt(0)" ::: "memory");
        } else {
            XB_SPIN(xb_ld(&bar[XB_XGEN(b.x)]) == gen, bar);
            __builtin_amdgcn_fence(__ATOMIC_ACQUIRE, "agent");
            asm volatile("s_waitcnt vmcnt(0)" ::: "memory");
        }
    }
    __syncthreads();
}


constexpr int NWAVES = 8;
constexpr int NPH = 12;
#ifndef MK_N_LAUNCHES
#define MK_N_LAUNCHES 12
#endif
constexpr int N_LAUNCHES = MK_N_LAUNCHES;

constexpr int BATCH = 4, SEQ = 4096, D = 1024, T = BATCH * SEQ;
constexpr int DN_H = 4, DK = 128, CH = 64, NCH = SEQ / CH;
constexpr int SW_H = 8, SW_KV = 2, HD = 64, WIN = 128, NB = SEQ / WIN;
constexpr int IN_COLS = 2824, NPROJ = 2816;
constexpr int PC_Z = 1536, PC_SQ = 2048, PC_SK = 2560, PC_SV = 2688;
constexpr int NE = 32, TOPK = 4, DFF = 1024;
constexpr int MAXTILES = 288, NPADMAX = MAXTILES * 256;
constexpr float EPS = 1e-6f;
constexpr int DNP_STRIDE = 36928;

constexpr size_t MiB = 1u << 20;
constexpr size_t WS_CTL = 0, CTL_ZERO_BYTES = 1 * MiB;
constexpr size_t WS_MODP = 1 * MiB;
constexpr size_t WS_MODF = 2 * MiB;
constexpr size_t WS_GB = 3 * MiB;
constexpr size_t WS_WIN = 4 * MiB;
constexpr size_t WS_WOUT = 10 * MiB;
constexpr size_t WS_LSLOT = 12 * MiB;
constexpr size_t WS_LGATE = 14 * MiB;
constexpr size_t WS_RSLOT = 16 * MiB;
constexpr size_t WS_RGATE = 17 * MiB;
constexpr size_t WS_H = 32 * MiB;
constexpr size_t WS_PROJ = 64 * MiB;
constexpr size_t WS_MIXED = 152 * MiB;
constexpr size_t WS_ODN = 184 * MiB;
constexpr size_t WS_DNP = 216 * MiB;
constexpr size_t WS_WUP = 384 * MiB;
constexpr size_t WS_WDN = 512 * MiB;
constexpr size_t WS_XS = 576 * MiB;
constexpr size_t WS_ACT = 720 * MiB;
constexpr size_t WS_SLOT = 864 * MiB;
constexpr size_t WS_END = 992 * MiB;
static_assert(WS_DNP + (size_t)1024 * DNP_STRIDE * 4 <= WS_WUP, "dnp");
static_assert(WS_XS + (size_t)NPADMAX * 1024 * 2 <= WS_ACT && WS_ACT + (size_t)NPADMAX * 1024 * 2 <= WS_SLOT, "xs/act");
constexpr int CW_CNT = 64;
constexpr int CW_BAR = 4096;

constexpr int LDS_BYTES = 147456;
constexpr int CTRL_OFF = LDS_BYTES - 4096;
constexpr int SCRATCH_BYTES = CTRL_OFF;

struct Frame {
    LAS unsigned char* lds;
    volatile LAS unsigned* MISC;
    gu32* ctl;
    int tid, lane, wave, vcu, G;
    const float *x, *c, *w_ada, *b_ada, *norm1_w, *w_in, *conv_w, *a_log, *dt_bias, *dn_norm_w, *q_norm_w, *k_norm_w, *sinks, *w_out, *norm2_w, *w_router, *b_router, *w_up, *b_up, *w_down, *b_down;
    float* out;
    float *modp, *modf, *gb, *odn, *dnp, *lgate, *rgate;
    int *lslot, *rslot;
    bf16 *Win_t, *Wout_t, *Wup_t, *Wdn_t, *H, *PROJ, *MIXED, *XS, *ACT, *SLOT;
};

__device__ __forceinline__ float bf2f(bf16 v) { return __uint_as_float((unsigned)v << 16); }
__device__ __forceinline__ float bflo(unsigned w) { return __uint_as_float(w << 16); }
__device__ __forceinline__ float bfhi(unsigned w) { return __uint_as_float(w & 0xffff0000u); }
__device__ __forceinline__ float wave_sum(float v) {
#pragma unroll
    for (int o = 1; o < 64; o <<= 1) v += __shfl_xor(v, o);
    return v;
}
__device__ __forceinline__ float siluf(float v) { return v / (1.f + __expf(-v)); }

struct DenseOrder {
    int nM, nN, nwg, G, c; size_t tstep;
    __device__ void init(int M, int N, int K, int G_, int c_) { nM = M / 256; nN = N / 256; nwg = nM * nN; G = G_; c = c_; tstep = (size_t)256 * K * 2; }
    __device__ bool next(int i, pg8::Unit& u) const {
        const long L = (long)i * G + c; if (L >= nwg) return false;
        int wgid = (int)L; { const int q = nwg / 8, r = nwg % 8, xcd = wgid % 8, off = wgid / 8; wgid = (xcd < r ? xcd * (q + 1) : r * (q + 1) + (xcd - r) * q) + off; }
        const int nig = 8 * nN, gid = wgid / nig, fm = gid * 8, gsz = (nM - fm) < 8 ? (nM - fm) : 8;
        u.pm = fm + ((wgid % nig) % gsz); u.pn = (wgid % nig) / gsz; u.e = 0; return true;
    }
    __device__ __forceinline__ size_t aoff(const pg8::Unit& u) const { return (size_t)u.pm * tstep; }
    __device__ __forceinline__ size_t boff(const pg8::Unit& u) const { return (size_t)u.pn * tstep; }
    __device__ __forceinline__ void a_ready(const pg8::Unit&) const {}
    __device__ __forceinline__ void done(const pg8::Unit&) const {}
};
struct MoeOrder {
    int ntiles, nN, G, c, rows_per_e; size_t tstep; const LAS int* tile_e;
    __device__ bool next(int i, pg8::Unit& u) const {
        const long L = (long)i * G + c; if (L >= (long)ntiles * nN) return false;
        u.pm = (int)(L / nN); u.pn = (int)(L % nN); u.e = __builtin_amdgcn_readfirstlane(tile_e[u.pm]); return true;
    }
    __device__ __forceinline__ size_t aoff(const pg8::Unit& u) const { return (size_t)u.pm * tstep; }
    __device__ __forceinline__ size_t boff(const pg8::Unit& u) const { return ((size_t)u.e * rows_per_e + (size_t)u.pn * 256) * 2048; }
    __device__ __forceinline__ void a_ready(const pg8::Unit&) const {}
    __device__ __forceinline__ void done(const pg8::Unit&) const {}
};

struct EpiX1 {
    static constexpr bool PERM = false, AFTER_DRAIN = false;
    const float* x; float* out; const float* modf;
    __device__ __forceinline__ void operator()(const f32x4 (&acc)[2][2][4][2], const pg8::Unit& u, int wr, int wc, int fr, int fq) const {
        const int row0 = u.pm * 256 + wr * 64 + fr, col0 = u.pn * 256 + wc * 32 + 4 * fq, b = u.pm >> 4;
        f32x4 gv[2][2];
#pragma unroll
        for (int bj = 0; bj < 2; ++bj)
#pragma unroll
            for (int n = 0; n < 2; ++n) gv[bj][n] = *(const f32x4*)(modf + b * 6144 + 2048 + col0 + bj * 128 + n * 16);
#pragma unroll
        for (int ai = 0; ai < 2; ++ai)
#pragma unroll
            for (int m = 0; m < 4; ++m) { const size_t off = (size_t)(row0 + ai * 128 + m * 16) * D + col0;
#pragma unroll
                for (int bj = 0; bj < 2; ++bj)
#pragma unroll
                    for (int n = 0; n < 2; ++n) { const f32x4 xv = *(const f32x4*)(x + off + bj * 128 + n * 16); *(f32x4*)(out + off + bj * 128 + n * 16) = xv + gv[bj][n] * acc[ai][bj][m][n]; } }
    }
};
struct EpiSwiglu {
    static constexpr bool PERM = true, AFTER_DRAIN = false;
    bf16* act; const float* b_up;
    __device__ __forceinline__ void operator()(const f32x4 (&acc)[2][2][4][2], const pg8::Unit& u, int wr, int wc, int fr, int fq) const {
        const int row0 = u.pm * 256 + wr * 64 + fr, colw = u.pn * 128 + wc * 32 + 8 * fq;
        const float* bg = b_up + (size_t)u.e * 2048 + colw; const float* bl = bg + 1024;
        f32x4 bgv[2], blv[2];
#pragma unroll
        for (int n = 0; n < 2; ++n) { bgv[n] = *(const f32x4*)(bg + 4 * n); blv[n] = *(const f32x4*)(bl + 4 * n); }
#pragma unroll
        for (int ai = 0; ai < 2; ++ai)
#pragma unroll
            for (int m = 0; m < 4; ++m) { float r[8];
#pragma unroll
                for (int n = 0; n < 2; ++n) { const f32x4 g4 = acc[ai][0][m][n] + bgv[n], l4 = acc[ai][1][m][n] + blv[n];
#pragma unroll
                    for (int i = 0; i < 4; ++i) { const float g = fminf(g4[i], 7.0f), l = fminf(fmaxf(l4[i], -7.0f), 7.0f); r[4 * n + i] = g / (1.f + __expf(-1.702f * g)) * (l + 1.f); } }
                v4u w; w.x = pk2(r[0], r[1]); w.y = pk2(r[2], r[3]); w.z = pk2(r[4], r[5]); w.w = pk2(r[6], r[7]);
                *(v4u*)(act + (size_t)(row0 + ai * 128 + m * 16) * DFF + colw) = w; }
    }
};
struct EpiDown {
    static constexpr bool PERM = true, AFTER_DRAIN = false;
    bf16* slot; const int* rslot; const float* rgate; const float* b_down;
    __device__ __forceinline__ void operator()(const f32x4 (&acc)[2][2][4][2], const pg8::Unit& u, int wr, int wc, int fr, int fq) const {
        const int row0 = u.pm * 256 + wr * 64 + fr, col0 = u.pn * 256 + wc * 32 + 8 * fq;
        const float* bb = b_down + (size_t)u.e * 1024 + col0;
        f32x4 bv[2][2];
#pragma unroll
        for (int bj = 0; bj < 2; ++bj)
#pragma unroll
            for (int n = 0; n < 2; ++n) bv[bj][n] = *(const f32x4*)(bb + bj * 128 + 4 * n);
#pragma unroll
        for (int ai = 0; ai < 2; ++ai)
#pragma unroll
            for (int m = 0; m < 4; ++m) { const int R = row0 + ai * 128 + m * 16; const int s = rslot[R]; const float gt = rgate[R];
                if (s >= 0) {
#pragma unroll
                    for (int bj = 0; bj < 2; ++bj) { const f32x4 v0 = (acc[ai][bj][m][0] + bv[bj][0]) * gt, v1 = (acc[ai][bj][m][1] + bv[bj][1]) * gt;
                        v4u w; w.x = pk2(v0[0], v0[1]); w.y = pk2(v0[2], v0[3]); w.z = pk2(v1[0], v1[1]); w.w = pk2(v1[2], v1[3]);
                        *(v4u*)(slot + (size_t)s * 1024 + col0 + bj * 128) = w; } } }
    }
};

__device__ __forceinline__ void p0_transpose_item(const float* W, int ldw, int K, bf16* WT, int src_col0, int dst_row0, int k0, LAS float* scr, int lane) {
#pragma unroll 8
    for (int i = 0; i < 32; ++i) { const int kk = 2 * i + (lane >> 5); scr[kk * 33 + (lane & 31)] = W[(size_t)(k0 + kk) * ldw + src_col0 + (lane & 31)]; }
    LDS_WAIT(); asm volatile("" ::: "memory");
    const int c = lane & 7;
#pragma unroll
    for (int j = 0; j < 4; ++j) { const int n = (lane >> 3) + 8 * j; const LAS float* s = scr + (8 * c) * 33 + n;
        v4u o; o.x = pk2(s[0 * 33], s[1 * 33]); o.y = pk2(s[2 * 33], s[3 * 33]); o.z = pk2(s[4 * 33], s[5 * 33]); o.w = pk2(s[6 * 33], s[7 * 33]);
        *(GAS v4u*)(WT + (size_t)(dst_row0 + n) * K + k0 + 8 * c) = o; }
    LDS_WAIT(); asm volatile("" ::: "memory");
}
__device__ __forceinline__ void p0_prologue(Frame& F) {
    LAS float* scr = (LAS float*)(F.lds + F.wave * 16384);
    const int gw = F.vcu * NWAVES + F.wave, NGW = F.G * NWAVES;
    for (int it = gw; it < 768; it += NGW) {
        const int s = it % 96, q = it / 96, col = s * 64 + F.lane;
        float a0 = 0.f, a1 = 0.f, a2 = 0.f, a3 = 0.f;
        for (int k = q * 128; k < q * 128 + 128; ++k) {
            const float wv = F.w_ada[(size_t)k * 6144 + col];
            a0 += siluf(F.c[k]) * wv; a1 += siluf(F.c[1024 + k]) * wv; a2 += siluf(F.c[2048 + k]) * wv; a3 += siluf(F.c[3072 + k]) * wv;
        }
        F.modp[(q * 4 + 0) * 6144 + col] = a0; F.modp[(q * 4 + 1) * 6144 + col] = a1; F.modp[(q * 4 + 2) * 6144 + col] = a2; F.modp[(q * 4 + 3) * 6144 + col] = a3;
    }
    constexpr int I_IN = 16 * 88, I_OUT = 16 * 32, I_UP = 32 * 1024, I_DN = 32 * 512, NITEMS = I_IN + I_OUT + I_UP + I_DN;
    for (int it = gw; it < NITEMS; it += NGW) {
        int r = it;
        if (r < I_IN) { const int kb = r / 88, nb = r % 88, dr = 32 * nb; p0_transpose_item(F.w_in, IN_COLS, D, F.Win_t, dr < 2048 ? dr : dr + 8, dr, 64 * kb, scr, F.lane); continue; } r -= I_IN;
        if (r < I_OUT) { const int kb = r / 32, nb = r % 32; p0_transpose_item(F.w_out, D, D, F.Wout_t, 32 * nb, 32 * nb, 64 * kb, scr, F.lane); continue; } r -= I_OUT;
        if (r < I_UP) { const int e = r >> 10, rr = r & 1023, kb = rr >> 6, nb = rr & 63, dr = 32 * nb, pn = dr >> 8, bj = (dr >> 7) & 1, j = dr & 127;
            p0_transpose_item(F.w_up + (size_t)e * 1024 * 2048, 2048, D, F.Wup_t + (size_t)e * 2048 * 1024, bj * 1024 + pn * 128 + j, dr, 64 * kb, scr, F.lane); continue; } r -= I_UP;
        { const int e = r >> 9, rr = r & 511, kb = rr >> 5, nb = rr & 31;
            p0_transpose_item(F.w_down + (size_t)e * 1024 * 1024, 1024, D, F.Wdn_t + (size_t)e * 1024 * 1024, 32 * nb, 32 * nb, 64 * kb, scr, F.lane); }
    }
}

__device__ __forceinline__ void mod_tables(Frame& F, LAS float* A, LAS float* Bv, const float* norm_w, int b, int sh_col) {
    for (int k = F.tid; k < 1024; k += NWAVES * 64) {
        float sh = F.b_ada[sh_col + k], sc = F.b_ada[sh_col + 1024 + k];
#pragma unroll
        for (int q = 0; q < 8; ++q) { sh += F.modp[(q * 4 + b) * 6144 + sh_col + k]; sc += F.modp[(q * 4 + b) * 6144 + sh_col + 1024 + k]; }
        A[k] = norm_w[k] * (1.f + sc); Bv[k] = sh;
    }
}
__device__ __forceinline__ void p1_hrows(Frame& F) {
    LAS float* A1 = (LAS float*)F.lds; LAS float* B1 = A1 + 1024; LAS float* Wab = B1 + 1024;
    for (int j = blockIdx.x; j < 24; j += F.G)
        for (int idx = j * 1024 + F.tid; idx < (j + 1) * 1024; idx += NWAVES * 64) { const int b = idx / 6144, col = idx % 6144; float s = F.b_ada[col];
#pragma unroll
            for (int q = 0; q < 8; ++q) s += F.modp[(q * 4 + b) * 6144 + col];
            F.modf[idx] = s; }
    for (int i = F.tid; i < 8192; i += NWAVES * 64) Wab[i] = F.w_in[(size_t)(i >> 3) * IN_COLS + 2048 + (i & 7)];
    for (int rg = blockIdx.x; rg < 256; rg += F.G) {
        const int b = rg >> 6;
        __syncthreads();
        mod_tables(F, A1, B1, F.norm1_w, b, 0);
        __syncthreads();
        for (int rr = F.wave; rr < 64; rr += NWAVES) {
            const int t = rg * 64 + rr;
            const GAS f32x4* xr = (const GAS f32x4*)(F.x + (size_t)t * D) + F.lane;
            f32x4 v[4]; float ss = 0.f;
#pragma unroll
            for (int j = 0; j < 4; ++j) { v[j] = xr[64 * j]; ss += (v[j].x * v[j].x + v[j].y * v[j].y) + (v[j].z * v[j].z + v[j].w * v[j].w); }
            const float rstd = rsqrtf(wave_sum(ss) * (1.f / D) + EPS);
            float acc[8];
#pragma unroll
            for (int i = 0; i < 8; ++i) acc[i] = 0.f;
            GAS unsigned long long* o8 = (GAS unsigned long long*)(F.H + (size_t)t * D) + F.lane;
#pragma unroll
            for (int j = 0; j < 4; ++j) { const int k = 4 * F.lane + 256 * j;
                const f32x4 a = *(const LAS f32x4*)(A1 + k), bb = *(const LAS f32x4*)(B1 + k);
                f32x4 hv = v[j] * rstd * a + bb;
                o8[64 * j] = (unsigned long long)pk2(hv.x, hv.y) | ((unsigned long long)pk2(hv.z, hv.w) << 32);
#pragma unroll
                for (int i = 0; i < 4; ++i) { const f32x4 wa = *(const LAS f32x4*)(Wab + (k + i) * 8), wb = *(const LAS f32x4*)(Wab + (k + i) * 8 + 4); const float hh = hv[i];
                    acc[0] += hh * wa.x; acc[1] += hh * wa.y; acc[2] += hh * wa.z; acc[3] += hh * wa.w; acc[4] += hh * wb.x; acc[5] += hh * wb.y; acc[6] += hh * wb.z; acc[7] += hh * wb.w; } }
#pragma unroll
            for (int i = 0; i < 8; ++i) acc[i] = wave_sum(acc[i]);
            if (F.lane < 8) { const int j = F.lane;
                float val = acc[0]; val = j == 1 ? acc[1] : val; val = j == 2 ? acc[2] : val; val = j == 3 ? acc[3] : val; val = j == 4 ? acc[4] : val; val = j == 5 ? acc[5] : val; val = j == 6 ? acc[6] : val; val = j == 7 ? acc[7] : val;
                float r;
                if (j < 4) { const float z = val + F.dt_bias[j]; const float sp = fmaxf(z, 0.f) + log1pf(__expf(-fabsf(z))); r = -__expf(F.a_log[j]) * sp; }
                else r = 1.f / (1.f + __expf(-val));
                F.gb[(size_t)t * 8 + j] = r; }
        }
    }
}

__device__ __forceinline__ void dn_prep_item(Frame& F, int item) {
    const int b = item >> 8, n = (item >> 2) & 63, h = item & 3, t0 = b * SEQ + n * CH, tid = F.tid;
    LAS float* qs = (LAS float*)F.lds; LAS float* ks = qs + 64 * 129; LAS float* vs = ks + 64 * 129; LAS float* Am = vs + 64 * 128; LAS float* gc = Am + 64 * 64; LAS float* bt = gc + 64;
    float* outp = F.dnp + (size_t)item * DNP_STRIDE;
    __syncthreads();
    for (int idx = tid; idx < 64 * 384; idx += NWAVES * 64) {
        const int c = idx / 384, ch = idx % 384, part = ch >> 7, d = ch & 127, chan = part * 512 + h * 128 + d;
        float a = 0.f;
#pragma unroll
        for (int j = 0; j < 4; ++j) { const int pos = n * CH + c - 3 + j; if (pos >= 0) a += F.conv_w[j * 1536 + chan] * bf2f(F.PROJ[(size_t)(b * SEQ + pos) * NPROJ + chan]); }
        const float val = siluf(a);
        if (part == 0) qs[c * 129 + d] = val; else if (part == 1) ks[c * 129 + d] = val; else vs[c * 128 + d] = val;
    }
    if (tid < 64) { gc[tid] = F.gb[(size_t)(t0 + tid) * 8 + h]; bt[tid] = F.gb[(size_t)(t0 + tid) * 8 + 4 + h]; }
    __syncthreads();
    if (tid == 0) { float s = 0.f; for (int c = 0; c < 64; ++c) { s += gc[c]; gc[c] = s; } }
    for (int r = 0; r < 8; ++r) { const int c = F.wave * 8 + r;
        const float q0 = qs[c * 129 + F.lane], q1 = qs[c * 129 + 64 + F.lane], k0 = ks[c * 129 + F.lane], k1 = ks[c * 129 + 64 + F.lane];
        const float sq = rsqrtf(wave_sum(q0 * q0 + q1 * q1) + EPS) * 0.08838834764831845f, sk = rsqrtf(wave_sum(k0 * k0 + k1 * k1) + EPS);
        qs[c * 129 + F.lane] = q0 * sq; qs[c * 129 + 64 + F.lane] = q1 * sq; ks[c * 129 + F.lane] = k0 * sk; ks[c * 129 + 64 + F.lane] = k1 * sk; }
    __syncthreads();
    for (int idx = tid; idx < 4096; idx += NWAVES * 64) { const int c = idx >> 6, s = idx & 63;
        float dkk = 0.f, dqk = 0.f;
#pragma unroll 8
        for (int d = 0; d < 128; ++d) { const float kv = ks[s * 129 + d]; dkk += ks[c * 129 + d] * kv; dqk += qs[c * 129 + d] * kv; }
        const float dec = __expf(fminf(gc[c] - gc[s], 0.f));
        Am[c * 64 + s] = (s < c) ? bt[c] * dkk * dec : 0.f;
        outp[32768 + idx] = (s <= c) ? dqk * dec : 0.f;
    }
    __syncthreads();
    {
        const float gl = gc[63];
        for (int idx = tid; idx < 8192; idx += NWAVES * 64) { const int c = idx >> 7, d = idx & 127; const float qv = qs[c * 129 + d], kv = ks[c * 129 + d], eg = __expf(gc[c]), be = bt[c];
            outp[16384 + idx] = qv * eg; outp[24576 + idx] = kv * __expf(gl - gc[c]); ks[c * 129 + d] = kv * be * eg; vs[c * 128 + d] *= be; }
        if (tid == 0) outp[36864] = __expf(gl);
    }
    __syncthreads();
    if (tid < 256) {
        const int col = tid; LAS float* R = (col < 128) ? (vs + col) : (ks + (col - 128)); const int rs = (col < 128) ? 128 : 129;
        for (int i = 1; i < 64; ++i) { float r = R[i * rs];
#pragma unroll 4
            for (int j = 0; j < i; ++j) r -= Am[i * 64 + j] * R[j * rs];
            R[i * rs] = r; }
        float* dst = (col < 128) ? (outp + 8192 + col) : (outp + col - 128);
        for (int i = 0; i < 64; ++i) dst[i * 128] = R[i * rs];
    }
}
__device__ __forceinline__ void swa_item(Frame& F, int item) {
    const int b = item >> 6, nb = (item >> 1) & 31, kvh = item & 1, tid = F.tid;
    LAS float* Ks = (LAS float*)F.lds; LAS float* Vs = Ks + 256 * 65;
    __syncthreads();
    {
        const int slot = tid >> 1, half = tid & 1, pos = nb * WIN - WIN + slot;
        float kv[32], vv[32]; float ss = 0.f;
        if (pos >= 0) {
            const v4u* kp = (const v4u*)(F.PROJ + (size_t)(b * SEQ + pos) * NPROJ + PC_SK + kvh * 64 + half * 32);
            const v4u* vp = (const v4u*)(F.PROJ + (size_t)(b * SEQ + pos) * NPROJ + PC_SV + kvh * 64 + half * 32);
#pragma unroll
            for (int i = 0; i < 4; ++i) { const v4u a = kp[i], c = vp[i];
                kv[8 * i + 0] = bflo(a.x); kv[8 * i + 1] = bfhi(a.x); kv[8 * i + 2] = bflo(a.y); kv[8 * i + 3] = bfhi(a.y); kv[8 * i + 4] = bflo(a.z); kv[8 * i + 5] = bfhi(a.z); kv[8 * i + 6] = bflo(a.w); kv[8 * i + 7] = bfhi(a.w);
                vv[8 * i + 0] = bflo(c.x); vv[8 * i + 1] = bfhi(c.x); vv[8 * i + 2] = bflo(c.y); vv[8 * i + 3] = bfhi(c.y); vv[8 * i + 4] = bflo(c.z); vv[8 * i + 5] = bfhi(c.z); vv[8 * i + 6] = bflo(c.w); vv[8 * i + 7] = bfhi(c.w); }
        } else {
#pragma unroll
            for (int i = 0; i < 32; ++i) { kv[i] = 0.f; vv[i] = 0.f; }
        }
#pragma unroll
        for (int i = 0; i < 32; ++i) ss += kv[i] * kv[i];
        ss += __shfl_xor(ss, 1);
        const float rs = rsqrtf(ss * (1.f / 64.f) + EPS);
#pragma unroll
        for (int i = 0; i < 32; ++i) { Ks[slot * 65 + half * 32 + i] = kv[i] * rs * F.k_norm_w[half * 32 + i]; Vs[slot * 65 + half * 32 + i] = vv[i]; }
    }
    __syncthreads();
    const int g = tid >> 7, i = tid & 127, hq = kvh * 4 + g, t = nb * WIN + i;
    float q[64];
    {
        const v4u* qp = (const v4u*)(F.PROJ + (size_t)(b * SEQ + t) * NPROJ + PC_SQ + hq * 64);
        float ss = 0.f;
#pragma unroll
        for (int j = 0; j < 8; ++j) { const v4u a = qp[j];
            q[8 * j + 0] = bflo(a.x); q[8 * j + 1] = bfhi(a.x); q[8 * j + 2] = bflo(a.y); q[8 * j + 3] = bfhi(a.y); q[8 * j + 4] = bflo(a.z); q[8 * j + 5] = bfhi(a.z); q[8 * j + 6] = bflo(a.w); q[8 * j + 7] = bfhi(a.w); }
#pragma unroll
        for (int d = 0; d < 64; ++d) ss += q[d] * q[d];
        const float rs = rsqrtf(ss * (1.f / 64.f) + EPS) * 0.125f;
#pragma unroll
        for (int d = 0; d < 64; ++d) q[d] *= rs * F.q_norm_w[d];
    }
    const float slope = exp2f(-(float)(hq + 1));
    float m = F.sinks[hq], l = 1.f, acc[64];
#pragma unroll
    for (int d = 0; d < 64; ++d) acc[d] = 0.f;
    for (int rel = 127; rel >= 0; --rel) {
        const int slot = i + 128 - rel;
        if (nb == 0 && slot < 128) continue;
        const LAS float* kr = Ks + slot * 65; const LAS float* vr = Vs + slot * 65;
        float s = 0.f;
#pragma unroll
        for (int d = 0; d < 64; ++d) s += q[d] * kr[d];
        const float logit = s - slope * (float)rel;
        const float mn = fmaxf(m, logit), corr = __expf(m - mn), p = __expf(logit - mn);
        l = l * corr + p; m = mn;
#pragma unroll
        for (int d = 0; d < 64; ++d) acc[d] = acc[d] * corr + p * vr[d];
    }
    const float il = 1.f / l;
    v4u* op = (v4u*)(F.MIXED + (size_t)(b * SEQ + t) * D + 512 + hq * 64);
#pragma unroll
    for (int j = 0; j < 8; ++j) { v4u w; w.x = pk2(acc[8 * j] * il, acc[8 * j + 1] * il); w.y = pk2(acc[8 * j + 2] * il, acc[8 * j + 3] * il); w.z = pk2(acc[8 * j + 4] * il, acc[8 * j + 5] * il); w.w = pk2(acc[8 * j + 6] * il, acc[8 * j + 7] * il); op[j] = w; }
}
__device__ __forceinline__ void p3_mixprep(Frame& F) {
    for (int it = blockIdx.x; it < 1024 + 256; it += F.G) {
#ifndef SKIP_SWA
        if (it < 256) swa_item(F, it);
#endif
#ifndef SKIP_DN
        if (it >= 256) dn_prep_item(F, it - 256);
#endif
    }
}

__device__ __forceinline__ void scan_item(Frame& F, int item) {
    const int bh = item >> 3, dvs = item & 7, b = bh >> 2, h = bh & 3, tid = F.tid;
    LAS float* wl = (LAS float*)F.lds; LAS float* ql = wl + 64 * 129; LAS float* kl = ql + 64 * 129; LAS float* aq = kl + 64 * 129;
    LAS float* Ss = aq + 64 * 65; LAS float* vn = Ss + 128 * 17; LAS float* ul = vn + 64 * 17;
    __syncthreads();
    for (int i = tid; i < 128 * 17; i += NWAVES * 64) Ss[i] = 0.f;
    for (int n = 0; n < NCH; ++n) {
        const float* p = F.dnp + (size_t)((b * 64 + n) * 4 + h) * DNP_STRIDE;
        __syncthreads();
        for (int i = tid; i < 8192; i += NWAVES * 64) { const int c = i >> 7, d = i & 127; wl[c * 129 + d] = p[i]; ql[c * 129 + d] = p[16384 + i]; kl[c * 129 + d] = p[24576 + i]; }
        for (int i = tid; i < 4096; i += NWAVES * 64) aq[(i >> 6) * 65 + (i & 63)] = p[32768 + i];
        for (int i = tid; i < 1024; i += NWAVES * 64) ul[i] = p[8192 + (i >> 4) * 128 + dvs * 16 + (i & 15)];
        const float dec = p[36864];
        __syncthreads();
        const int c = tid >> 3, e0 = (tid & 7) * 2;
        float p0 = 0.f, p1 = 0.f, o0 = 0.f, o1 = 0.f;
#pragma unroll 8
        for (int d = 0; d < 128; ++d) { const float s0 = Ss[d * 17 + e0], s1 = Ss[d * 17 + e0 + 1], wv = wl[c * 129 + d], qv = ql[c * 129 + d]; p0 += wv * s0; p1 += wv * s1; o0 += qv * s0; o1 += qv * s1; }
        vn[c * 17 + e0] = ul[c * 16 + e0] - p0; vn[c * 17 + e0 + 1] = ul[c * 16 + e0 + 1] - p1;
        __syncthreads();
        for (int s = 0; s <= c; ++s) { const float a = aq[c * 65 + s]; o0 += a * vn[s * 17 + e0]; o1 += a * vn[s * 17 + e0 + 1]; }
        float* op = F.odn + (size_t)(b * SEQ + n * CH + c) * 512 + h * 128 + dvs * 16 + e0; op[0] = o0; op[1] = o1;
        { const int d = tid >> 2, f0 = (tid & 3) * 4; float a0 = 0.f, a1 = 0.f, a2 = 0.f, a3 = 0.f;
#pragma unroll 8
          for (int c2 = 0; c2 < 64; ++c2) { const float kv = kl[c2 * 129 + d]; a0 += kv * vn[c2 * 17 + f0]; a1 += kv * vn[c2 * 17 + f0 + 1]; a2 += kv * vn[c2 * 17 + f0 + 2]; a3 += kv * vn[c2 * 17 + f0 + 3]; }
          Ss[d * 17 + f0] = Ss[d * 17 + f0] * dec + a0; Ss[d * 17 + f0 + 1] = Ss[d * 17 + f0 + 1] * dec + a1; Ss[d * 17 + f0 + 2] = Ss[d * 17 + f0 + 2] * dec + a2; Ss[d * 17 + f0 + 3] = Ss[d * 17 + f0 + 3] * dec + a3; }
    }
}
__device__ __forceinline__ void p4_scan(Frame& F) { for (int it = blockIdx.x; it < 128; it += F.G) scan_item(F, it); }

__device__ __forceinline__ void p5_dnnorm(Frame& F) {
    const int gw = F.vcu * NWAVES + F.wave, NGW = F.G * NWAVES, lane = F.lane, d0 = (lane & 15) * 8;
    for (int t = gw; t < T; t += NGW) {
        const f32x4* op = (const f32x4*)(F.odn + (size_t)t * 512 + lane * 8);
        const f32x4 a = op[0], c = op[1];
        float ss = (a.x * a.x + a.y * a.y) + (a.z * a.z + a.w * a.w) + (c.x * c.x + c.y * c.y) + (c.z * c.z + c.w * c.w);
        ss += __shfl_xor(ss, 1); ss += __shfl_xor(ss, 2); ss += __shfl_xor(ss, 4); ss += __shfl_xor(ss, 8);
        const float rs = rsqrtf(ss * (1.f / 128.f) + EPS);
        const v4u zz = *(const v4u*)(F.PROJ + (size_t)t * NPROJ + PC_Z + lane * 8);
        const f32x4 w0 = *(const f32x4*)(F.dn_norm_w + d0), w1 = *(const f32x4*)(F.dn_norm_w + d0 + 4);
        float r[8] = {a.x * rs * w0.x, a.y * rs * w0.y, a.z * rs * w0.z, a.w * rs * w0.w, c.x * rs * w1.x, c.y * rs * w1.y, c.z * rs * w1.z, c.w * rs * w1.w};
        const float z[8] = {bflo(zz.x), bfhi(zz.x), bflo(zz.y), bfhi(zz.y), bflo(zz.z), bfhi(zz.z), bflo(zz.w), bfhi(zz.w)};
#pragma unroll
        for (int i = 0; i < 8; ++i) r[i] *= siluf(z[i]);
        v4u w; w.x = pk2(r[0], r[1]); w.y = pk2(r[2], r[3]); w.z = pk2(r[4], r[5]); w.w = pk2(r[6], r[7]);
        *(v4u*)(F.MIXED + (size_t)t * D + lane * 8) = w;
    }
}

__device__ __forceinline__ void p7_router(Frame& F) {
    LAS float* A2 = (LAS float*)F.lds; LAS float* B2 = A2 + 1024; LAS float* Wt = B2 + 1024;
    for (int i = F.tid; i < 32768; i += NWAVES * 64) { const int k = i >> 5, e = i & 31; Wt[e * 1024 + k] = F.w_router[i]; }
    for (int rg = blockIdx.x; rg < 256; rg += F.G) {
        const int b = rg >> 6;
        __syncthreads();
        mod_tables(F, A2, B2, F.norm2_w, b, 3072);
        __syncthreads();
        for (int rr = F.wave; rr < 64; rr += NWAVES) {
            const int t = rg * 64 + rr;
            const GAS f32x4* xr = (const GAS f32x4*)(F.out + (size_t)t * D) + F.lane;
            f32x4 v[4]; float ss = 0.f;
#pragma unroll
            for (int j = 0; j < 4; ++j) { v[j] = xr[64 * j]; ss += (v[j].x * v[j].x + v[j].y * v[j].y) + (v[j].z * v[j].z + v[j].w * v[j].w); }
            const float rstd = rsqrtf(wave_sum(ss) * (1.f / D) + EPS);
            GAS unsigned long long* o8 = (GAS unsigned long long*)(F.H + (size_t)t * D) + F.lane;
#pragma unroll
            for (int j = 0; j < 4; ++j) { const int k = 4 * F.lane + 256 * j;
                const f32x4 a = *(const LAS f32x4*)(A2 + k), bb = *(const LAS f32x4*)(B2 + k);
                v[j] = v[j] * rstd * a + bb;
                o8[64 * j] = (unsigned long long)pk2(v[j].x, v[j].y) | ((unsigned long long)pk2(v[j].z, v[j].w) << 32); }
            float mylg = -3.0e38f;
#pragma unroll 4
            for (int e = 0; e < 32; ++e) { float s = 0.f;
#pragma unroll
                for (int j = 0; j < 4; ++j) { const f32x4 w = *(const LAS f32x4*)(Wt + e * 1024 + 4 * F.lane + 256 * j); s += (v[j].x * w.x + v[j].y * w.y) + (v[j].z * w.z + v[j].w * w.w); }
                s = wave_sum(s); if (F.lane == e) mylg = s + F.b_router[e]; }
            float tv[4]; int ti[4];
#pragma unroll
            for (int r = 0; r < 4; ++r) { float bv = mylg; int bi = F.lane;
#pragma unroll
                for (int o = 1; o < 64; o <<= 1) { const float ov = __shfl_xor(bv, o); const int oi = __shfl_xor(bi, o); if (ov > bv || (ov == bv && oi < bi)) { bv = ov; bi = oi; } }
                tv[r] = bv; ti[r] = bi; if (F.lane == bi) mylg = -3.0e38f; }
            const float e1 = __expf(tv[1] - tv[0]), e2 = __expf(tv[2] - tv[0]), e3 = __expf(tv[3] - tv[0]), inv = 1.f / (1.f + e1 + e2 + e3);
            if (F.lane < 4) { const int r = F.lane; const int e = r == 0 ? ti[0] : r == 1 ? ti[1] : r == 2 ? ti[2] : ti[3]; const float gt = (r == 0 ? 1.f : r == 1 ? e1 : r == 2 ? e2 : e3) * inv;
                const unsigned pos = atomicAdd((unsigned*)(F.ctl + CW_CNT + e), 1u);
                F.lslot[e * T + pos] = t * 4 + r; F.lgate[e * T + pos] = gt; }
        }
    }
}

__device__ __forceinline__ int moe_plan(Frame& F) {
    LAS int* tile_e = (LAS int*)(F.lds + CTRL_OFF + 256); LAS int* tile_l = tile_e + MAXTILES; LAS int* cnt_l = tile_l + MAXTILES;
    __syncthreads();
    if (F.tid == 0) { int nt = 0;
        for (int e = 0; e < NE; ++e) { const int c = (int)__hip_atomic_load(F.ctl + CW_CNT + e, RLX_AGENT); cnt_l[e] = c; const int k = (c + 255) >> 8;
            for (int j = 0; j < k; ++j) { tile_e[nt + j] = e; tile_l[nt + j] = j * 256; } nt += k; }
        F.MISC[0] = (unsigned)nt; }
    __syncthreads();
    return (int)F.MISC[0];
}
__device__ __forceinline__ void p8_gather(Frame& F) {
    const int nt = moe_plan(F);
    const LAS int* tile_e = (const LAS int*)(F.lds + CTRL_OFF + 256); const LAS int* tile_l = tile_e + MAXTILES; const LAS int* cnt_l = tile_l + MAXTILES;
    const int gw = F.vcu * NWAVES + F.wave, NGW = F.G * NWAVES;
    for (int R = gw; R < nt * 256; R += NGW) {
        const int ti = R >> 8, e = tile_e[ti], loc = tile_l[ti] + (R & 255);
        v4u a = (v4u){0u, 0u, 0u, 0u}, c = a; int s = -1; float gt = 0.f;
        if (loc < cnt_l[e]) { s = F.lslot[e * T + loc]; gt = F.lgate[e * T + loc]; const v4u* hp = (const v4u*)(F.H + (size_t)(s >> 2) * D) + F.lane * 2; a = hp[0]; c = hp[1]; }
        v4u* xp = (v4u*)(F.XS + (size_t)R * D) + F.lane * 2; xp[0] = a; xp[1] = c;
        if (F.lane == 0) { F.rslot[R] = s; F.rgate[R] = gt; }
    }
}

__device__ __forceinline__ void p11_combine(Frame& F) {
    const int gw = F.vcu * NWAVES + F.wave, NGW = F.G * NWAVES, lane = F.lane;
    for (int t = gw; t < T; t += NGW) {
        const int b = t >> 12;
        const float* g2 = F.modf + b * 6144 + 5120;
#pragma unroll
        for (int j = 0; j < 2; ++j) {
            const int col = j * 512 + lane * 8;
            float s[8];
#pragma unroll
            for (int i = 0; i < 8; ++i) s[i] = 0.f;
#pragma unroll
            for (int k = 0; k < 4; ++k) { const v4u w = *(const v4u*)(F.SLOT + (size_t)(t * 4 + k) * D + col);
                s[0] += bflo(w.x); s[1] += bfhi(w.x); s[2] += bflo(w.y); s[3] += bfhi(w.y); s[4] += bflo(w.z); s[5] += bfhi(w.z); s[6] += bflo(w.w); s[7] += bfhi(w.w); }
            f32x4* op = (f32x4*)(F.out + (size_t)t * D + col);
            const f32x4 g0 = *(const f32x4*)(g2 + col), g1 = *(const f32x4*)(g2 + col + 4);
            f32x4 x0 = op[0], x1 = op[1];
            x0.x += g0.x * s[0]; x0.y += g0.y * s[1]; x0.z += g0.z * s[2]; x0.w += g0.w * s[3]; x1.x += g1.x * s[4]; x1.y += g1.y * s[5]; x1.z += g1.z * s[6]; x1.w += g1.w * s[7];
            op[0] = x0; op[1] = x1;
        }
    }
}

struct Args { const float* in[21]; float* out; unsigned char* ws; int ph_lo, ph_hi, li, pad; };
__global__ void __launch_bounds__(NWAVES * 64, 2) fwd_kernel(Args args) {
    extern __shared__ __attribute__((aligned(16))) unsigned char lds[];
    Frame F;
    F.lds = (LAS unsigned char*)lds;
    F.MISC = (volatile LAS unsigned*)(F.lds + CTRL_OFF);
    F.tid = threadIdx.x; F.lane = F.tid & 63; F.wave = __builtin_amdgcn_readfirstlane(F.tid >> 6);
    F.G = gridDim.x; { const int bx = blockIdx.x; F.vcu = (F.G % 8 == 0) ? (bx % 8) * (F.G / 8) + bx / 8 : bx; }
    unsigned char* ws = args.ws;
    F.ctl = (gu32*)(ws + WS_CTL);
    F.x = args.in[0]; F.c = args.in[1]; F.w_ada = args.in[2]; F.b_ada = args.in[3]; F.norm1_w = args.in[4]; F.w_in = args.in[5]; F.conv_w = args.in[6]; F.a_log = args.in[7]; F.dt_bias = args.in[8];
    F.dn_norm_w = args.in[9]; F.q_norm_w = args.in[10]; F.k_norm_w = args.in[11]; F.sinks = args.in[12]; F.w_out = args.in[13]; F.norm2_w = args.in[14]; F.w_router = args.in[15]; F.b_router = args.in[16];
    F.w_up = args.in[17]; F.b_up = args.in[18]; F.w_down = args.in[19]; F.b_down = args.in[20]; F.out = args.out;
    F.modp = (float*)(ws + WS_MODP); F.modf = (float*)(ws + WS_MODF); F.gb = (float*)(ws + WS_GB); F.odn = (float*)(ws + WS_ODN); F.dnp = (float*)(ws + WS_DNP);
    F.lslot = (int*)(ws + WS_LSLOT); F.lgate = (float*)(ws + WS_LGATE); F.rslot = (int*)(ws + WS_RSLOT); F.rgate = (float*)(ws + WS_RGATE);
    F.Win_t = (bf16*)(ws + WS_WIN); F.Wout_t = (bf16*)(ws + WS_WOUT); F.Wup_t = (bf16*)(ws + WS_WUP); F.Wdn_t = (bf16*)(ws + WS_WDN);
    F.H = (bf16*)(ws + WS_H); F.PROJ = (bf16*)(ws + WS_PROJ); F.MIXED = (bf16*)(ws + WS_MIXED); F.XS = (bf16*)(ws + WS_XS); F.ACT = (bf16*)(ws + WS_ACT); F.SLOT = (bf16*)(ws + WS_SLOT);
    for (int u = F.tid; u < 32; u += NWAVES * 64) ((LAS unsigned*)(F.lds + CTRL_OFF))[u] = 0u;
    __syncthreads();
    XcdBarrier bar; bar.bar = (unsigned*)(F.ctl + CW_BAR); bar.x = 0; bar.st = nullptr;
    if (N_LAUNCHES == 1) bar = xcd_barrier_post((unsigned*)(F.ctl + CW_BAR), F.MISC + 8);
    const int lo = args.ph_lo, hi = args.ph_hi;
#ifndef PHASE_MASK
#define PHASE_MASK 0xFFFu
#endif
#define IN(k) (((PHASE_MASK >> (k)) & 1u) && lo <= (k) && (k) < hi)
#define SEAM(k) do { if (IN(k) && IN((k) + 1)) xcd_barrier(bar); } while (0)

    if (IN(0)) { p0_prologue(F); SEAM(0); }
    if (IN(1)) { p1_hrows(F); SEAM(1); }
    if (IN(2)) {
        pg8::Gemm g{F.H, F.Win_t, T, NPROJ, D}; DenseOrder S; S.init(T, NPROJ, D, F.G, (int)blockIdx.x);
        pg8::EpiBf16<0> E{F.PROJ, NPROJ, nullptr, 0, 0, 1.f};
        pg8::gemm_phase<pg8::EpiBf16<0>, DenseOrder, true, true>(F.lds, g, S, E);
        SEAM(2);
    }
    if (IN(3)) { p3_mixprep(F); SEAM(3); }
    if (IN(4)) { p4_scan(F); SEAM(4); }
    if (IN(5)) { p5_dnnorm(F); SEAM(5); }
    if (IN(6)) {
        pg8::Gemm g{F.MIXED, F.Wout_t, T, D, D}; DenseOrder S; S.init(T, D, D, F.G, (int)blockIdx.x);
        EpiX1 E{F.x, F.out, F.modf};
        pg8::gemm_phase<EpiX1, DenseOrder, true, true>(F.lds, g, S, E);
        SEAM(6);
    }
    if (IN(7)) { p7_router(F); SEAM(7); }
    if (IN(8)) { p8_gather(F); SEAM(8); }
    if (IN(9)) {
        const int nt = moe_plan(F);
        pg8::Gemm g{F.XS, F.Wup_t, 0, 0, D};
        MoeOrder S{nt, 8, F.G, (int)blockIdx.x, 2048, (size_t)256 * D * 2, (const LAS int*)(F.lds + CTRL_OFF + 256)};
        EpiSwiglu E{F.ACT, F.b_up};
        pg8::gemm_phase<EpiSwiglu, MoeOrder, true, true>(F.lds, g, S, E);
        SEAM(9);
    }
    if (IN(10)) {
        const int nt = moe_plan(F);
        pg8::Gemm g{F.ACT, F.Wdn_t, 0, 0, DFF};
        MoeOrder S{nt, 4, F.G, (int)blockIdx.x, 1024, (size_t)256 * DFF * 2, (const LAS int*)(F.lds + CTRL_OFF + 256)};
        EpiDown E{F.SLOT, F.rslot, F.rgate, F.b_down};
        pg8::gemm_phase<EpiDown, MoeOrder, true, true>(F.lds, g, S, E);
        SEAM(10);
    }
    if (IN(11)) { p11_combine(F); }
#undef IN
#undef SEAM
}

extern "C" void kernel_launch(void* const* d_in, const int* in_sizes, int n_in, void* d_out, int out_size, void* d_ws, size_t ws_size, hipStream_t stream) {
    static int grid = 0;
    if (grid == 0) {
        if (n_in != 21 || out_size != T * D || ws_size < WS_END) { fprintf(stderr, "kernel_launch: unexpected shapes (n_in %d out %d ws %zu)\n", n_in, out_size, ws_size); grid = -1; return; }
        int dev = 0, cus = 0;
        if (hipGetDevice(&dev) != hipSuccess || hipDeviceGetAttribute(&cus, hipDeviceAttributeMultiprocessorCount, dev) != hipSuccess) { grid = -1; return; }
        if (hipFuncSetAttribute((const void*)fwd_kernel, hipFuncAttributeMaxDynamicSharedMemorySize, LDS_BYTES) != hipSuccess) { fprintf(stderr, "kernel_launch: hipFuncSetAttribute failed\n"); grid = -1; return; }
        int per_cu = 0;
        if (hipOccupancyMaxActiveBlocksPerMultiprocessor(&per_cu, (const void*)fwd_kernel, NWAVES * 64, LDS_BYTES) != hipSuccess || per_cu < 1) fprintf(stderr, "kernel_launch: occupancy query reports %d\n", per_cu);
        (void)hipGetLastError();
        grid = cus;
    }
    if (grid < 0) return;
    if (hipMemsetAsync((char*)d_ws + WS_CTL, 0, CTL_ZERO_BYTES, stream) != hipSuccess) { fprintf(stderr, "kernel_launch: memset failed\n"); return; }
    Args a{};
    for (int i = 0; i < 21; ++i) a.in[i] = (const float*)d_in[i];
    a.out = (float*)d_out; a.ws = (unsigned char*)d_ws;
    for (int li = 0; li < N_LAUNCHES; ++li) {
        a.ph_lo = (N_LAUNCHES == 1) ? 0 : li; a.ph_hi = (N_LAUNCHES == 1) ? NPH : li + 1; a.li = li;
        hipLaunchKernelGGL(fwd_kernel, dim3(grid), dim3(NWAVES * 64), LDS_BYTES, stream, a);
        const hipError_t le = hipPeekAtLastError();
        if (le != hipSuccess) { fprintf(stderr, "kernel_launch: launch %d failed: %s\n", li, hipGetErrorName(le)); break; }
    }
}
```

```cpp
#include <hip/hip_runtime.h>
#include <cstdio>
#include <cstdint>

namespace pg8 {
#define PG8_LAS __attribute__((address_space(3)))
typedef unsigned short bf16_t;
typedef short bf16x8 __attribute__((ext_vector_type(8)));
typedef float f32x4 __attribute__((ext_vector_type(4)));
typedef unsigned u32x4 __attribute__((ext_vector_type(4)));
constexpr int BM = 256, BK = 64, HALF = 128, HTB = HALF * BK * 2  , STAGE_BYTES = 8 * HTB, NXCD = 8, WGM = 8;

__host__ __device__ __forceinline__ int lds_byte(int r, int c) { const int st = (r >> 4) * 2 + (c >> 5), rr = r & 15, cc = c & 31, ob = rr * 64 + cc * 2; return st * 1024 + (ob ^ (((ob >> 9) & 1) << 5)); }
__host__ __device__ __forceinline__ void stage_rc(int b, int& R, int& C) { const int st = b / 1024, sb = b % 1024, swz = sb ^ (((sb >> 9) & 1) << 5); R = (st >> 1) * 16 + swz / 64; C = (st & 1) * 32 + (swz % 64) / 2; }
__host__ __device__ __forceinline__ int perm32(int rho) { const int n = rho >> 4, i = rho & 15; return 8 * (i >> 2) + 4 * n + (i & 3); }

struct Unit { int pm, pn, e, l0; };
typedef int i32x4 __attribute__((ext_vector_type(4)));
typedef int i32x8 __attribute__((ext_vector_type(8)));
__device__ __forceinline__ bf16x8 frag_lo(i32x8 v) { return __builtin_bit_cast(bf16x8, __builtin_shufflevector(v, v, 0, 1, 2, 3)); }
__device__ __forceinline__ bf16x8 frag_hi(i32x8 v) { return __builtin_bit_cast(bf16x8, __builtin_shufflevector(v, v, 4, 5, 6, 7)); }
struct MmaBf16 { typedef f32x4 acc_t; static __device__ __forceinline__ acc_t mma(i32x8 a, i32x8 b, acc_t c) {
    c = __builtin_amdgcn_mfma_f32_16x16x32_bf16(frag_lo(a), frag_lo(b), c, 0, 0, 0); return __builtin_amdgcn_mfma_f32_16x16x32_bf16(frag_hi(a), frag_hi(b), c, 0, 0, 0); } };
struct MmaI8 { typedef i32x4 acc_t; static __device__ __forceinline__ acc_t mma(i32x8 a, i32x8 b, acc_t c) {
    c = __builtin_amdgcn_mfma_i32_16x16x64_i8(__builtin_shufflevector(a, a, 0, 1, 2, 3), __builtin_shufflevector(b, b, 0, 1, 2, 3), c, 0, 0, 0);
    return __builtin_amdgcn_mfma_i32_16x16x64_i8(__builtin_shufflevector(a, a, 4, 5, 6, 7), __builtin_shufflevector(b, b, 4, 5, 6, 7), c, 0, 0, 0); } };
typedef long i64x4v __attribute__((ext_vector_type(4)));
struct MmaFp8 { typedef f32x4 acc_t; static __device__ __forceinline__ acc_t mma(i32x8 a, i32x8 b, acc_t c) {
    asm volatile("v_mfma_f32_16x16x128_f8f6f4 %0, %1, %2, %0" : "+v"(c) : "v"(a), "v"(b)); return c; } };
struct Gemm { const bf16_t* A; const bf16_t* Bt; int M, N, K; };

__device__ __forceinline__ unsigned cvt_pk_bf16(float lo, float hi) { unsigned r; asm volatile("v_cvt_pk_bf16_f32 %0, %1, %2" : "=v"(r) : "v"(lo), "v"(hi)); return r; }
typedef float f32x2 __attribute__((ext_vector_type(2)));
__device__ __forceinline__ f32x2 gelu_pk(f32x2 v) {
    const f32x2 av = __builtin_elementwise_abs(v), d = av * 0.2316418882f + 1.0f;
    f32x2 t; t.x = __builtin_amdgcn_rcpf(d.x); t.y = __builtin_amdgcn_rcpf(d.y);
    f32x2 q = t * 0.5307027145f + (-0.7265760135f); q = q * t + 0.7107068705f; q = q * t + (-0.142248368f); q = q * t + 0.127414796f; q = q * t;
    const f32x2 s = (v * v) * (-0.72134752044f);
    f32x2 e; e.x = __builtin_amdgcn_exp2f(s.x); e.y = __builtin_amdgcn_exp2f(s.y);
    const f32x2 m = v * (q * e), r = v - m;
    f32x2 o; o.x = v.x < 0.f ? m.x : r.x; o.y = v.y < 0.f ? m.y : r.y; return o;
}

template <int ACT  > struct EpiBf16 {
    typedef MmaBf16 Mma; static constexpr bool PERM = true, AFTER_DRAIN = false; static_assert(ACT == 0 || ACT == 1, "EpiBf16: ACT is 0 (none) or 1 (gelu_pk)");
    bf16_t* O; int ldc; const float* bias; int split_cols; size_t split_stride; float scale0;
    __device__ __forceinline__ void operator()(const f32x4 (&acc)[2][2][4][2], const Unit& u, int wr, int wc, int fr, int fq) const {
        const int row0 = u.pm * BM + wr * 64 + fr; int colt = u.pn * BM; bf16_t* base = O;
        float sc = 1.f; if (split_cols) { const int t = colt / split_cols; base += (size_t)t * split_stride; colt -= t * split_cols; if (t == 0) sc = scale0; }
        const int col0 = colt + wc * 32 + 8 * fq, bcol0 = u.pn * BM + wc * 32 + 8 * fq;
        f32x4 bv[2][2];
#pragma unroll
        for (int bj = 0; bj < 2; ++bj)
#pragma unroll
            for (int n = 0; n < 2; ++n) bv[bj][n] = bias ? *(const f32x4*)(bias + bcol0 + bj * HALF + 4 * n) : (f32x4){0.f, 0.f, 0.f, 0.f};
#pragma unroll
        for (int ai = 0; ai < 2; ++ai)
#pragma unroll
            for (int m = 0; m < 4; ++m) { bf16_t* rowp = base + (size_t)(row0 + ai * HALF + m * 16) * ldc + col0;
#pragma unroll
                for (int bj = 0; bj < 2; ++bj) { f32x4 v0 = acc[ai][bj][m][0] + bv[bj][0], v1 = acc[ai][bj][m][1] + bv[bj][1];
                    if (ACT == 1) { f32x2 a = gelu_pk((f32x2){v0[0], v0[1]}), b = gelu_pk((f32x2){v0[2], v0[3]}), c = gelu_pk((f32x2){v1[0], v1[1]}), d = gelu_pk((f32x2){v1[2], v1[3]});
                        v0 = (f32x4){a.x, a.y, b.x, b.y}; v1 = (f32x4){c.x, c.y, d.x, d.y}; }
                    v0 = v0 * sc; v1 = v1 * sc; u32x4 w; w.x = cvt_pk_bf16(v0[0], v0[1]); w.y = cvt_pk_bf16(v0[2], v0[3]); w.z = cvt_pk_bf16(v1[0], v1[1]); w.w = cvt_pk_bf16(v1[2], v1[3]);
                    *(u32x4*)(rowp + bj * HALF) = w; } }
    }
};

template <class Epi, class Sched, bool ALIGN_EPI = false, bool SP2 = false>
__device__ __forceinline__ void gemm_phase(PG8_LAS unsigned char* lds, const Gemm g, const Sched& S, const Epi& E, const int wid, const int lane) {
    const int tid = wid * 64 + lane, wr = wid >> 2, wc = wid & 3, fr = lane & 15, fq = lane >> 4;
    const int K = g.K, nt = K / BK;
    unsigned voffB[2];
#pragma unroll
    for (int i = 0; i < 2; ++i) { int R, C; stage_rc(tid * 16 + i * 8192, R, C); const int Rb = Epi::PERM ? ((R & ~31) + perm32(R & 31)) : R;
        voffB[i] = (unsigned)(Rb * K + C) * 2u; }
    const size_t kstep = (size_t)(BK * 2);
    const size_t hstep = (size_t)HALF * K * 2;
    const unsigned ldsw = (unsigned)wid * 1024u;
    const int aoff = lds_byte(wr * 64 + fr, fq * 8), boff = lds_byte(wc * 32 + fr, fq * 8);
#define PG8_SA(b, h) (((b) * 2 + (h)) * HTB)
#define PG8_SB(b, h) ((4 + (b) * 2 + (h)) * HTB)
#define PG8_STAGE(bufoff, gbase, voff) do { _Pragma("unroll") for (int _i = 0; _i < 2; ++_i) \
        __builtin_amdgcn_global_load_lds((const unsigned*)((const char*)(gbase) + (voff)[_i]), (PG8_LAS unsigned*)(lds + (bufoff) + ldsw + _i * 8192), 16, 0, 0); } while (0)
#define PG8_LDA(dst, b, h) do { _Pragma("unroll") for (int m = 0; m < 4; ++m) { const i32x4 lo_ = *(const PG8_LAS i32x4*)(lds + PG8_SA(b, h) + aoff + m * 2048), hi_ = *(const PG8_LAS i32x4*)(lds + PG8_SA(b, h) + aoff + m * 2048 + 1024); dst[m] = __builtin_shufflevector(lo_, hi_, 0, 1, 2, 3, 4, 5, 6, 7); } } while (0)
#define PG8_LDB(dst, b, h) do { _Pragma("unroll") for (int n = 0; n < 2; ++n) { const i32x4 lo_ = *(const PG8_LAS i32x4*)(lds + PG8_SB(b, h) + boff + n * 2048), hi_ = *(const PG8_LAS i32x4*)(lds + PG8_SB(b, h) + boff + n * 2048 + 1024); dst[n] = __builtin_shufflevector(lo_, hi_, 0, 1, 2, 3, 4, 5, 6, 7); } } while (0)
#define PG8_MMA(ai, bj, At, Bt) do { __builtin_amdgcn_s_setprio(1); _Pragma("unroll") for (int m = 0; m < 4; ++m) _Pragma("unroll") for (int n = 0; n < 2; ++n) \
        acc[ai][bj][m][n] = Epi::Mma::mma(Bt[n], At[m], acc[ai][bj][m][n]); __builtin_amdgcn_s_setprio(0); } while (0)
#define PG8_WAIT_V(n) asm volatile("s_waitcnt vmcnt(" #n ")" ::: "memory")
#define PG8_WAIT_L(n) asm volatile("s_waitcnt lgkmcnt(" #n ")" ::: "memory")
#define PG8_BAR __builtin_amdgcn_s_barrier()
#define PG8_SCHED __builtin_amdgcn_sched_barrier(0)
    Unit cur, nxt; int ui = 0;
    if (!S.next(0, cur)) return;
    typedef typename Epi::Mma::acc_t acc_t;
    acc_t acc[2][2][4][2];
#pragma unroll
    for (int a = 0; a < 2; ++a)
#pragma unroll
        for (int b = 0; b < 2; ++b)
#pragma unroll
            for (int m = 0; m < 4; ++m)
#pragma unroll
                for (int n = 0; n < 2; ++n) acc[a][b][m][n] = acc_t{};
    i32x8 At[4], B0[2], B1[2];
    const char* const A0 = (const char*)g.A; const char* cB = (const char*)g.Bt + S.boff(cur);
    unsigned oA0[2], oA1[2], nA0[2], nA1[2];
    S.a_offsets(cur, oA0, oA1);
    S.a_ready(cur);
    if constexpr (SP2) {
        PG8_STAGE(PG8_SB(0, 0), cB, voffB); PG8_STAGE(PG8_SB(0, 1), cB + hstep, voffB); PG8_STAGE(PG8_SA(0, 0), A0, oA0); PG8_STAGE(PG8_SA(0, 1), A0, oA1);
        if (wr == 1) PG8_BAR;
        PG8_WAIT_V(2); PG8_BAR;
        PG8_STAGE(PG8_SB(1, 0), cB + kstep, voffB); PG8_STAGE(PG8_SA(1, 0), A0 + kstep, oA0); PG8_STAGE(PG8_SB(1, 1), cB + hstep + kstep, voffB);
        PG8_WAIT_V(6); PG8_BAR;
    }
    for (;;) {
        const bool has_next = S.next(ui + 1, nxt);
        const char* nB = has_next ? (const char*)g.Bt + S.boff(nxt) : cB;
        if (has_next) S.a_offsets(nxt, nA0, nA1); else { nA0[0] = oA0[0]; nA0[1] = oA0[1]; nA1[0] = oA1[0]; nA1[1] = oA1[1]; }
#pragma nounroll
        for (int t = 0; t < nt; t += 2) {
            const bool last = (t == nt - 2);
            const char* a1 = A0 + (size_t)(t + 1) * kstep;
            const char* a2 = last ? A0 : A0 + (size_t)(t + 2) * kstep; const char* b2 = last ? nB : cB + (size_t)(t + 2) * kstep;
            unsigned s0[2], s1[2]; s0[0] = last ? nA0[0] : oA0[0]; s0[1] = last ? nA0[1] : oA0[1]; s1[0] = last ? nA1[0] : oA1[0]; s1[1] = last ? nA1[1] : oA1[1];
            const char* a3 = a2 + kstep; const char* b3 = b2 + kstep;
            if (last && has_next) S.a_ready(nxt);
            if constexpr (SP2) {
            PG8_LDB(B0, 0, 0); PG8_LDB(B1, 0, 1); PG8_SCHED; PG8_LDA(At, 0, 0); PG8_STAGE(PG8_SA(1, 1), a1, oA1);
            PG8_WAIT_V(8); PG8_WAIT_L(0); PG8_BAR; PG8_MMA(0, 0, At, B0); PG8_MMA(0, 1, At, B1); PG8_BAR; PG8_SCHED;
            PG8_LDA(At, 0, 1); PG8_STAGE(PG8_SB(0, 0), b2, voffB); PG8_STAGE(PG8_SB(0, 1), b2 + hstep, voffB); PG8_STAGE(PG8_SA(0, 0), a2, s0);
            PG8_WAIT_V(8); PG8_WAIT_L(0); PG8_BAR; PG8_MMA(1, 0, At, B0); PG8_MMA(1, 1, At, B1); PG8_BAR; PG8_SCHED;
            PG8_LDB(B0, 1, 0); PG8_LDB(B1, 1, 1); PG8_SCHED; PG8_LDA(At, 1, 0); PG8_STAGE(PG8_SA(0, 1), a2, s1);
            PG8_WAIT_V(8); PG8_WAIT_L(0); PG8_BAR; PG8_MMA(0, 0, At, B0); PG8_MMA(0, 1, At, B1); PG8_BAR; PG8_SCHED;
            PG8_LDA(At, 1, 1); PG8_STAGE(PG8_SB(1, 0), b3, voffB); PG8_STAGE(PG8_SB(1, 1), b3 + hstep, voffB); PG8_STAGE(PG8_SA(1, 0), a3, s0);
            PG8_WAIT_V(8); PG8_WAIT_L(0); PG8_BAR; PG8_MMA(1, 0, At, B0); PG8_MMA(1, 1, At, B1); PG8_BAR; PG8_SCHED;
            }
        }
        if constexpr (ALIGN_EPI) { if (wr == 0) PG8_BAR; }
        asm volatile("s_nop 7\n\ts_nop 7\n\ts_nop 7" ::: "memory");
        if constexpr (!Epi::AFTER_DRAIN) { E(acc, cur, wr, wc, fr, fq); S.done(cur); }
        if (!has_next) break;
#pragma unroll
        for (int a = 0; a < 2; ++a)
#pragma unroll
            for (int b = 0; b < 2; ++b)
#pragma unroll
                for (int m = 0; m < 4; ++m)
#pragma unroll
                    for (int n = 0; n < 2; ++n) acc[a][b][m][n] = acc_t{};
        cur = nxt; cB = nB; ++ui; oA0[0] = nA0[0]; oA0[1] = nA0[1]; oA1[0] = nA1[0]; oA1[1] = nA1[1];
        if constexpr (ALIGN_EPI) { if (wr == 1) PG8_BAR; }
    }
    PG8_WAIT_V(0);
    if constexpr (!ALIGN_EPI) { if (wr == 0) PG8_BAR; }
    PG8_BAR;
    if constexpr (Epi::AFTER_DRAIN) { E.fused(acc, cur, wr, wc, fr, fq, lds, wid, lane); S.done(cur); }
#undef PG8_SA
#undef PG8_SB
#undef PG8_STAGE
#undef PG8_LDA
#undef PG8_LDB
#undef PG8_MMA
#undef PG8_WAIT_V
#undef PG8_WAIT_L
#undef PG8_BAR
#undef PG8_SCHED
}
}

#define GAS __attribute__((address_space(1)))
#define LAS __attribute__((address_space(3)))
typedef unsigned short bf16;
typedef unsigned v4u __attribute__((ext_vector_type(4)));
typedef float f32x4 __attribute__((ext_vector_type(4)));
typedef short bf16x8 __attribute__((ext_vector_type(8)));
typedef GAS unsigned gu32;
typedef GAS unsigned long long gu64;
#define RLX_AGENT __ATOMIC_RELAXED, __HIP_MEMORY_SCOPE_AGENT
#define LDS_WAIT() asm volatile("s_waitcnt lgkmcnt(0)" ::: "memory")
#define VM_WAIT() asm volatile("s_waitcnt vmcnt(0)" ::: "memory")
__device__ __forceinline__ unsigned long long rt() { return __builtin_amdgcn_s_memrealtime(); }
__device__ __forceinline__ unsigned f2bf(float f) { unsigned u = __builtin_bit_cast(unsigned, f); return (u + 0x7fffu + ((u >> 16) & 1u)) >> 16; }
typedef float f32x2_t __attribute__((ext_vector_type(2))); typedef __bf16 bf16x2_t __attribute__((ext_vector_type(2)));
__device__ __forceinline__ unsigned pk2(float lo, float hi) { const f32x2_t v = {lo, hi}; const bf16x2_t b = __builtin_convertvector(v, bf16x2_t); return __builtin_bit_cast(unsigned, b); }

#define XB_TMO      128
#define XB_XCNT(j)  (256  + 64 * (j))
#define XB_XSUB(j)  (1280 + 64 * (j))
#define XB_XGEN(j)  (2304 + 64 * (j))
#define XB_TOP      3328
#define XB_TOPGEN   3392
#define XCD_BAR_WORDS 3456
#define XB_SPIN_CAP (1u << 18)

__device__ __forceinline__ unsigned xb_ld(unsigned* p)              { return __hip_atomic_load(p, __ATOMIC_RELAXED, __HIP_MEMORY_SCOPE_AGENT); }
__device__ __forceinline__ unsigned xb_add(unsigned* p, unsigned v) { return __hip_atomic_fetch_add(p, v, __ATOMIC_RELAXED, __HIP_MEMORY_SCOPE_AGENT); }
__device__ __forceinline__ unsigned xb_xcc_id() { return (unsigned)__builtin_amdgcn_s_getreg((3 << 11) | 20) & 0xFu; }
#define XB_SPIN(cond, bar) do { unsigned _sp = 0; while (cond) { __builtin_amdgcn_s_sleep(1); \
    if ((++_sp & 255u) == 0u) { if (xb_ld(&(bar)[XB_TMO])) break; if (_sp > XB_SPIN_CAP) { atomicAdd(&(bar)[XB_TMO], 1u); break; } } } } while (0)

struct XcdBarrier {
    unsigned wv;
    unsigned* bar; unsigned x;
    volatile LAS unsigned* st;
};

__device__ __forceinline__ int lane_now() { int l; asm volatile("v_mbcnt_lo_u32_b32 %0, -1, 0\n\tv_mbcnt_hi_u32_b32 %0, -1, %0" : "=v"(l)); return l; }
__device__ __forceinline__ XcdBarrier xcd_barrier_post(unsigned* bar, volatile LAS unsigned* st, unsigned wv) {
    XcdBarrier b; b.wv = wv; b.bar = bar; b.x = xb_xcc_id(); b.st = st;
    if (wv == 0u && lane_now() == 0) (void)xb_add(&bar[XB_XCNT(b.x)], 1u);
    return b;
}
__device__ __forceinline__ void xcd_barrier_complete(unsigned* bar, unsigned x, unsigned& nloc, unsigned& nx) {
    const unsigned G = gridDim.x * gridDim.y * gridDim.z;
    unsigned sum, cnt, mine, sp = 0u;
    for (;;) {
        sum = 0u; cnt = 0u; mine = 0u;
#pragma unroll
        for (unsigned j = 0; j < 16; ++j) { const unsigned c = xb_ld(&bar[XB_XCNT(j)]); sum += c; cnt += (c > 0u) ? 1u : 0u; mine = (j == x) ? c : mine; }
        if (sum == G) break;
        __builtin_amdgcn_s_sleep(1);
        if ((++sp & 255u) == 0u) { if (xb_ld(&bar[XB_TMO])) break; if (sp > XB_SPIN_CAP) { atomicAdd(&bar[XB_TMO], 1u); break; } }
    }
    nloc = mine > 0u ? mine : 1u; nx = cnt > 0u ? cnt : 1u;
}

__device__ __forceinline__ void xcd_barrier(const XcdBarrier& b) {
    asm volatile("s_waitcnt vmcnt(0)" ::: "memory");
    __syncthreads();
    if (b.wv == 0u && lane_now() == 0) {
        unsigned* bar = b.bar;
        __builtin_amdgcn_s_waitcnt(0);
        unsigned nloc = b.st[0], nx = b.st[1];
        if (nloc == 0u) { xcd_barrier_complete(bar, b.x, nloc, nx); b.st[0] = nloc; b.st[1] = nx; }
        const unsigned old = xb_add(&bar[XB_XSUB(b.x)], 1u);
        const unsigned gen = old / nloc;
        if (old + 1u == (gen + 1u) * nloc) {
            __builtin_amdgcn_fence(__ATOMIC_RELEASE, "agent");
            asm volatile("s_waitcnt vmcnt(0)" ::: "memory");
            const unsigned og = xb_add(&bar[XB_TOP], 1u);
            const unsigned tg = og / nx;
            if (og + 1u == (tg + 1u) * nx) xb_add(&bar[XB_TOPGEN], 1u);
            else XB_SPIN(xb_ld(&bar[XB_TOPGEN]) == tg, bar);
            __builtin_amdgcn_fence(__ATOMIC_ACQUIRE, "agent");
            xb_add(&bar[XB_XGEN(b.x)], 1u);
            asm volatile("s_waitcnt vmcnt(0)" ::: "memory");
        } else {
            XB_SPIN(xb_ld(&bar[XB_XGEN(b.x)]) == gen, bar);
            __builtin_amdgcn_fence(__ATOMIC_ACQUIRE, "agent");
            asm volatile("s_waitcnt vmcnt(0)" ::: "memory");
        }
    }
    __syncthreads();
}


constexpr int NWAVES = 8;
constexpr int NPH = 12;
#ifndef MK_N_LAUNCHES
#define MK_N_LAUNCHES 1
#endif
constexpr int N_LAUNCHES = MK_N_LAUNCHES;

constexpr int BATCH = 4, SEQ = 4096, D = 1024, T = BATCH * SEQ;
constexpr int DN_H = 4, DK = 128, CH = 64, NCH = SEQ / CH;
constexpr int SW_H = 8, SW_KV = 2, HD = 64, WIN = 128, NB = SEQ / WIN;
constexpr int IN_COLS = 2824, NPROJ = 3072, PC_AB = 2816;
constexpr int PC_Z = 1536, PC_SQ = 2048, PC_SK = 2560, PC_SV = 2688;
constexpr int NE = 32, TOPK = 4, DFF = 1024;
constexpr int MAXTILES = 288, NPADMAX = MAXTILES * 256;
constexpr float EPS = 1e-6f;
constexpr int DNP_STRIDE = 36928;

constexpr size_t MiB = 1u << 20;
constexpr size_t WS_CTL = 0, CTL_ZERO_BYTES = 1 * MiB;
constexpr size_t WS_MODP = 18 * MiB;
constexpr int KSPLIT = 32; static_assert(KSPLIT == 32, "the adaLN GEMV items hold 1024 / KSPLIT = 32 weight rows in registers");
constexpr size_t WS_MODF = 2 * MiB;
constexpr size_t WS_GB = 3 * MiB;
constexpr size_t WS_WIN = 4 * MiB;
constexpr size_t WS_WOUT = 10 * MiB;
constexpr size_t WS_LSLOT = 12 * MiB;
constexpr size_t WS_LGATE = 14 * MiB;
constexpr size_t WS_LHS = 22 * MiB;
constexpr size_t WS_RSLOT = 16 * MiB;
constexpr size_t WS_RGATE = 17 * MiB;
constexpr size_t WS_H = 32 * MiB;
constexpr size_t WS_PROJ = 64 * MiB;
constexpr size_t WS_MIXED = 300 * MiB;
constexpr size_t WS_RSTAT = 297 * MiB;
constexpr size_t WS_ODN = 184 * MiB;
constexpr size_t WS_DNIMG = 216 * MiB;
constexpr size_t WS_DNUT = 280 * MiB;
constexpr size_t WS_DEC = 296 * MiB;
constexpr int IMG_W = 0, IMG_Q = 17408, IMG_K = 34816, IMG_A = 52224, IMG_U = 60928, IMG_UHALF = 8704, IMG_KS = 136;
constexpr int GI_U = 32768, IMG_BYTES = 65536; constexpr float IMG_SC = 16.f;
constexpr int IMG_LDS = IMG_U + IMG_UHALF;
constexpr size_t WS_WUP = 384 * MiB;
constexpr size_t WS_WDN = 512 * MiB;
constexpr size_t WS_XS = 576 * MiB;
constexpr size_t WS_ACT = 720 * MiB;
constexpr size_t WS_SLOT = 864 * MiB;
constexpr size_t WS_END = 992 * MiB;
static_assert(WS_XS + (size_t)NPADMAX * 1024 * 2 <= WS_ACT && WS_ACT + (size_t)NPADMAX * 1024 * 2 <= WS_SLOT, "xs/act");
constexpr int CW_CNT = 8192;
constexpr int CW_BAR = 4096;
constexpr int CW_SWAQ = 12288;
constexpr int CW_FLAG = 16384;
constexpr int CW_TS = 128;
#ifndef PROBE_A
#define PROBE_A -1
#endif
#ifndef PROBE_B
#define PROBE_B -1
#endif
#ifndef PROBE_SCALE
#define PROBE_SCALE 1.0e-6f
#endif

constexpr int WR_STRIDE = 1032;
constexpr int LDS_BYTES = 147456;
constexpr int CTRL_OFF = LDS_BYTES - 4096;
constexpr int SCRATCH_BYTES = CTRL_OFF;

struct Args { const float* in[21]; float* out; unsigned char* ws; int ph_lo, ph_hi, li, pad; };
struct Frame {
    LAS unsigned char* lds;
    volatile LAS unsigned* MISC;
    gu32* ctl;
    int tid, lane, wave, vcu, G;
    __device__ __forceinline__ void refresh() {
        lane = lane_now(); tid = wave * 64 + lane;
        const __attribute__((address_space(4))) Args* ap = (const __attribute__((address_space(4))) Args*)__builtin_amdgcn_kernarg_segment_ptr();
        asm volatile("" : "+s"(ap));
        x = ap->in[0]; c = ap->in[1]; w_ada = ap->in[2]; b_ada = ap->in[3]; norm1_w = ap->in[4]; w_in = ap->in[5]; conv_w = ap->in[6]; a_log = ap->in[7]; dt_bias = ap->in[8];
        dn_norm_w = ap->in[9]; q_norm_w = ap->in[10]; k_norm_w = ap->in[11]; sinks = ap->in[12]; w_out = ap->in[13]; norm2_w = ap->in[14]; w_router = ap->in[15]; b_router = ap->in[16];
        w_up = ap->in[17]; b_up = ap->in[18]; w_down = ap->in[19]; b_down = ap->in[20]; out = ap->out; ws = ap->ws; ctl = (gu32*)(ap->ws + WS_CTL);
    }
    const float *x, *c, *w_ada, *b_ada, *norm1_w, *w_in, *conv_w, *a_log, *dt_bias, *dn_norm_w, *q_norm_w, *k_norm_w, *sinks, *w_out, *norm2_w, *w_router, *b_router, *w_up, *b_up, *w_down, *b_down;
    float* out; unsigned char* ws;
    __device__ __forceinline__ float* modp() const { return (float*)(ws + WS_MODP); }
    __device__ __forceinline__ float* modf() const { return (float*)(ws + WS_MODF); }
    __device__ __forceinline__ bf16* wrimg() const { return (bf16*)(ws + WS_GB + 600 * 1024); }
    __device__ __forceinline__ float* odn() const { return (float*)(ws + WS_ODN); }
    __device__ __forceinline__ float* lgate() const { return (float*)(ws + WS_LGATE); }
    __device__ __forceinline__ float* lhs() const { return (float*)(ws + WS_LHS); }
    __device__ __forceinline__ int* lslot() const { return (int*)(ws + WS_LSLOT); }
    __device__ __forceinline__ unsigned char* dnimg() const { return (unsigned char*)(ws + WS_DNIMG); }
    __device__ __forceinline__ float* rstat() const { return (float*)(ws + WS_RSTAT); }
    __device__ __forceinline__ signed char* Hq() const { return (signed char*)(ws + WS_H); }
    __device__ __forceinline__ signed char* Win8() const { return (signed char*)(ws + WS_WIN); }
    __device__ __forceinline__ float* hscale1() const { return (float*)(ws + WS_GB); }
    __device__ __forceinline__ float* inscale() const { return (float*)(ws + WS_GB + 512 * 1024); }
    __device__ __forceinline__ signed char* H8() const { return (signed char*)(ws + WS_XS); }
    __device__ __forceinline__ signed char* Wup8() const { return (signed char*)(ws + WS_WUP); }
    __device__ __forceinline__ float* upscale() const { return (float*)(ws + WS_RSLOT); }
    __device__ __forceinline__ float* hscale() const { return (float*)(ws + WS_RGATE); }
    __device__ __forceinline__ bf16* Wout_t() const { return (bf16*)(ws + WS_WOUT); }
    __device__ __forceinline__ bf16* Wdn_t() const { return (bf16*)(ws + WS_WDN); }
    __device__ __forceinline__ bf16* PROJ() const { return (bf16*)(ws + WS_PROJ); }
    __device__ __forceinline__ bf16* MIXED() const { return (bf16*)(ws + WS_MIXED); }
    __device__ __forceinline__ bf16* ACT() const { return (bf16*)(ws + WS_ACT); }
    __device__ __forceinline__ bf16* SLOT() const { return (bf16*)(ws + WS_SLOT); }
};

typedef unsigned v2u __attribute__((ext_vector_type(2)));
__device__ __forceinline__ void st_wt8(void* p, unsigned lo, unsigned hi) { __hip_atomic_store((unsigned long long*)p, ((unsigned long long)hi << 32) | lo, __ATOMIC_RELAXED, __HIP_MEMORY_SCOPE_AGENT); }
__device__ __forceinline__ unsigned fp8x4(float a, float b, float c, float d) { unsigned w = __builtin_amdgcn_cvt_pk_fp8_f32(a, b, 0u, false); return __builtin_amdgcn_cvt_pk_fp8_f32(c, d, w, true); }
__device__ __forceinline__ void st_wt4(void* p, unsigned v) { __hip_atomic_store((unsigned*)p, v, __ATOMIC_RELAXED, __HIP_MEMORY_SCOPE_AGENT); }
__device__ __forceinline__ float bf2f(bf16 v) { return __uint_as_float((unsigned)v << 16); }
__device__ __forceinline__ float bflo(unsigned w) { return __uint_as_float(w << 16); }
__device__ __forceinline__ float bfhi(unsigned w) { return __uint_as_float(w & 0xffff0000u); }
__device__ __forceinline__ float wave_sum(float v) {
#pragma unroll
    for (int o = 1; o < 64; o <<= 1) v += __shfl_xor(v, o);
    return v;
}
__device__ __forceinline__ float siluf(float v) { return v / (1.f + __expf(-v)); }

struct DenseOrder {
    int nM, nN, nwg, G, c, tid; size_t tstep;
    __device__ void init(int M, int N, int K, int G_, int c_, int tid_) { nM = M / 256; nN = N / 256; nwg = nM * nN; G = G_; c = c_; tid = tid_; tstep = (size_t)256 * K * 2; }
    __device__ bool next(int i, pg8::Unit& u) const {
        const long L = (long)i * G + c; if (L >= nwg) return false;
        int wgid = (int)L; { const int q = nwg / 8, r = nwg % 8, xcd = wgid % 8, off = wgid / 8; wgid = (xcd < r ? xcd * (q + 1) : r * (q + 1) + (xcd - r) * q) + off; }
        const int nig = 8 * nN, gid = wgid / nig, fm = gid * 8, gsz = (nM - fm) < 8 ? (nM - fm) : 8;
        u.pm = fm + ((wgid % nig) % gsz); u.pn = (wgid % nig) / gsz; u.e = 0; return true;
    }
    __device__ __forceinline__ void a_offsets(const pg8::Unit& u, unsigned (&o0)[2], unsigned (&o1)[2]) const {
#pragma unroll
        for (int i = 0; i < 2; ++i) { int R, C; pg8::stage_rc(tid * 16 + i * 8192, R, C); o0[i] = (unsigned)((size_t)u.pm * tstep) + (unsigned)(R * (int)(tstep / 512) + C) * 2u; o1[i] = o0[i] + (unsigned)(tstep / 2); } }
    __device__ __forceinline__ size_t boff(const pg8::Unit& u) const { return (size_t)u.pn * tstep; }
    __device__ __forceinline__ void a_ready(const pg8::Unit&) const {}
    __device__ __forceinline__ void done(const pg8::Unit&) const {}
};
constexpr int PL_CNT = 0, PL_NT = 32, PL_TS = 64, PL_GN = 96, PL_GE = 104;
struct MoeOrder {
    int nN, lcn, lc, grp, rows_per_e, rowbytes; const LAS int* P; const int* lslot; bool gather; int tid;
    __device__ bool next(int i, pg8::Unit& u) const {
        int uidx = i * lcn + lc; const int n = P[PL_GN + grp];
        for (int k = 0; k < n; ++k) { const int e = P[PL_GE + grp * 16 + k], U = P[PL_NT + e] * nN;
            if (uidx < U) { const int tile = uidx / nN; u.e = __builtin_amdgcn_readfirstlane(e); u.pn = __builtin_amdgcn_readfirstlane(uidx - tile * nN); u.pm = __builtin_amdgcn_readfirstlane(P[PL_TS + e] + tile); u.l0 = __builtin_amdgcn_readfirstlane(tile * 256); return true; }
            uidx -= U; }
        return false;
    }
    __device__ __forceinline__ void a_offsets(const pg8::Unit& u, unsigned (&o0)[2], unsigned (&o1)[2]) const {
        const int cnt = P[PL_CNT + u.e];
#pragma unroll
        for (int i = 0; i < 2; ++i) { int R, C; pg8::stage_rc(tid * 16 + i * 8192, R, C);
            if (gather) { const int l0 = u.l0 + R, l1 = l0 + 128;
                const int t0 = (l0 < cnt) ? (lslot[u.e * T + l0] >> 2) : 0, t1 = (l1 < cnt) ? (lslot[u.e * T + l1] >> 2) : 0;
                o0[i] = (unsigned)t0 * (unsigned)rowbytes + (unsigned)C * 2u; o1[i] = (unsigned)t1 * (unsigned)rowbytes + (unsigned)C * 2u; }
            else { o0[i] = (unsigned)(u.pm * 256 + R) * (unsigned)rowbytes + (unsigned)C * 2u; o1[i] = o0[i] + 128u * (unsigned)rowbytes; } }
    }
    __device__ __forceinline__ size_t boff(const pg8::Unit& u) const { return ((size_t)u.e * rows_per_e + (size_t)u.pn * 256) * (size_t)rowbytes; }
    __device__ __forceinline__ void a_ready(const pg8::Unit&) const {}
    __device__ __forceinline__ void done(const pg8::Unit&) const {}
};

struct EpiProjI8 {
    typedef pg8::MmaI8 Mma; static constexpr bool PERM = true, AFTER_DRAIN = false;
    bf16* O; const float* hs; const float* ws;
    __device__ __forceinline__ void operator()(const pg8::i32x4 (&acc)[2][2][4][2], const pg8::Unit& u, int wr, int wc, int fr, int fq) const {
        const int row0 = u.pm * 256 + wr * 64 + fr, col0 = u.pn * 256 + wc * 32 + 8 * fq;
        float h[2][4]; f32x4 sc[2][2];
#pragma unroll
        for (int bj = 0; bj < 2; ++bj) { sc[bj][0] = *(const f32x4*)(ws + col0 + bj * 128); sc[bj][1] = *(const f32x4*)(ws + col0 + bj * 128 + 4); }
#pragma unroll
        for (int ai = 0; ai < 2; ++ai)
#pragma unroll
            for (int m = 0; m < 4; ++m) h[ai][m] = hs[row0 + ai * 128 + m * 16];
#pragma unroll
        for (int ai = 0; ai < 2; ++ai)
#pragma unroll
            for (int m = 0; m < 4; ++m) { const int row = row0 + ai * 128 + m * 16; bf16* rowp = O + (size_t)row * NPROJ + col0;
#pragma unroll
                for (int bj = 0; bj < 2; ++bj) {
                    const f32x4 c0 = __builtin_convertvector(acc[ai][bj][m][0], f32x4) * h[ai][m] * sc[bj][0], c1 = __builtin_convertvector(acc[ai][bj][m][1], f32x4) * h[ai][m] * sc[bj][1];
                    v4u w; w.x = pk2(c0[0], c0[1]); w.y = pk2(c0[2], c0[3]); w.z = pk2(c1[0], c1[1]); w.w = pk2(c1[2], c1[3]);
                    *(v4u*)(rowp + bj * 128) = w; } }
    }
};
struct EpiX1 {
    typedef pg8::MmaBf16 Mma; static constexpr bool PERM = false, AFTER_DRAIN = false;
    const float* x; float* out; const float* modf; float* rstat;
    __device__ __forceinline__ void operator()(const f32x4 (&acc)[2][2][4][2], const pg8::Unit& u, int wr, int wc, int fr, int fq) const {
        const int row0 = u.pm * 256 + wr * 64 + fr, col0 = u.pn * 256 + wc * 32 + 4 * fq, b = u.pm >> 4;
        f32x4 gv[2][2], av[2][2];
#pragma unroll
        for (int bj = 0; bj < 2; ++bj)
#pragma unroll
            for (int n = 0; n < 2; ++n) { gv[bj][n] = *(const f32x4*)(modf + b * 6144 + 2048 + col0 + bj * 128 + n * 16); av[bj][n] = *(const f32x4*)(modf + 32768 + b * 1024 + col0 + bj * 128 + n * 16); }
        f32x4 xv[2][2][2][2];
#define X1_LOAD(buf, sl, r) do { const size_t off_ = (size_t)(row0 + ((r) >> 2) * 128 + ((r) & 3) * 16) * D + col0; \
            _Pragma("unroll") for (int bj = 0; bj < 2; ++bj) _Pragma("unroll") for (int n = 0; n < 2; ++n) xv[buf][sl][bj][n] = *(const f32x4*)(x + off_ + bj * 128 + n * 16); } while (0)
#define X1_ROW(buf, sl, r) do { const int ai = (r) >> 2, m = (r) & 3, row = row0 + ai * 128 + m * 16; const size_t off = (size_t)row * D + col0; float ss = 0.f, ma = 0.f; \
            _Pragma("unroll") for (int bj = 0; bj < 2; ++bj) _Pragma("unroll") for (int n = 0; n < 2; ++n) { const f32x4 r_ = xv[buf][sl][bj][n] + gv[bj][n] * acc[ai][bj][m][n]; *(f32x4*)(out + off + bj * 128 + n * 16) = r_; \
                ss += (r_.x * r_.x + r_.y * r_.y) + (r_.z * r_.z + r_.w * r_.w); const f32x4 q = r_ * av[bj][n]; \
                ma = fmaxf(fmaxf(ma, fmaxf(fabsf(q.x), fabsf(q.y))), fmaxf(fabsf(q.z), fabsf(q.w))); } \
            ss += __shfl_xor(ss, 16); ss += __shfl_xor(ss, 32); ma = fmaxf(ma, __shfl_xor(ma, 16)); ma = fmaxf(ma, __shfl_xor(ma, 32)); \
            if (fq == 0) { float* rp = rstat + ((size_t)row * 16 + u.pn * 4 + wc) * 2; rp[0] = ss; rp[1] = ma; } } while (0)
        X1_LOAD(0, 0, 0); X1_LOAD(1, 0, 1);
        X1_ROW(0, 0, 0); X1_LOAD(0, 0, 2); X1_LOAD(0, 1, 3);
        X1_ROW(1, 0, 1); X1_LOAD(1, 0, 4); X1_LOAD(1, 1, 5);
        X1_ROW(0, 0, 2); X1_ROW(0, 1, 3); X1_LOAD(0, 0, 6); X1_LOAD(0, 1, 7);
        X1_ROW(1, 0, 4); X1_ROW(1, 1, 5);
        X1_ROW(0, 0, 6); X1_ROW(0, 1, 7);
#undef X1_ROW
#undef X1_LOAD
    }
};
struct EpiSwiglu {
    typedef pg8::MmaI8 Mma; static constexpr bool PERM = true, AFTER_DRAIN = false;
    unsigned char* act; const float* b_up; const float* wscale; const float* lhs; const LAS int* P;
    __device__ __forceinline__ void operator()(const pg8::i32x4 (&acc)[2][2][4][2], const pg8::Unit& u, int wr, int wc, int fr, int fq) const {
        const int row0 = u.pm * 256 + wr * 64 + fr, colw = u.pn * 128 + wc * 32 + 8 * fq, l00 = u.l0 + wr * 64 + fr, cnt = P[PL_CNT + u.e];
        const float* bg = b_up + (size_t)u.e * 2048 + colw; const float* bl = bg + 1024;
        const float* sg = wscale + (size_t)u.e * 2048 + u.pn * 256 + wc * 32 + 8 * fq; const float* sl = sg + 128;
        float hsv[2][4];
#pragma unroll
        for (int ai = 0; ai < 2; ++ai)
#pragma unroll
            for (int m = 0; m < 4; ++m) hsv[ai][m] = lhs[u.e * T + l00 + ai * 128 + m * 16];
        f32x4 bgv[2], blv[2], sgv[2], slv[2];
#pragma unroll
        for (int n = 0; n < 2; ++n) { bgv[n] = *(const f32x4*)(bg + 4 * n); blv[n] = *(const f32x4*)(bl + 4 * n); sgv[n] = *(const f32x4*)(sg + 4 * n); slv[n] = *(const f32x4*)(sl + 4 * n); }
#pragma unroll
        for (int ai = 0; ai < 2; ++ai)
#pragma unroll
            for (int m = 0; m < 4; ++m) { const int l = l00 + ai * 128 + m * 16; const float hs = (l < cnt) ? hsv[ai][m] : 0.f;
                float r[8];
#pragma unroll
                for (int n = 0; n < 2; ++n) {
#pragma unroll
                    for (int i = 0; i < 4; ++i) { const float g0 = (float)acc[ai][0][m][n][i] * hs * sgv[n][i] + bgv[n][i], l0 = (float)acc[ai][1][m][n][i] * hs * slv[n][i] + blv[n][i];
                        const float g = fminf(g0, 7.0f), l1 = fminf(fmaxf(l0, -7.0f), 7.0f);
                        r[4 * n + i] = g * __builtin_amdgcn_rcpf(1.f + __builtin_amdgcn_exp2f(g * (-1.702f * 1.44269504f))) * (l1 + 1.f); } }
                unsigned w0 = __builtin_amdgcn_cvt_pk_fp8_f32(r[0], r[1], 0u, false); w0 = __builtin_amdgcn_cvt_pk_fp8_f32(r[2], r[3], w0, true);
                unsigned w1 = __builtin_amdgcn_cvt_pk_fp8_f32(r[4], r[5], 0u, false); w1 = __builtin_amdgcn_cvt_pk_fp8_f32(r[6], r[7], w1, true);
                *(v2u*)(act + (size_t)(row0 + ai * 128 + m * 16) * DFF + colw) = (v2u){w0, w1}; }
    }
};
struct EpiDown {
    typedef pg8::MmaFp8 Mma; static constexpr bool PERM = true, AFTER_DRAIN = false;
    unsigned char* slot; const int* lslot; const float* lgate; const float* b_down; const LAS int* P;
    __device__ __forceinline__ void operator()(const f32x4 (&acc)[2][2][4][2], const pg8::Unit& u, int wr, int wc, int fr, int fq) const {
        const int l00 = u.l0 + wr * 64 + fr, col0 = u.pn * 256 + wc * 32 + 8 * fq, cnt = P[PL_CNT + u.e];
        const float* bb = b_down + (size_t)u.e * 1024 + col0;
        f32x4 bv[2][2];
#pragma unroll
        for (int bj = 0; bj < 2; ++bj)
#pragma unroll
            for (int n = 0; n < 2; ++n) bv[bj][n] = *(const f32x4*)(bb + bj * 128 + 4 * n);
        int sx[2][4]; float gx[2][4];
#pragma unroll
        for (int ai = 0; ai < 2; ++ai)
#pragma unroll
            for (int m = 0; m < 4; ++m) { const int l = l00 + ai * 128 + m * 16; sx[ai][m] = lslot[u.e * T + l]; gx[ai][m] = lgate[u.e * T + l]; }
#pragma unroll
        for (int ai = 0; ai < 2; ++ai)
#pragma unroll
            for (int m = 0; m < 4; ++m) { const int l = l00 + ai * 128 + m * 16;
                if (l < cnt) { const int sidx = sx[ai][m]; const float gt = gx[ai][m];
#pragma unroll
                    for (int bj = 0; bj < 2; ++bj) { const f32x4 v0 = (acc[ai][bj][m][0] * (1.f / 64.f) + bv[bj][0]) * (gt * 16.f), v1 = (acc[ai][bj][m][1] * (1.f / 64.f) + bv[bj][1]) * (gt * 16.f);
                        unsigned w0 = __builtin_amdgcn_cvt_pk_fp8_f32(v0[0], v0[1], 0u, false); w0 = __builtin_amdgcn_cvt_pk_fp8_f32(v0[2], v0[3], w0, true);
                        unsigned w1 = __builtin_amdgcn_cvt_pk_fp8_f32(v1[0], v1[1], 0u, false); w1 = __builtin_amdgcn_cvt_pk_fp8_f32(v1[2], v1[3], w1, true);
                        *(v2u*)(slot + (size_t)sidx * 1024 + col0 + bj * 128) = (v2u){w0, w1}; } } }
    }
};

__device__ __forceinline__ void p0_transpose_item(const float* W, int ldw, int K, bf16* WT, int src_col0, int dst_row0, int k0, LAS float* scr, int lane) {
#pragma unroll 8
    for (int i = 0; i < 32; ++i) { const int kk = 2 * i + (lane >> 5); scr[kk * 33 + (lane & 31)] = W[(size_t)(k0 + kk) * ldw + src_col0 + (lane & 31)]; }
    LDS_WAIT(); asm volatile("" ::: "memory");
    const int c = lane & 7;
#pragma unroll
    for (int j = 0; j < 4; ++j) { const int n = (lane >> 3) + 8 * j; const LAS float* s = scr + (8 * c) * 33 + n;
        v4u o; o.x = pk2(s[0 * 33], s[1 * 33]); o.y = pk2(s[2 * 33], s[3 * 33]); o.z = pk2(s[4 * 33], s[5 * 33]); o.w = pk2(s[6 * 33], s[7 * 33]);
        *(GAS v4u*)(WT + (size_t)(dst_row0 + n) * K + k0 + 8 * c) = o; }
    LDS_WAIT(); asm volatile("" ::: "memory");
}
__device__ __forceinline__ void p0_prologue(Frame& F) {
    LAS float* scr = (LAS float*)(F.lds + F.wave * 14336);
    if ((int)blockIdx.x < 48 && F.G > 96) return;
    const int first = (F.G > 96) ? 48 : 0, gw = ((int)blockIdx.x - first) * NWAVES + F.wave, NGW = (F.G - first) * NWAVES;
    for (int e = (int)blockIdx.x - first; e < 32; e += F.G - first) {
        bf16* img = F.wrimg();
        for (int k = F.tid; k < 1024; k += NWAVES * 64) { const float w = F.w_router[k * 32 + e]; const unsigned hi = pk2(w, 0.f) & 0xffffu; const float rem = w - __uint_as_float(hi << 16);
            img[e * WR_STRIDE + k] = (bf16)hi; img[(32 + e) * WR_STRIDE + k] = (bf16)(pk2(rem, 0.f) & 0xffffu); } }
    LAS float* SCL = (LAS float*)(F.lds + 8 * 16384 - 16384);
    __syncthreads();
    for (int i = F.tid; i < 4096; i += NWAVES * 64) { const int bb = i >> 10, k = i & 1023; SCL[k * 4 + bb] = siluf(F.c[i]); }
    __syncthreads();
    for (int it0 = gw; it0 < 96 * KSPLIT; it0 += 2 * NGW) {
        const int it1 = it0 + NGW; const bool two = it1 < 96 * KSPLIT;
        const int s0 = it0 % 96, q0 = it0 / 96, c0 = s0 * 64 + F.lane, s1 = two ? it1 % 96 : s0, q1 = two ? it1 / 96 : q0, c1 = s1 * 64 + F.lane;
        float w0[32], w1[32];
#pragma unroll
        for (int k = 0; k < 32; ++k) w0[k] = F.w_ada[(size_t)(q0 * 32 + k) * 6144 + c0];
        if (two) {
#pragma unroll
            for (int k = 0; k < 32; ++k) w1[k] = F.w_ada[(size_t)(q1 * 32 + k) * 6144 + c1]; }
        { f32x4 a = (f32x4){0.f, 0.f, 0.f, 0.f};
#pragma unroll
          for (int k = 0; k < 32; ++k) a = a + *(const LAS f32x4*)(SCL + (q0 * 32 + k) * 4) * w0[k];
          float* mp = F.modp() + (size_t)c0 * KSPLIT + q0; mp[0] = a.x; mp[(size_t)6144 * KSPLIT] = a.y; mp[(size_t)2 * 6144 * KSPLIT] = a.z; mp[(size_t)3 * 6144 * KSPLIT] = a.w; }
        if (two) { f32x4 a = (f32x4){0.f, 0.f, 0.f, 0.f};
#pragma unroll
          for (int k = 0; k < 32; ++k) a = a + *(const LAS f32x4*)(SCL + (q1 * 32 + k) * 4) * w1[k];
          float* mp = F.modp() + (size_t)c1 * KSPLIT + q1; mp[0] = a.x; mp[(size_t)6144 * KSPLIT] = a.y; mp[(size_t)2 * 6144 * KSPLIT] = a.z; mp[(size_t)3 * 6144 * KSPLIT] = a.w; }
    }
    __syncthreads();
    constexpr int I_IN = 0, I_OUT = 16 * 32, NITEMS = I_IN + I_OUT;
    for (int it = gw; it < NITEMS; it += NGW) {
        int r = it;
        { const int kb = r / 32, nb = r % 32; p0_transpose_item(F.w_out, D, D, F.Wout_t(), 32 * nb, 32 * nb, 64 * kb, scr, F.lane); }
    }
}
__device__ __forceinline__ void transpose64_item(const float* W, int ldw, int K, bf16* WT, int src_col0, int dst_row0, int k0, LAS float* scr, int lane) {
    const int r4 = lane >> 4, cg = lane & 15;
    f32x4 v[16];
#pragma unroll
    for (int i = 0; i < 16; ++i) v[i] = *(const GAS f32x4*)(W + (size_t)(k0 + 4 * i + r4) * ldw + src_col0 + 4 * cg);
#pragma unroll
    for (int i = 0; i < 16; ++i) { LAS float* p = scr + (4 * i + r4) * 65 + 4 * cg; p[0] = v[i].x; p[1] = v[i].y; p[2] = v[i].z; p[3] = v[i].w; }
    LDS_WAIT(); asm volatile("" ::: "memory");
    const int c = lane & 7;
#pragma unroll
    for (int j = 0; j < 8; ++j) { const int n = (lane >> 3) + 8 * j; const LAS float* sp = scr + (8 * c) * 65 + n;
        v4u o; o.x = pk2(sp[0 * 65], sp[1 * 65]); o.y = pk2(sp[2 * 65], sp[3 * 65]); o.z = pk2(sp[4 * 65], sp[5 * 65]); o.w = pk2(sp[6 * 65], sp[7 * 65]);
        *(GAS v4u*)(WT + (size_t)(dst_row0 + n) * K + k0 + 8 * c) = o; }
    LDS_WAIT(); asm volatile("" ::: "memory");
}
__device__ __forceinline__ void quant_strip(Frame& F, const float* W, const int ldw, signed char* out8, float* sout) {
    const int lane = F.lane, r4 = lane >> 4, cg = lane & 15;
    LAS float* scr = (LAS float*)(F.lds + F.wave * 16640); LAS float* cmax = (LAS float*)(F.lds + 8 * 16640); LAS float* scl = cmax + 512;
    __syncthreads();
    f32x4 v[2][16];
#pragma unroll
    for (int tt = 0; tt < 2; ++tt) { const int k0 = 64 * (F.wave + 8 * tt);
#pragma unroll
        for (int i = 0; i < 16; ++i) v[tt][i] = *(const GAS f32x4*)(W + (size_t)(k0 + 4 * i + r4) * ldw + 4 * cg); }
    float m0 = 0.f, m1 = 0.f, m2 = 0.f, m3 = 0.f;
#pragma unroll
    for (int tt = 0; tt < 2; ++tt)
#pragma unroll
        for (int i = 0; i < 16; ++i) { m0 = fmaxf(m0, fabsf(v[tt][i].x)); m1 = fmaxf(m1, fabsf(v[tt][i].y)); m2 = fmaxf(m2, fabsf(v[tt][i].z)); m3 = fmaxf(m3, fabsf(v[tt][i].w)); }
    m0 = fmaxf(m0, __shfl_xor(m0, 16)); m0 = fmaxf(m0, __shfl_xor(m0, 32)); m1 = fmaxf(m1, __shfl_xor(m1, 16)); m1 = fmaxf(m1, __shfl_xor(m1, 32));
    m2 = fmaxf(m2, __shfl_xor(m2, 16)); m2 = fmaxf(m2, __shfl_xor(m2, 32)); m3 = fmaxf(m3, __shfl_xor(m3, 16)); m3 = fmaxf(m3, __shfl_xor(m3, 32));
    if (r4 == 0) { LAS float* cm = cmax + F.wave * 64 + 4 * cg; cm[0] = m0; cm[1] = m1; cm[2] = m2; cm[3] = m3; }
    __syncthreads();
    if (F.tid < 64) { float m = 1e-30f;
#pragma unroll
        for (int w = 0; w < 8; ++w) m = fmaxf(m, cmax[w * 64 + F.tid]);
        scl[F.tid] = 127.f / m; sout[F.tid] = m * (1.f / 127.f); }
    __syncthreads();
#pragma unroll
    for (int tt = 0; tt < 2; ++tt) { const int k0 = 64 * (F.wave + 8 * tt);
#pragma unroll
        for (int i = 0; i < 16; ++i) { LAS float* p = scr + (4 * i + r4) * 65 + 4 * cg; p[0] = v[tt][i].x; p[1] = v[tt][i].y; p[2] = v[tt][i].z; p[3] = v[tt][i].w; }
        LDS_WAIT(); asm volatile("" ::: "memory");
        const int c = lane & 7;
#pragma unroll
        for (int jj = 0; jj < 8; ++jj) { const int n = (lane >> 3) + 8 * jj; const LAS float* sp = scr + (8 * c) * 65 + n; const float q = scl[n];
            const int q0 = (int)rintf(sp[0 * 65] * q), q1 = (int)rintf(sp[1 * 65] * q), q2 = (int)rintf(sp[2 * 65] * q), q3 = (int)rintf(sp[3 * 65] * q), q4 = (int)rintf(sp[4 * 65] * q), q5 = (int)rintf(sp[5 * 65] * q), q6 = (int)rintf(sp[6 * 65] * q), q7 = (int)rintf(sp[7 * 65] * q);
            const unsigned lo = (unsigned)(q0 & 255) | ((unsigned)(q1 & 255) << 8) | ((unsigned)(q2 & 255) << 16) | ((unsigned)(q3 & 255) << 24);
            const unsigned hi = (unsigned)(q4 & 255) | ((unsigned)(q5 & 255) << 8) | ((unsigned)(q6 & 255) << 16) | ((unsigned)(q7 & 255) << 24);
            *(GAS v2u*)(out8 + (size_t)n * 1024 + k0 + 8 * c) = (v2u){lo, hi}; }
        LDS_WAIT(); asm volatile("" ::: "memory"); }
}
__device__ __forceinline__ void quant_up_item(Frame& F, int it) {
    const int e = it >> 5, strip = it & 31, dr = 64 * strip, pn = dr >> 8, bj = (dr >> 7) & 1, j = dr & 127;
    quant_strip(F, F.w_up + (size_t)e * 1024 * 2048 + bj * 1024 + pn * 128 + j, 2048, F.Wup8() + ((size_t)e * 2048 + dr) * 1024, F.upscale() + (size_t)e * 2048 + dr);
}
__device__ __forceinline__ void quant_up_pipe(Frame& F, int first) {
    const int lane = F.lane, r4 = lane >> 4, cg = lane & 15, step = F.G - first; const unsigned voff = (unsigned)(r4 * 8192 + 16 * cg);
    LAS float* scr = (LAS float*)(F.lds + F.wave * 16640); LAS float* cmax = (LAS float*)(F.lds + 8 * 16640); LAS float* scl = cmax + 512;
    int it = (int)blockIdx.x - first;
    if (it >= 32 * 32) return;
    __syncthreads();
    f32x4 v[2][16];
    const float* W; { const int e = it >> 5, dr = 64 * (it & 31); W = F.w_up + (size_t)e * 1024 * 2048 + ((dr >> 7) & 1) * 1024 + (dr >> 8) * 128 + (dr & 127); }
#pragma unroll
    for (int tt = 0; tt < 2; ++tt) { const int k0 = 64 * (F.wave + 8 * tt);
#pragma unroll
        for (int i = 0; i < 16; ++i) v[tt][i] = *(const GAS f32x4*)((const GAS char*)(W + (size_t)(k0 + 4 * i) * 2048) + voff); }
    for (;;) {
        const int e = it >> 5, dr = 64 * (it & 31), nit = it + step; const bool more = nit < 32 * 32;
        signed char* out8 = F.Wup8() + ((size_t)e * 2048 + dr) * 1024; float* sout = F.upscale() + (size_t)e * 2048 + dr;
        { const int en = nit >> 5, drn = 64 * (nit & 31); W = F.w_up + (size_t)en * 1024 * 2048 + ((drn >> 7) & 1) * 1024 + (drn >> 8) * 128 + (drn & 127); }
        float m0 = 0.f, m1 = 0.f, m2 = 0.f, m3 = 0.f;
#pragma unroll
        for (int tt = 0; tt < 2; ++tt)
#pragma unroll
            for (int i = 0; i < 16; ++i) { m0 = fmaxf(m0, fabsf(v[tt][i].x)); m1 = fmaxf(m1, fabsf(v[tt][i].y)); m2 = fmaxf(m2, fabsf(v[tt][i].z)); m3 = fmaxf(m3, fabsf(v[tt][i].w)); }
        m0 = fmaxf(m0, __shfl_xor(m0, 16)); m0 = fmaxf(m0, __shfl_xor(m0, 32)); m1 = fmaxf(m1, __shfl_xor(m1, 16)); m1 = fmaxf(m1, __shfl_xor(m1, 32));
        m2 = fmaxf(m2, __shfl_xor(m2, 16)); m2 = fmaxf(m2, __shfl_xor(m2, 32)); m3 = fmaxf(m3, __shfl_xor(m3, 16)); m3 = fmaxf(m3, __shfl_xor(m3, 32));
        if (r4 == 0) { LAS float* cm = cmax + F.wave * 64 + 4 * cg; cm[0] = m0; cm[1] = m1; cm[2] = m2; cm[3] = m3; }
        __syncthreads();
        if (F.tid < 64) { float m = 1e-30f;
#pragma unroll
            for (int w = 0; w < 8; ++w) m = fmaxf(m, cmax[w * 64 + F.tid]);
            scl[F.tid] = 127.f / m; sout[F.tid] = m * (1.f / 127.f); }
        __syncthreads();
#pragma unroll
        for (int tt = 0; tt < 2; ++tt) { const int k0 = 64 * (F.wave + 8 * tt);
#pragma unroll
            for (int i = 0; i < 16; ++i) { LAS float* p = scr + (4 * i + r4) * 65 + 4 * cg; p[0] = v[tt][i].x; p[1] = v[tt][i].y; p[2] = v[tt][i].z; p[3] = v[tt][i].w; }
            LDS_WAIT(); asm volatile("" ::: "memory");
            if (more) {
#pragma unroll
                for (int i = 0; i < 16; ++i) v[tt][i] = *(const GAS f32x4*)((const GAS char*)(W + (size_t)(k0 + 4 * i) * 2048) + voff); }
            const int c = lane & 7;
#pragma unroll
            for (int jj = 0; jj < 8; ++jj) { const int n = (lane >> 3) + 8 * jj; const LAS float* sp = scr + (8 * c) * 65 + n; const float q = scl[n];
                const int q0 = (int)rintf(sp[0 * 65] * q), q1 = (int)rintf(sp[1 * 65] * q), q2 = (int)rintf(sp[2 * 65] * q), q3 = (int)rintf(sp[3 * 65] * q), q4 = (int)rintf(sp[4 * 65] * q), q5 = (int)rintf(sp[5 * 65] * q), q6 = (int)rintf(sp[6 * 65] * q), q7 = (int)rintf(sp[7 * 65] * q);
                const unsigned lo = (unsigned)(q0 & 255) | ((unsigned)(q1 & 255) << 8) | ((unsigned)(q2 & 255) << 16) | ((unsigned)(q3 & 255) << 24);
                const unsigned hi = (unsigned)(q4 & 255) | ((unsigned)(q5 & 255) << 8) | ((unsigned)(q6 & 255) << 16) | ((unsigned)(q7 & 255) << 24);
                *(GAS v2u*)(out8 + (size_t)n * 1024 + k0 + 8 * c) = (v2u){lo, hi}; }
            LDS_WAIT(); asm volatile("" ::: "memory"); }
        if (!more) break;
        it = nit;
    }
}
__device__ __forceinline__ void quant_in_item(Frame& F, int strip) {
    const int dr = 64 * strip, sc = dr < 2048 ? dr : (dr < 2816 ? dr + 8 : dr - 2816 + 2048);
    quant_strip(F, F.w_in + sc, IN_COLS, F.Win8() + (size_t)dr * 1024, F.inscale() + dr);
}
__device__ __forceinline__ void transpose64_fp8_item(const float* W, int ldw, unsigned char* WT, int src_col0, int dst_row0, int k0, LAS float* scr, int lane) {
    const int r4 = lane >> 4, cg = lane & 15;
    f32x4 v[16];
#pragma unroll
    for (int i = 0; i < 16; ++i) v[i] = *(const GAS f32x4*)(W + (size_t)(k0 + 4 * i + r4) * ldw + src_col0 + 4 * cg);
#pragma unroll
    for (int i = 0; i < 16; ++i) { LAS float* p = scr + (4 * i + r4) * 65 + 4 * cg; p[0] = v[i].x * 64.f; p[1] = v[i].y * 64.f; p[2] = v[i].z * 64.f; p[3] = v[i].w * 64.f; }
    LDS_WAIT(); asm volatile("" ::: "memory");
    const int c = lane & 7;
#pragma unroll
    for (int j = 0; j < 8; ++j) { const int n = (lane >> 3) + 8 * j; const LAS float* sp = scr + (8 * c) * 65 + n;
        unsigned w0 = __builtin_amdgcn_cvt_pk_fp8_f32(sp[0 * 65], sp[1 * 65], 0u, false); w0 = __builtin_amdgcn_cvt_pk_fp8_f32(sp[2 * 65], sp[3 * 65], w0, true);
        unsigned w1 = __builtin_amdgcn_cvt_pk_fp8_f32(sp[4 * 65], sp[5 * 65], 0u, false); w1 = __builtin_amdgcn_cvt_pk_fp8_f32(sp[6 * 65], sp[7 * 65], w1, true);
        *(GAS v2u*)(WT + (size_t)(dst_row0 + n) * 1024 + k0 + 8 * c) = (v2u){w0, w1}; }
    LDS_WAIT(); asm volatile("" ::: "memory");
}
__device__ __forceinline__ void expert_transposes(Frame& F, int first) {
    quant_up_pipe(F, first);
    __syncthreads();
    LAS float* scr = (LAS float*)(F.lds + F.wave * 16640);
    const int gw = ((int)blockIdx.x - first) * NWAVES + F.wave, NGW = (F.G - first) * NWAVES;
    { const int lane = F.lane, r4 = lane >> 4, cg = lane & 15, c = lane & 7; const unsigned voff = (unsigned)(r4 * 4096 + 16 * cg);
      int r = gw;
      if (r < 32 * 256) {
        f32x4 v[16];
        { const int e = r >> 8, rr = r & 255, kb = rr >> 4, nb = rr & 15; const float* W = F.w_down + (size_t)e * 1024 * 1024 + (size_t)(64 * kb) * 1024 + 64 * nb;
#pragma unroll
          for (int i = 0; i < 16; ++i) v[i] = *(const GAS f32x4*)((const GAS char*)(W + (size_t)(4 * i) * 1024) + voff); }
        for (;;) {
            const int e = r >> 8, rr = r & 255, kb = rr >> 4, nb = rr & 15, rn = r + NGW; const bool more = rn < 32 * 256;
            unsigned char* WT = (unsigned char*)F.Wdn_t() + (size_t)e * 1024 * 1024 + (size_t)(64 * nb) * 1024 + 64 * kb;
#pragma unroll
            for (int i = 0; i < 16; ++i) { LAS float* p = scr + (4 * i + r4) * 65 + 4 * cg; p[0] = v[i].x * 64.f; p[1] = v[i].y * 64.f; p[2] = v[i].z * 64.f; p[3] = v[i].w * 64.f; }
            LDS_WAIT(); asm volatile("" ::: "memory");
            if (more) { const int en = rn >> 8, rrn = rn & 255, kbn = rrn >> 4, nbn = rrn & 15; const float* W = F.w_down + (size_t)en * 1024 * 1024 + (size_t)(64 * kbn) * 1024 + 64 * nbn;
#pragma unroll
                for (int i = 0; i < 16; ++i) v[i] = *(const GAS f32x4*)((const GAS char*)(W + (size_t)(4 * i) * 1024) + voff); }
#pragma unroll
            for (int j = 0; j < 8; ++j) { const int n = (lane >> 3) + 8 * j; const LAS float* sp = scr + (8 * c) * 65 + n;
                unsigned w0 = __builtin_amdgcn_cvt_pk_fp8_f32(sp[0 * 65], sp[1 * 65], 0u, false); w0 = __builtin_amdgcn_cvt_pk_fp8_f32(sp[2 * 65], sp[3 * 65], w0, true);
                unsigned w1 = __builtin_amdgcn_cvt_pk_fp8_f32(sp[4 * 65], sp[5 * 65], 0u, false); w1 = __builtin_amdgcn_cvt_pk_fp8_f32(sp[6 * 65], sp[7 * 65], w1, true);
                *(GAS v2u*)(WT + (size_t)n * 1024 + 8 * c) = (v2u){w0, w1}; }
            LDS_WAIT(); asm volatile("" ::: "memory");
            if (!more) break;
            r = rn;
        } } }
}

__device__ __forceinline__ float mod_sum(Frame& F, int b, int col) {
    const f32x4* p = (const f32x4*)(F.modp() + ((size_t)b * 6144 + col) * KSPLIT); f32x4 a = p[0];
#pragma unroll
    for (int i = 1; i < KSPLIT / 4; ++i) a = a + p[i];
    return F.b_ada[col] + ((a.x + a.y) + (a.z + a.w));
}
__device__ __forceinline__ void mod_tables(Frame& F, LAS float* A, LAS float* Bv, const float* norm_w, int b, int sh_col) {
    for (int k = F.tid; k < 1024; k += NWAVES * 64) { A[k] = norm_w[k] * (1.f + mod_sum(F, b, sh_col + 1024 + k)); Bv[k] = mod_sum(F, b, sh_col + k); }
}
__device__ __forceinline__ void p1_hrows(Frame& F) {
    LAS float* A1 = (LAS float*)F.lds; LAS float* B1 = A1 + 1024;
    f32x4 xv[8][4];
    if ((int)blockIdx.x < 256) {
#pragma unroll
        for (int i = 0; i < 8; ++i) { const GAS f32x4* xr = (const GAS f32x4*)(F.x + (size_t)((int)blockIdx.x * 64 + F.wave + 8 * i) * D) + F.lane;
#pragma unroll
            for (int j = 0; j < 4; ++j) xv[i][j] = xr[64 * j]; } }
    for (int blk = blockIdx.x; blk < 256; blk += F.G) {
        if (F.tid < 96) { const int idx = blk * 96 + F.tid; F.modf()[idx] = mod_sum(F, idx / 6144, idx % 6144); }
        else if (F.tid < 128) { const int idx = blk * 32 + F.tid - 96, b2 = idx >> 11, k = idx & 1023;
            if (((idx >> 10) & 1) == 0) F.modf()[32768 + b2 * 1024 + k] = F.norm2_w[k] * (1.f + mod_sum(F, b2, 4096 + k)); else F.modf()[32768 + 4096 + b2 * 1024 + k] = mod_sum(F, b2, 3072 + k); } }
    for (int rg = blockIdx.x; rg < 256; rg += F.G) {
        const int b = rg >> 6;
        __syncthreads();
        mod_tables(F, A1, B1, F.norm1_w, b, 0);
        __syncthreads();
        if (rg != (int)blockIdx.x) {
#pragma unroll
            for (int i = 0; i < 8; ++i) { const GAS f32x4* xr = (const GAS f32x4*)(F.x + (size_t)(rg * 64 + F.wave + 8 * i) * D) + F.lane;
#pragma unroll
                for (int j = 0; j < 4; ++j) xv[i][j] = xr[64 * j]; } }
#pragma unroll
        for (int ri = 0; ri < 8; ++ri) { const int rr = F.wave + 8 * ri;
            const int t = rg * 64 + rr;
            f32x4 v[4];
#pragma unroll
            for (int j = 0; j < 4; ++j) v[j] = xv[ri][j];
            float ss = 0.f;
#pragma unroll
            for (int j = 0; j < 4; ++j) ss += (v[j].x * v[j].x + v[j].y * v[j].y) + (v[j].z * v[j].z + v[j].w * v[j].w);
            const float rstd = rsqrtf(wave_sum(ss) * (1.f / D) + EPS);
            f32x4 hv[4]; float am = 0.f;
#pragma unroll
            for (int j = 0; j < 4; ++j) { const int k = 4 * F.lane + 256 * j;
                const f32x4 a = *(const LAS f32x4*)(A1 + k), bb = *(const LAS f32x4*)(B1 + k);
                hv[j] = v[j] * rstd * a + bb; am = fmaxf(fmaxf(am, fmaxf(fabsf(hv[j].x), fabsf(hv[j].y))), fmaxf(fabsf(hv[j].z), fabsf(hv[j].w))); }
#pragma unroll
            for (int o = 1; o < 64; o <<= 1) am = fmaxf(am, __shfl_xor(am, o));
            am = fmaxf(am, 1e-30f); const float qs = 127.f / am; if (F.lane == 0) F.hscale1()[t] = am * (1.f / 127.f);
            GAS unsigned* o4 = (GAS unsigned*)(F.Hq() + (size_t)t * D) + F.lane;
#pragma unroll
            for (int j = 0; j < 4; ++j) { const int q0 = (int)rintf(hv[j].x * qs), q1 = (int)rintf(hv[j].y * qs), q2 = (int)rintf(hv[j].z * qs), q3 = (int)rintf(hv[j].w * qs);
                o4[64 * j] = (unsigned)(q0 & 255) | ((unsigned)(q1 & 255) << 8) | ((unsigned)(q2 & 255) << 16) | ((unsigned)(q3 & 255) << 24); }
        }
    }
}

__device__ __forceinline__ bf16x8 lda_frag(const LAS unsigned char* p) {
    const v2u lo = *(const LAS v2u*)p, hi = *(const LAS v2u*)(p + 32);
    const v4u w = (v4u){lo.x, lo.y, hi.x, hi.y}; return __builtin_bit_cast(bf16x8, w);
}
__device__ __forceinline__ bf16x8 pack_frag(const f32x4 a, const f32x4 b) { const v4u w = (v4u){pk2(a.x, a.y), pk2(a.z, a.w), pk2(b.x, b.y), pk2(b.z, b.w)}; return __builtin_bit_cast(bf16x8, w); }
constexpr int PQ_OFF = 0, PK_OFF = 17408, PKT_OFF = 34816, PVT_OFF = 53248, PAF_OFF = 71680, PTF_OFF = 88320, PTU_OFF = 104960, PTW_OFF = 114176, PMF_OFF = 123392, PSC_OFF = 129536;
__device__ __forceinline__ void dn_prep_item(Frame& F, int item, bool loadcw) {
    const int b = item >> 8, n = (item >> 2) & 63, h = item & 3, t0 = b * SEQ + n * CH, tid = F.tid, lane = F.lane, r16 = lane & 15, q4 = lane >> 4, wv = F.wave;
    LAS unsigned char* L = F.lds;
    LAS bf16* Qr = (LAS bf16*)(L + PQ_OFF); LAS bf16* Kr = (LAS bf16*)(L + PK_OFF); LAS bf16* Kt = (LAS bf16*)(L + PKT_OFF); LAS bf16* Vt = (LAS bf16*)(L + PVT_OFF);
    LAS float* Af = (LAS float*)(L + PAF_OFF); LAS float* Tf = (LAS float*)(L + PTF_OFF); LAS bf16* Tu = (LAS bf16*)(L + PTU_OFF); LAS bf16* Tw = (LAS bf16*)(L + PTW_OFF);
    LAS float* Mf = (LAS float*)(L + PMF_OFF); LAS float* gc = (LAS float*)(L + PSC_OFF); LAS float* bt = gc + 64; LAS float* eg = bt + 64; LAS float* e2 = eg + 64;
    unsigned char* img = F.dnimg() + (size_t)item * IMG_BYTES;
    __syncthreads();
    const int g16 = tid >> 4, l16 = tid & 15, cp = g16 >> 3, r8 = 8 * (g16 & 7), chan0 = cp * 512 + h * 128 + 8 * l16;
    v4u cin[11];
    if (g16 < 24) {
#pragma unroll
        for (int jj = 0; jj < 11; ++jj) { const int pos = n * CH + r8 - 3 + jj; cin[jj] = (v4u){0u, 0u, 0u, 0u}; if (pos >= 0) cin[jj] = *(const v4u*)(F.PROJ() + (size_t)(b * SEQ + pos) * NPROJ + chan0); }
    }
    LAS float* CWL = (LAS float*)(L + PSC_OFF + 1024);
    if (loadcw && tid < 384) { const int cpw = tid >> 7, rem = tid & 127, lw = rem >> 3, jw = (rem >> 1) & 3, hw = rem & 1;
        *(LAS f32x4*)(CWL + (cpw * 16 + lw) * 32 + jw * 8 + 4 * hw) = *(const f32x4*)(F.conv_w + jw * 1536 + cpw * 512 + h * 128 + 8 * lw + 4 * hw); }
    if (wv == 0) { const bf16* pab = F.PROJ() + (size_t)(t0 + lane) * NPROJ + PC_AB + h; const float za = bf2f(pab[0]) + F.dt_bias[h], zb = bf2f(pab[4]);
        float g = -__expf(F.a_log[h]) * (fmaxf(za, 0.f) + log1pf(__expf(-fabsf(za))));
#pragma unroll
        for (int o = 1; o < 64; o <<= 1) { const float tt = __shfl_up(g, o); if (lane >= o) g += tt; }
        const float gl = __shfl(g, 63);
        gc[lane] = g; bt[lane] = 1.f / (1.f + __expf(-zb)); eg[lane] = __expf(g); e2[lane] = __expf(gl - g);
        if (lane == 63) { const float dcy = __expf(gl); st_wt4(img + GI_U + 128, __float_as_uint(dcy)); st_wt4(img + GI_U + IMG_UHALF + 128, __float_as_uint(dcy)); } }
    for (int i = tid; i < 64 * 65; i += NWAVES * 64) Tf[i] = 0.f;
    __syncthreads();
    if (g16 < 24) {
#pragma unroll
      for (int rp = 0; rp < 4; ++rp) { const int r0 = r8 + 2 * rp;
        float xin[5][8];
#pragma unroll
        for (int jj = 0; jj < 5; ++jj) { const v4u w = cin[2 * rp + jj];
            xin[jj][0] = bflo(w.x); xin[jj][1] = bfhi(w.x); xin[jj][2] = bflo(w.y); xin[jj][3] = bfhi(w.y); xin[jj][4] = bflo(w.z); xin[jj][5] = bfhi(w.z); xin[jj][6] = bflo(w.w); xin[jj][7] = bfhi(w.w); }
        float y0[8], y1[8];
#pragma unroll
        for (int i = 0; i < 8; ++i) { y0[i] = 0.f; y1[i] = 0.f; }
#pragma unroll
        for (int j = 0; j < 4; ++j) { const f32x4 ca = *(const LAS f32x4*)(CWL + (cp * 16 + l16) * 32 + j * 8), cb = *(const LAS f32x4*)(CWL + (cp * 16 + l16) * 32 + j * 8 + 4); const float cw[8] = {ca.x, ca.y, ca.z, ca.w, cb.x, cb.y, cb.z, cb.w};
#pragma unroll
            for (int i = 0; i < 8; ++i) { y0[i] += cw[i] * xin[j][i]; y1[i] += cw[i] * xin[j + 1][i]; } }
        float s0 = 0.f, s1 = 0.f;
#pragma unroll
        for (int i = 0; i < 8; ++i) { y0[i] = siluf(y0[i]); y1[i] = siluf(y1[i]); s0 += y0[i] * y0[i]; s1 += y1[i] * y1[i]; }
        if (cp < 2) {
            s0 += __shfl_xor(s0, 1); s0 += __shfl_xor(s0, 2); s0 += __shfl_xor(s0, 4); s0 += __shfl_xor(s0, 8);
            s1 += __shfl_xor(s1, 1); s1 += __shfl_xor(s1, 2); s1 += __shfl_xor(s1, 4); s1 += __shfl_xor(s1, 8);
            const float f = (cp == 0) ? 0.08838834764831845f : 1.f, n0 = rsqrtf(s0 + EPS) * f, n1 = rsqrtf(s1 + EPS) * f;
#pragma unroll
            for (int i = 0; i < 8; ++i) { y0[i] *= n0; y1[i] *= n1; }
        }
        const v4u w0 = (v4u){pk2(y0[0], y0[1]), pk2(y0[2], y0[3]), pk2(y0[4], y0[5]), pk2(y0[6], y0[7])}, w1 = (v4u){pk2(y1[0], y1[1]), pk2(y1[2], y1[3]), pk2(y1[4], y1[5]), pk2(y1[6], y1[7])};
        if (cp == 0) { *(LAS v4u*)(Qr + r0 * 136 + 8 * l16) = w0; *(LAS v4u*)(Qr + (r0 + 1) * 136 + 8 * l16) = w1;
            const float g0 = eg[r0] * IMG_SC, g1 = eg[r0 + 1] * IMG_SC;
            unsigned char* q0p = img + IMG_Q / 2 + r0 * 136 + 8 * l16; unsigned char* q1p = q0p + 136;
            st_wt8(q0p, fp8x4(y0[0] * g0, y0[1] * g0, y0[2] * g0, y0[3] * g0), fp8x4(y0[4] * g0, y0[5] * g0, y0[6] * g0, y0[7] * g0));
            st_wt8(q1p, fp8x4(y1[0] * g1, y1[1] * g1, y1[2] * g1, y1[3] * g1), fp8x4(y1[4] * g1, y1[5] * g1, y1[6] * g1, y1[7] * g1)); }
        else if (cp == 1) { *(LAS v4u*)(Kr + r0 * 136 + 8 * l16) = w0; *(LAS v4u*)(Kr + (r0 + 1) * 136 + 8 * l16) = w1;
#pragma unroll
            for (int i = 0; i < 8; ++i) *(LAS unsigned*)(Kt + (8 * l16 + i) * 72 + r0) = pk2(y0[i], y1[i]); }
        else {
#pragma unroll
            for (int i = 0; i < 8; ++i) *(LAS unsigned*)(Vt + (8 * l16 + i) * 72 + r0) = pk2(y0[i], y1[i]); }
        __builtin_amdgcn_sched_barrier(0);
      } }
    __syncthreads();
    { const int dk = tid >> 2, cc = (tid & 3) * 16;
      const v4u ka = *(const LAS v4u*)(Kt + dk * 72 + cc), kb = *(const LAS v4u*)(Kt + dk * 72 + cc + 8);
      const unsigned kw[8] = {ka.x, ka.y, ka.z, ka.w, kb.x, kb.y, kb.z, kb.w};
      float kf[16];
#pragma unroll
      for (int i = 0; i < 8; ++i) { kf[2 * i] = bflo(kw[i]) * e2[cc + 2 * i] * IMG_SC; kf[2 * i + 1] = bfhi(kw[i]) * e2[cc + 2 * i + 1] * IMG_SC; }
      unsigned char* kp = img + IMG_K / 2 + dk * (IMG_KS / 2) + cc;
#pragma unroll
      for (int i = 0; i < 4; ++i) st_wt4(kp + 4 * i, fp8x4(kf[4 * i], kf[4 * i + 1], kf[4 * i + 2], kf[4 * i + 3])); }
    { const int mt = wv >> 1;
      bf16x8 ak[4];
#pragma unroll
      for (int ks = 0; ks < 4; ++ks) ak[ks] = *(const LAS bf16x8*)(Kr + (16 * mt + r16) * 136 + 32 * ks + 8 * q4);
#pragma unroll
      for (int u = 0; u < 2; ++u) { const int nt = 2 * (wv & 1) + u;
        f32x4 akk = (f32x4){0.f, 0.f, 0.f, 0.f}, aqk = (f32x4){0.f, 0.f, 0.f, 0.f};
#pragma unroll
        for (int ks = 0; ks < 4; ++ks) { const bf16x8 bk = *(const LAS bf16x8*)(Kr + (16 * nt + r16) * 136 + 32 * ks + 8 * q4), bq = *(const LAS bf16x8*)(Qr + (16 * nt + r16) * 136 + 32 * ks + 8 * q4);
            akk = __builtin_amdgcn_mfma_f32_16x16x32_bf16(ak[ks], bk, akk, 0, 0, 0); aqk = __builtin_amdgcn_mfma_f32_16x16x32_bf16(ak[ks], bq, aqk, 0, 0, 0); }
        const int col = 16 * nt + r16; const float gcol = gc[col]; float o[4];
#pragma unroll
        for (int i = 0; i < 4; ++i) { const int row = 16 * mt + 4 * q4 + i; const float grow = gc[row];
            Af[row * 65 + col] = (col < row) ? bt[row] * akk[i] * __expf(grow - gcol) : 0.f;
            o[i] = (row <= col) ? aqk[i] * __expf(gcol - grow) : 0.f; }
        st_wt4(img + IMG_A / 2 + col * (IMG_KS / 2) + 16 * mt + 4 * q4, fp8x4(o[0] * IMG_SC, o[1] * IMG_SC, o[2] * IMG_SC, o[3] * IMG_SC)); } }
    __syncthreads();
    if (tid < 64) { const int blk = tid >> 4, c = tid & 15; float x[16];
#pragma unroll
        for (int i = 0; i < 16; ++i) { float r = (i == c) ? 1.f : 0.f;
#pragma unroll
            for (int j = 0; j < i; ++j) r -= Af[(16 * blk + i) * 65 + 16 * blk + j] * x[j];
            x[i] = r; }
#pragma unroll
        for (int i = 0; i < 16; ++i) Tf[(16 * blk + i) * 65 + 16 * blk + c] = x[i]; }
    __syncthreads();
    if (wv < 2) { const int lo = 32 * wv; f32x4 m = (f32x4){0.f, 0.f, 0.f, 0.f};
#pragma unroll
      for (int ks = 0; ks < 4; ++ks) m = __builtin_amdgcn_mfma_f32_16x16x4f32(Af[(lo + 16 + r16) * 65 + lo + 4 * ks + q4], Tf[(lo + 4 * ks + q4) * 65 + lo + r16], m, 0, 0, 0);
#pragma unroll
      for (int i = 0; i < 4; ++i) Mf[wv * 272 + (4 * q4 + i) * 17 + r16] = m[i];
      LDS_WAIT(); asm volatile("" ::: "memory");
      f32x4 x = (f32x4){0.f, 0.f, 0.f, 0.f};
#pragma unroll
      for (int ks = 0; ks < 4; ++ks) x = __builtin_amdgcn_mfma_f32_16x16x4f32(Tf[(lo + 16 + r16) * 65 + lo + 16 + 4 * ks + q4], Mf[wv * 272 + (4 * ks + q4) * 17 + r16], x, 0, 0, 0);
#pragma unroll
      for (int i = 0; i < 4; ++i) Tf[(lo + 16 + 4 * q4 + i) * 65 + lo + r16] = -x[i]; }
    __syncthreads();
    { const int ti = (wv >> 1) & 1, tj = wv & 1; f32x4 m = (f32x4){0.f, 0.f, 0.f, 0.f};
      if (wv < 4) {
#pragma unroll
        for (int ks = 0; ks < 8; ++ks) m = __builtin_amdgcn_mfma_f32_16x16x4f32(Af[(32 + 16 * ti + r16) * 65 + 4 * ks + q4], Tf[(4 * ks + q4) * 65 + 16 * tj + r16], m, 0, 0, 0);
#pragma unroll
        for (int i = 0; i < 4; ++i) Mf[544 + (16 * ti + 4 * q4 + i) * 33 + 16 * tj + r16] = m[i]; }
      __syncthreads();
      if (wv < 4) { f32x4 x = (f32x4){0.f, 0.f, 0.f, 0.f};
#pragma unroll
        for (int ks = 0; ks < 8; ++ks) x = __builtin_amdgcn_mfma_f32_16x16x4f32(Tf[(32 + 16 * ti + r16) * 65 + 32 + 4 * ks + q4], Mf[544 + (4 * ks + q4) * 33 + 16 * tj + r16], x, 0, 0, 0);
#pragma unroll
        for (int i = 0; i < 4; ++i) Tf[(32 + 16 * ti + 4 * q4 + i) * 65 + 16 * tj + r16] = -x[i]; } }
    __syncthreads();
    for (int idx = tid; idx < 4096; idx += NWAVES * 64) { const int i = idx >> 6, c = idx & 63; const float tv = Tf[i * 65 + c] * bt[c];
        Tu[i * 72 + c] = (bf16)f2bf(tv); Tw[i * 72 + c] = (bf16)f2bf(tv * eg[c]); }
    __syncthreads();
    { bf16x8 bv[2], akt[2];
#pragma unroll
      for (int ks = 0; ks < 2; ++ks) { bv[ks] = *(const LAS bf16x8*)(Vt + (16 * wv + r16) * 72 + 32 * ks + 8 * q4); akt[ks] = *(const LAS bf16x8*)(Kt + (16 * wv + r16) * 72 + 32 * ks + 8 * q4); }
#pragma unroll
      for (int t4 = 0; t4 < 4; ++t4) {
        f32x4 au = (f32x4){0.f, 0.f, 0.f, 0.f}, aw = (f32x4){0.f, 0.f, 0.f, 0.f};
#pragma unroll
        for (int ks = 0; ks < 2; ++ks) { const bf16x8 tu = *(const LAS bf16x8*)(Tu + (16 * t4 + r16) * 72 + 32 * ks + 8 * q4), tw = *(const LAS bf16x8*)(Tw + (16 * t4 + r16) * 72 + 32 * ks + 8 * q4);
            au = __builtin_amdgcn_mfma_f32_16x16x32_bf16(tu, bv[ks], au, 0, 0, 0);
            aw = __builtin_amdgcn_mfma_f32_16x16x32_bf16(akt[ks], tw, aw, 0, 0, 0); }
        st_wt8(img + GI_U + (16 * wv + r16) * 136 + (16 * t4 + 4 * q4) * 2, pk2(au[0], au[1]), pk2(au[2], au[3]));
        st_wt4(img + IMG_W / 2 + (16 * t4 + r16) * 136 + 16 * wv + 4 * q4, fp8x4(aw[0] * IMG_SC, aw[1] * IMG_SC, aw[2] * IMG_SC, aw[3] * IMG_SC)); } }
    asm volatile("s_waitcnt vmcnt(0)" ::: "memory");
    __syncthreads();
    if (tid == 0) __hip_atomic_store(F.ctl + CW_FLAG + item, 1u, RLX_AGENT);
}
constexpr int SWK_STRIDE = 72, SWV_STRIDE = 264;
__device__ __forceinline__ void swa_item(Frame& F, int item) {
    const int b = item >> 6, nb = (item >> 1) & 31, kvh = item & 1, tid = F.tid, lane = F.lane, r16 = lane & 15, q4 = lane >> 4;
    LAS bf16* Ks = (LAS bf16*)F.lds; LAS bf16* Vt = Ks + 256 * SWK_STRIDE;
    const int g = F.wave & 3, qh = F.wave >> 2, hq = kvh * 4 + g;
    __syncthreads();
    v4u qa[4], qc[4];
#pragma unroll
    for (int m = 0; m < 4; ++m) { const bf16* qp = F.PROJ() + (size_t)(b * SEQ + nb * WIN + 64 * qh + 16 * m + r16) * NPROJ + PC_SQ + hq * 64 + 8 * q4; qa[m] = *(const v4u*)qp; qc[m] = *(const v4u*)(qp + 32); }
    const f32x4 qw0 = *(const f32x4*)(F.q_norm_w + 8 * q4), qw1 = *(const f32x4*)(F.q_norm_w + 8 * q4 + 4), qw2 = *(const f32x4*)(F.q_norm_w + 32 + 8 * q4), qw3 = *(const f32x4*)(F.q_norm_w + 32 + 8 * q4 + 4);
    const float sinkv = F.sinks[hq];
    {
        const int slot = tid >> 1, half = tid & 1, pos = nb * WIN - WIN + slot;
        float kv[32], vv[32]; float ss = 0.f;
        if (pos >= 0) {
            const v4u* kp = (const v4u*)(F.PROJ() + (size_t)(b * SEQ + pos) * NPROJ + PC_SK + kvh * 64 + half * 32);
            const v4u* vp = (const v4u*)(F.PROJ() + (size_t)(b * SEQ + pos) * NPROJ + PC_SV + kvh * 64 + half * 32);
#pragma unroll
            for (int i = 0; i < 4; ++i) { const v4u a = kp[i], c = vp[i];
                kv[8 * i + 0] = bflo(a.x); kv[8 * i + 1] = bfhi(a.x); kv[8 * i + 2] = bflo(a.y); kv[8 * i + 3] = bfhi(a.y); kv[8 * i + 4] = bflo(a.z); kv[8 * i + 5] = bfhi(a.z); kv[8 * i + 6] = bflo(a.w); kv[8 * i + 7] = bfhi(a.w);
                vv[8 * i + 0] = bflo(c.x); vv[8 * i + 1] = bfhi(c.x); vv[8 * i + 2] = bflo(c.y); vv[8 * i + 3] = bfhi(c.y); vv[8 * i + 4] = bflo(c.z); vv[8 * i + 5] = bfhi(c.z); vv[8 * i + 6] = bflo(c.w); vv[8 * i + 7] = bfhi(c.w); }
        } else {
#pragma unroll
            for (int i = 0; i < 32; ++i) { kv[i] = 0.f; vv[i] = 0.f; }
        }
#pragma unroll
        for (int i = 0; i < 32; ++i) ss += kv[i] * kv[i];
        ss += __shfl_xor(ss, 1);
        const float rs = rsqrtf(ss * (1.f / 64.f) + EPS);
#pragma unroll
        for (int i = 0; i < 4; ++i) { const f32x4 w0 = *(const f32x4*)(F.k_norm_w + half * 32 + 8 * i), w1 = *(const f32x4*)(F.k_norm_w + half * 32 + 8 * i + 4);
            *(LAS v4u*)(Ks + slot * SWK_STRIDE + half * 32 + 8 * i) = (v4u){pk2(kv[8 * i] * rs * w0.x, kv[8 * i + 1] * rs * w0.y), pk2(kv[8 * i + 2] * rs * w0.z, kv[8 * i + 3] * rs * w0.w),
                                                                             pk2(kv[8 * i + 4] * rs * w1.x, kv[8 * i + 5] * rs * w1.y), pk2(kv[8 * i + 6] * rs * w1.z, kv[8 * i + 7] * rs * w1.w)}; }
#pragma unroll
        for (int i = 0; i < 32; ++i) Vt[(half * 32 + i) * SWV_STRIDE + slot] = (bf16)f2bf(vv[i]);
    }
    __syncthreads();
    const float LOG2E = 1.4426950408889634f;
    const float slope2 = exp2f(-(float)(hq + 1)) * LOG2E, sink2 = sinkv * LOG2E;
#pragma nounroll
    for (int m = 0; m < 4; ++m) {
        const int i0 = 64 * qh + 16 * m, iq = i0 + r16, t = nb * WIN + iq;
        bf16x8 qf[2];
        {
            const v4u a = qa[0], c = qc[0];
            qa[0] = qa[1]; qa[1] = qa[2]; qa[2] = qa[3]; qc[0] = qc[1]; qc[1] = qc[2]; qc[2] = qc[3];
            float x[16] = {bflo(a.x), bfhi(a.x), bflo(a.y), bfhi(a.y), bflo(a.z), bfhi(a.z), bflo(a.w), bfhi(a.w), bflo(c.x), bfhi(c.x), bflo(c.y), bfhi(c.y), bflo(c.z), bfhi(c.z), bflo(c.w), bfhi(c.w)};
            float ss = 0.f;
#pragma unroll
            for (int i = 0; i < 16; ++i) ss += x[i] * x[i];
            ss += __shfl_xor(ss, 16); ss += __shfl_xor(ss, 32);
            const float rs = rsqrtf(ss * (1.f / 64.f) + EPS) * 0.125f * LOG2E;
            const f32x4 w0 = qw0, w1 = qw1, w2 = qw2, w3 = qw3;
            const v4u f0 = (v4u){pk2(x[0] * rs * w0.x, x[1] * rs * w0.y), pk2(x[2] * rs * w0.z, x[3] * rs * w0.w), pk2(x[4] * rs * w1.x, x[5] * rs * w1.y), pk2(x[6] * rs * w1.z, x[7] * rs * w1.w)};
            const v4u f1 = (v4u){pk2(x[8] * rs * w2.x, x[9] * rs * w2.y), pk2(x[10] * rs * w2.z, x[11] * rs * w2.w), pk2(x[12] * rs * w3.x, x[13] * rs * w3.y), pk2(x[14] * rs * w3.z, x[15] * rs * w3.w)};
            qf[0] = __builtin_bit_cast(bf16x8, f0); qf[1] = __builtin_bit_cast(bf16x8, f1);
        }
        const int kt0 = 2 * (2 * qh + (m >> 1));
        f32x4 st[10]; float mx = sink2;
#pragma unroll
        for (int kk = 0; kk < 10; ++kk) {
            const int kt = kt0 + kk;
            f32x4 a4 = (f32x4){0.f, 0.f, 0.f, 0.f};
#pragma unroll
            for (int ks = 0; ks < 2; ++ks) { const bf16x8 kf = *(const LAS bf16x8*)(Ks + (16 * kt + r16) * SWK_STRIDE + 32 * ks + 8 * q4); a4 = __builtin_amdgcn_mfma_f32_16x16x32_bf16(kf, qf[ks], a4, 0, 0, 0); }
#pragma unroll
            for (int i = 0; i < 4; ++i) { const int j = 16 * kt + 4 * q4 + i, dlt = j - iq;
                const bool ok = (dlt >= 1) && (dlt <= 128) && (nb > 0 || j >= 128);
                const float v = ok ? a4[i] - slope2 * (float)(128 - dlt) : -3.0e38f;
                a4[i] = v; mx = fmaxf(mx, v); }
            st[kk] = a4;
        }
        mx = fmaxf(mx, __shfl_xor(mx, 16)); mx = fmaxf(mx, __shfl_xor(mx, 32));
        float sum = 0.f;
#pragma unroll
        for (int kk = 0; kk < 10; ++kk)
#pragma unroll
            for (int i = 0; i < 4; ++i) { const float p = __builtin_amdgcn_exp2f(st[kk][i] - mx); st[kk][i] = p; sum += p; }
        sum += __shfl_xor(sum, 16); sum += __shfl_xor(sum, 32);
        const float inv = 1.f / (sum + __builtin_amdgcn_exp2f(sink2 - mx));
        f32x4 o[4];
#pragma unroll
        for (int dt = 0; dt < 4; ++dt) o[dt] = (f32x4){0.f, 0.f, 0.f, 0.f};
#pragma unroll
        for (int s2 = 0; s2 < 5; ++s2) { const bf16x8 pf = pack_frag(st[2 * s2], st[2 * s2 + 1]);
#pragma unroll
            for (int dt = 0; dt < 4; ++dt) { const bf16x8 vf = lda_frag((const LAS unsigned char*)(Vt + (16 * dt + r16) * SWV_STRIDE + 16 * kt0 + 32 * s2 + 4 * q4)); o[dt] = __builtin_amdgcn_mfma_f32_16x16x32_bf16(vf, pf, o[dt], 0, 0, 0); } }
        bf16* op = F.MIXED() + (size_t)(b * SEQ + t) * D + 512 + hq * 64 + 4 * q4;
#pragma unroll
        for (int dt = 0; dt < 4; ++dt) *(v2u*)(op + 16 * dt) = (v2u){pk2(o[dt][0] * inv, o[dt][1] * inv), pk2(o[dt][2] * inv, o[dt][3] * inv)};
    }
}
constexpr int SCAN_NCW = 4;
__device__ __forceinline__ void scan_step(const int n, const LAS unsigned char* cur, f32x4 (&S)[8], float* op, const int ulo, const int c16, const int q4) {
    bf16x8 sf[4];
#pragma unroll
    for (int s2 = 0; s2 < 4; ++s2) sf[s2] = pack_frag(S[2 * s2], S[2 * s2 + 1]);
    f32x4 Pm[4], Om[4];
#pragma unroll
    for (int mt = 0; mt < 4; ++mt) { Pm[mt] = (f32x4){0.f, 0.f, 0.f, 0.f}; Om[mt] = (f32x4){0.f, 0.f, 0.f, 0.f}; }
#pragma unroll
    for (int mt = 0; mt < 4; ++mt)
#pragma unroll
        for (int s2 = 0; s2 < 4; ++s2) {
            const bf16x8 aw = lda_frag(cur + IMG_W + (16 * mt + c16) * 272 + (32 * s2 + 4 * q4) * 2);
            const bf16x8 aq = lda_frag(cur + IMG_Q + (16 * mt + c16) * 272 + (32 * s2 + 4 * q4) * 2);
            Pm[mt] = __builtin_amdgcn_mfma_f32_16x16x32_bf16(aw, sf[s2], Pm[mt], 0, 0, 0);
            Om[mt] = __builtin_amdgcn_mfma_f32_16x16x32_bf16(aq, sf[s2], Om[mt], 0, 0, 0);
        }
    const float dec = *(const LAS float*)(cur + IMG_U + 128);
    f32x4 Vm[4];
#pragma unroll
    for (int mt = 0; mt < 4; ++mt) { const v2u uc = *(const LAS v2u*)(cur + ulo + 32 * mt); const f32x4 u4 = (f32x4){bflo(uc.x), bfhi(uc.x), bflo(uc.y), bfhi(uc.y)}; Vm[mt] = u4 - Pm[mt] * (1.f / IMG_SC); }
    bf16x8 vf[2], vg[2];
    vf[0] = pack_frag(Vm[0], Vm[1]); vf[1] = pack_frag(Vm[2], Vm[3]);
    vg[0] = pack_frag(Vm[0] * (1.f / IMG_SC), Vm[1] * (1.f / IMG_SC)); vg[1] = pack_frag(Vm[2] * (1.f / IMG_SC), Vm[3] * (1.f / IMG_SC));
#pragma unroll
    for (int mt = 0; mt < 4; ++mt)
#pragma unroll
        for (int s2 = 0; s2 < 2; ++s2) {
            const bf16x8 aa = lda_frag(cur + IMG_A + (16 * mt + c16) * IMG_KS + (32 * s2 + 4 * q4) * 2);
            Om[mt] = __builtin_amdgcn_mfma_f32_16x16x32_bf16(aa, vf[s2], Om[mt], 0, 0, 0);
        }
#pragma unroll
    for (int m8 = 0; m8 < 8; ++m8) { S[m8] = S[m8] * dec;
#pragma unroll
        for (int s2 = 0; s2 < 2; ++s2) {
            const bf16x8 ak = lda_frag(cur + IMG_K + (16 * m8 + c16) * IMG_KS + (32 * s2 + 4 * q4) * 2);
            S[m8] = __builtin_amdgcn_mfma_f32_16x16x32_bf16(ak, vg[s2], S[m8], 0, 0, 0);
        } }
    float* o2 = op + (size_t)n * CH * 512;
#pragma unroll
    for (int mt = 0; mt < 4; ++mt)
#pragma unroll
        for (int i = 0; i < 4; ++i) o2[(size_t)(16 * mt + i) * 512] = Om[mt][i] * (1.f / IMG_SC);
    asm volatile("s_waitcnt lgkmcnt(0)" ::: "memory"); __builtin_amdgcn_s_barrier(); asm volatile("" ::: "memory");
}
constexpr int SC_NP = 11;
#define SC_LD(R, nn) do { const int n_ = ((nn) < NCH) ? (nn) : NCH - 1; const unsigned char* q_ = img + (size_t)n_ * istep; \
    { unsigned sp_ = 0; while (n_ >= ready) { const unsigned long long m_ = __ballot(__hip_atomic_load(flagp + lane * 4, RLX_AGENT) != 0u); ready = (m_ == ~0ull) ? 64 : __builtin_ctzll(~m_); \
        if (n_ >= ready) { __builtin_amdgcn_s_sleep(8); if (++sp_ > (1u << 20)) break; } } } \
    _Pragma("unroll") for (int p_ = 0; p_ < SC_NP; ++p_) { if (p_ < 8) asm volatile("global_load_dwordx4 %0, %1, %2" : "=v"(R[p_]) : "v"(vmain), "s"(q_ + p_ * 4096) : "memory"); \
        else asm volatile("global_load_dwordx4 %0, %1, %2" : "=v"(R[p_]) : "v"(vmain), "s"(q_ + GI_U + upart + (p_ - 8) * 4096) : "memory"); } } while (0)
#define SC_WAITR(R, CNT) asm volatile("s_waitcnt vmcnt(" #CNT ")" : "+v"(R[0]), "+v"(R[1]), "+v"(R[2]), "+v"(R[3]), "+v"(R[4]), "+v"(R[5]), "+v"(R[6]), "+v"(R[7]), "+v"(R[8]), "+v"(R[9]), "+v"(R[10]) :: "memory")
__device__ __forceinline__ void sc_cvt_store(LAS unsigned char* dst, const v4u q) {
    const unsigned qq[4] = {q.x, q.y, q.z, q.w}; unsigned o[8];
#pragma unroll
    for (int j = 0; j < 4; ++j) { const f32x2_t p0 = __builtin_amdgcn_cvt_pk_f32_fp8(qq[j], false), p1 = __builtin_amdgcn_cvt_pk_f32_fp8(qq[j], true); o[2 * j] = pk2(p0[0], p0[1]); o[2 * j + 1] = pk2(p1[0], p1[1]); }
    *(LAS v4u*)dst = (v4u){o[0], o[1], o[2], o[3]}; *(LAS v4u*)(dst + 16) = (v4u){o[4], o[5], o[6], o[7]};
}
#define SC_ST(R, buf) do { LAS unsigned char* b_ = (buf); _Pragma("unroll") for (int p_ = 0; p_ < 8; ++p_) if (p_ < 7 || hl * 16 < IMG_U / 2 - 7 * 4096) sc_cvt_store(b_ + 2 * (p_ * 4096 + hl * 16), R[p_]); \
    _Pragma("unroll") for (int p_ = 8; p_ < SC_NP; ++p_) if (p_ < 10 || hl * 16 < IMG_UHALF - 2 * 4096) *(LAS v4u*)(b_ + IMG_U + (p_ - 8) * 4096 + hl * 16) = R[p_]; \
    asm volatile("s_waitcnt lgkmcnt(0)" ::: "memory"); } while (0)
#define SC_BAR() do { __builtin_amdgcn_s_barrier(); asm volatile("" ::: "memory"); } while (0)
__device__ __forceinline__ void scan_item(Frame& F, int item) {
    static_assert(SCAN_NCW == 4 && 2 * IMG_LDS <= SCRATCH_BYTES && 8 * 4096 >= IMG_U / 2 && 7 * 4096 < IMG_U / 2 && GI_U + 2 * IMG_UHALF + 4096 <= IMG_BYTES, "scan geometry");
    constexpr int NSPLIT = 8 / SCAN_NCW;
    const int bh = item / NSPLIT, part = item % NSPLIT, b = bh >> 2, h = bh & 3, tid = F.tid, lane = F.lane, c16 = lane & 15, q4 = lane >> 4;
    const bool comp = F.wave < SCAN_NCW;
    LAS unsigned char* bufs = F.lds;
    const size_t istep = (size_t)4 * IMG_BYTES;
    const unsigned char* img = F.dnimg() + (size_t)((b * 64) * 4 + h) * IMG_BYTES;
    __syncthreads();
    if (comp) {
        const int dv0 = (part * SCAN_NCW + F.wave) * 16;
        const int ulo = IMG_U + (F.wave * 16 + c16) * 136 + 8 * q4;
        float* op = F.odn() + (size_t)(b * SEQ + 4 * q4) * 512 + h * 128 + dv0 + c16;
        f32x4 S[8];
#pragma unroll
        for (int i = 0; i < 8; ++i) S[i] = (f32x4){0.f, 0.f, 0.f, 0.f};
        SC_BAR();
        for (int n = 0; n < NCH; n += 2) { scan_step(n, bufs, S, op, ulo, c16, q4); scan_step(n + 1, bufs + IMG_LDS, S, op, ulo, c16, q4); }
    } else {
        const int hl = tid - 256;
        gu32* flagp = F.ctl + CW_FLAG + (b * 64) * 4 + h;
        int ready = 0;
        const unsigned vmain = (unsigned)hl * 16u; const int upart = part * IMG_UHALF;
        v4u R0[SC_NP], R1[SC_NP];
        SC_LD(R0, 0); SC_LD(R1, 1);
        SC_WAITR(R0, 11); SC_ST(R0, bufs); SC_LD(R0, 2); SC_BAR();
        for (int n = 0; n < NCH - 2; n += 2) {
            SC_WAITR(R1, 11); SC_ST(R1, bufs + IMG_LDS); SC_LD(R1, n + 3); SC_BAR();
            SC_WAITR(R0, 11); SC_ST(R0, bufs); SC_LD(R0, n + 4); SC_BAR();
        }
        SC_WAITR(R1, 11); SC_ST(R1, bufs + IMG_LDS); SC_LD(R1, NCH + 1); SC_BAR();
        SC_BAR();
        SC_WAITR(R0, 0); SC_WAITR(R1, 0);
    }
}
__device__ __forceinline__ void p34_mix(Frame& F, const XcdBarrier& bar) {
    constexpr int NSCAN = 16 * (8 / SCAN_NCW);
    if (F.G > NSCAN + 32) {
        if ((int)blockIdx.x < NSCAN) {
#ifndef NO_SCAN
            scan_item(F, (int)blockIdx.x);
#endif
        } else { const int np = F.G - NSCAN;
#ifndef NO_PREP
            int lasth = -1;
            for (int k = (int)blockIdx.x - NSCAN; k < 1024; k += np) { const int n = k >> 4, bh = k & 15; dn_prep_item(F, ((bh >> 2) * 64 + n) * 4 + (bh & 3), (bh & 3) != lasth); lasth = bh & 3; }
#endif
#ifndef NO_TR
            __syncthreads(); expert_transposes(F, NSCAN);
#endif
        }
#ifndef NO_SWA
        for (;;) { __syncthreads(); if (F.tid == 0) F.MISC[20] = __hip_atomic_fetch_add(F.ctl + CW_SWAQ, 1u, RLX_AGENT); __syncthreads(); const int it = (int)F.MISC[20]; if (it >= 256) break; swa_item(F, it); }
#endif
    }
}

__device__ __forceinline__ void p5_dnnorm(Frame& F) {
    const int gw = F.vcu * NWAVES + F.wave, NGW = F.G * NWAVES, lane = F.lane, d0 = (lane & 15) * 8;
    for (int t = gw; t < T; t += NGW) {
        const f32x4* op = (const f32x4*)(F.odn() + (size_t)t * 512 + lane * 8);
        const f32x4 a = op[0], c = op[1];
        float ss = (a.x * a.x + a.y * a.y) + (a.z * a.z + a.w * a.w) + (c.x * c.x + c.y * c.y) + (c.z * c.z + c.w * c.w);
        ss += __shfl_xor(ss, 1); ss += __shfl_xor(ss, 2); ss += __shfl_xor(ss, 4); ss += __shfl_xor(ss, 8);
        const float rs = rsqrtf(ss * (1.f / 128.f) + EPS);
        const v4u zz = *(const v4u*)(F.PROJ() + (size_t)t * NPROJ + PC_Z + lane * 8);
        const f32x4 w0 = *(const f32x4*)(F.dn_norm_w + d0), w1 = *(const f32x4*)(F.dn_norm_w + d0 + 4);
        float r[8] = {a.x * rs * w0.x, a.y * rs * w0.y, a.z * rs * w0.z, a.w * rs * w0.w, c.x * rs * w1.x, c.y * rs * w1.y, c.z * rs * w1.z, c.w * rs * w1.w};
        const float z[8] = {bflo(zz.x), bfhi(zz.x), bflo(zz.y), bfhi(zz.y), bflo(zz.z), bfhi(zz.z), bflo(zz.w), bfhi(zz.w)};
#pragma unroll
        for (int i = 0; i < 8; ++i) r[i] *= siluf(z[i]);
        v4u w; w.x = pk2(r[0], r[1]); w.y = pk2(r[2], r[3]); w.z = pk2(r[4], r[5]); w.w = pk2(r[6], r[7]);
        *(v4u*)(F.MIXED() + (size_t)t * D + lane * 8) = w;
    }
}

__device__ __forceinline__ void p7_router(Frame& F) {
    LAS bf16* Wh = (LAS bf16*)F.lds; LAS bf16* Wl = Wh + 32 * WR_STRIDE; LAS float* LG = (LAS float*)(F.lds + 2 * 32 * WR_STRIDE * 2);
    const int lane = F.lane, r16 = lane & 15, q4 = lane >> 4, wq = F.wave & 3, eh = F.wave >> 2;
    __syncthreads();
    { const v4u* src = (const v4u*)F.wrimg(); LAS v4u* dst = (LAS v4u*)Wh;
#pragma unroll 4
      for (int i = F.tid; i < 2 * 32 * WR_STRIDE / 8; i += NWAVES * 64) dst[i] = src[i]; }
    for (int rg = blockIdx.x; rg < 256; rg += F.G) {
        const int b = rg >> 6, t = rg * 64 + wq * 16 + r16;
        const float* m2a = F.modf() + 32768 + b * 1024; const float* m2b = F.modf() + 32768 + 4096 + b * 1024;
        __syncthreads();
        for (int i = F.tid; i < 64 * 33; i += NWAVES * 64) LG[i] = 0.f;
        float mB2;
        { float m = fmaxf(fabsf(m2b[F.tid]), fabsf(m2b[F.tid + 512]));
#pragma unroll
          for (int o = 1; o < 64; o <<= 1) m = fmaxf(m, __shfl_xor(m, o));
          LAS float* red = (LAS float*)(LG + 64 * 33 + 64);
          if (lane == 0) red[F.wave] = m;
          __syncthreads();
          mB2 = fmaxf(fmaxf(fmaxf(red[0], red[1]), fmaxf(red[2], red[3])), fmaxf(fmaxf(red[4], red[5]), fmaxf(red[6], red[7])));
          __syncthreads(); }
        const float* xr = F.out + (size_t)t * D + 8 * q4;
        float ss = 0.f, ma = 0.f;
        { const f32x4* rp = (const f32x4*)(F.rstat() + (size_t)t * 32);
#pragma unroll
          for (int i = 0; i < 8; ++i) { const f32x4 q = rp[i]; ss += q.x + q.z; ma = fmaxf(ma, fmaxf(q.y, q.w)); } }
        const float rstd = rsqrtf(ss * (1.f / D) + EPS);
        const float amax = fmaxf(rstd * ma + mB2, 1e-30f), qs = 127.f / amax;
        if (eh == 0 && q4 == 0) { F.hscale()[t] = amax * (1.f / 127.f); ((LAS float*)(LG + 64 * 33 + 96))[wq * 16 + r16] = amax * (1.f / 127.f); }
        f32x4 acc0 = (f32x4){0.f, 0.f, 0.f, 0.f}, acc1 = acc0;
        const LAS bf16* whp = Wh + r16 * WR_STRIDE + 8 * q4; const LAS bf16* wlp = Wl + r16 * WR_STRIDE + 8 * q4;
        signed char* qrow = F.H8() + (size_t)t * D + 8 * q4;
#pragma unroll 4
        for (int s3 = 0; s3 < 16; ++s3) { const int s2 = 16 * eh + s3;
            const f32x4 a = *(const f32x4*)(xr + 32 * s2), c = *(const f32x4*)(xr + 32 * s2 + 4);
            const f32x4 a0 = *(const f32x4*)(m2a + 32 * s2 + 8 * q4), a1 = *(const f32x4*)(m2a + 32 * s2 + 8 * q4 + 4), b0 = *(const f32x4*)(m2b + 32 * s2 + 8 * q4), b1 = *(const f32x4*)(m2b + 32 * s2 + 8 * q4 + 4);
            const f32x4 h0 = a * rstd * a0 + b0, h1 = c * rstd * a1 + b1;
            float hv[8] = {h0.x, h0.y, h0.z, h0.w, h1.x, h1.y, h1.z, h1.w}; unsigned hw[4], lw[4];
#pragma unroll
            for (int i = 0; i < 4; ++i) { hw[i] = pk2(hv[2 * i], hv[2 * i + 1]); lw[i] = pk2(hv[2 * i] - bflo(hw[i]), hv[2 * i + 1] - bfhi(hw[i])); }
            const v4u xhw = (v4u){hw[0], hw[1], hw[2], hw[3]};
            const v4u xlw = (v4u){lw[0], lw[1], lw[2], lw[3]};
            { int q[8];
#pragma unroll
              for (int i = 0; i < 8; ++i) q[i] = (int)rintf(hv[i] * qs);
              const unsigned lo = (unsigned)(q[0] & 255) | ((unsigned)(q[1] & 255) << 8) | ((unsigned)(q[2] & 255) << 16) | ((unsigned)(q[3] & 255) << 24);
              const unsigned hi = (unsigned)(q[4] & 255) | ((unsigned)(q[5] & 255) << 8) | ((unsigned)(q[6] & 255) << 16) | ((unsigned)(q[7] & 255) << 24);
              *(v2u*)(qrow + 32 * s2) = (v2u){lo, hi}; }
            const bf16x8 xh = __builtin_bit_cast(bf16x8, xhw), xl = __builtin_bit_cast(bf16x8, xlw);
            const bf16x8 wh0 = *(const LAS bf16x8*)(whp + 32 * s2), wl0 = *(const LAS bf16x8*)(wlp + 32 * s2), wh1 = *(const LAS bf16x8*)(whp + 16 * WR_STRIDE + 32 * s2), wl1 = *(const LAS bf16x8*)(wlp + 16 * WR_STRIDE + 32 * s2);
            acc0 = __builtin_amdgcn_mfma_f32_16x16x32_bf16(wh0, xh, acc0, 0, 0, 0); acc1 = __builtin_amdgcn_mfma_f32_16x16x32_bf16(wh1, xh, acc1, 0, 0, 0);
            acc0 = __builtin_amdgcn_mfma_f32_16x16x32_bf16(wh0, xl, acc0, 0, 0, 0); acc1 = __builtin_amdgcn_mfma_f32_16x16x32_bf16(wh1, xl, acc1, 0, 0, 0);
            acc0 = __builtin_amdgcn_mfma_f32_16x16x32_bf16(wl0, xh, acc0, 0, 0, 0); acc1 = __builtin_amdgcn_mfma_f32_16x16x32_bf16(wl1, xh, acc1, 0, 0, 0);
        }
#pragma unroll
        for (int i = 0; i < 4; ++i) { atomicAdd((float*)(LG + (wq * 16 + r16) * 33 + 4 * q4 + i), acc0[i] + (eh == 0 ? F.b_router[4 * q4 + i] : 0.f)); atomicAdd((float*)(LG + (wq * 16 + r16) * 33 + 16 + 4 * q4 + i), acc1[i] + (eh == 0 ? F.b_router[16 + 4 * q4 + i] : 0.f)); }
        __syncthreads();
        LAS unsigned* lc = (LAS unsigned*)(LG + 64 * 33); LAS unsigned* lbase = lc + 32;
        if (F.tid < 32) lc[F.tid] = 0u;
        __syncthreads();
        float tv[4]; int ti[4]; unsigned rk[4];
        if (F.wave == 0) {
#pragma unroll
            for (int r = 0; r < 4; ++r) { float bv = -3.0e38f; int bi = 0;
                for (int e = 0; e < 32; ++e) { const float v = LG[lane * 33 + e]; const bool taken = (r > 0 && ti[0] == e) || (r > 1 && ti[1] == e) || (r > 2 && ti[2] == e); if (!taken && v > bv) { bv = v; bi = e; } }
                tv[r] = bv; ti[r] = bi; rk[r] = atomicAdd((unsigned*)(lc + bi), 1u); }
        }
        __syncthreads();
        if (F.tid < 32) lbase[F.tid] = atomicAdd((unsigned*)(F.ctl + CW_CNT + 64 * F.tid), lc[F.tid]);
        __syncthreads();
        if (F.wave == 0) {
            const int tt = rg * 64 + lane;
            const float e1 = __expf(tv[1] - tv[0]), e2 = __expf(tv[2] - tv[0]), e3 = __expf(tv[3] - tv[0]), inv = 1.f / (1.f + e1 + e2 + e3);
            const float gts[4] = {inv, e1 * inv, e2 * inv, e3 * inv}; const float hsr = ((const LAS float*)(LG + 64 * 33 + 96))[lane];
#pragma unroll
            for (int r = 0; r < 4; ++r) { const unsigned pos = lbase[ti[r]] + rk[r]; F.lslot()[ti[r] * T + pos] = tt * 4 + r; F.lgate()[ti[r] * T + pos] = gts[r]; F.lhs()[ti[r] * T + pos] = hsr; }
        }
    }
}

__device__ __forceinline__ void moe_plan(Frame& F) {
    LAS int* P = (LAS int*)(F.lds + CTRL_OFF + 256); LAS int* ord = P + PL_GE + 128;
    __syncthreads();
    if (F.tid < NE) { const int c = (int)__hip_atomic_load(F.ctl + CW_CNT + 64 * F.tid, RLX_AGENT); P[PL_CNT + F.tid] = c; P[PL_NT + F.tid] = (c + 255) >> 8; }
    if (F.tid < 8) P[PL_GN + F.tid] = 0;
    __syncthreads();
    if (F.tid < NE) { const int e = F.tid, k = P[PL_NT + e]; int rank = 0, ts = 0;
        for (int o = 0; o < NE; ++o) { const int ko = P[PL_NT + o]; rank += (ko > k || (ko == k && o < e)) ? 1 : 0; ts += (o < e) ? ko : 0; }
        ord[rank] = e; P[PL_TS + e] = ts; }
    __syncthreads();
    if (F.tid == 0) {
        int load[8], gn[8];
#pragma unroll
        for (int g = 0; g < 8; ++g) { load[g] = 0; gn[g] = 0; }
        for (int it = 0; it < NE; ++it) { const int be = ord[it], bk = P[PL_NT + be];
            int bg = 0, bl = load[0];
#pragma unroll
            for (int g = 1; g < 8; ++g) if (load[g] < bl) { bl = load[g]; bg = g; }
            int n = 0;
#pragma unroll
            for (int g = 0; g < 8; ++g) if (g == bg) { n = gn[g]; load[g] += bk; gn[g] += 1; }
            P[PL_GE + bg * 16 + n] = be; }
#pragma unroll
        for (int g = 0; g < 8; ++g) P[PL_GN + g] = gn[g];
    }
    __syncthreads();
}

__device__ __forceinline__ void p2_proj(Frame& F) {
    pg8::Gemm g{(const bf16*)F.Hq(), (const bf16*)F.Win8(), T, NPROJ, D / 2}; DenseOrder S; S.init(T, NPROJ, D / 2, F.G, (int)blockIdx.x, F.tid);
    EpiProjI8 E{F.PROJ(), F.hscale1(), F.inscale()};
    pg8::gemm_phase<EpiProjI8, DenseOrder, true, true>(F.lds, g, S, E, F.wave, F.lane);
}
__device__ __forceinline__ void p6_outproj(Frame& F) {
    pg8::Gemm g{F.MIXED(), F.Wout_t(), T, D, D}; DenseOrder S; S.init(T, D, D, F.G, (int)blockIdx.x, F.tid);
    EpiX1 E{F.x, F.out, F.modf(), F.rstat()};
    pg8::gemm_phase<EpiX1, DenseOrder, true, true>(F.lds, g, S, E, F.wave, F.lane);
}
__device__ __forceinline__ void p9_up(Frame& F) {
    moe_plan(F);
    pg8::Gemm g{(const bf16*)F.H8(), (const bf16*)F.Wup8(), 0, 0, D / 2};
    MoeOrder S{8, F.G / 8, (int)blockIdx.x / 8, (int)blockIdx.x % 8, 2048, 1024, (const LAS int*)(F.lds + CTRL_OFF + 256), F.lslot(), true, F.tid};
    EpiSwiglu E{(unsigned char*)F.ACT(), F.b_up, F.upscale(), F.lhs(), (const LAS int*)(F.lds + CTRL_OFF + 256)};
    pg8::gemm_phase<EpiSwiglu, MoeOrder, true, true>(F.lds, g, S, E, F.wave, F.lane);
}
__device__ __forceinline__ void p10_down(Frame& F, bool have_plan) {
    if (!have_plan) moe_plan(F);
    pg8::Gemm g{F.ACT(), F.Wdn_t(), 0, 0, DFF / 2};
    MoeOrder S{4, F.G / 8, (int)blockIdx.x / 8, (int)blockIdx.x % 8, 1024, 1024, (const LAS int*)(F.lds + CTRL_OFF + 256), F.lslot(), false, F.tid};
    EpiDown E{(unsigned char*)F.SLOT(), F.lslot(), F.lgate(), F.b_down, (const LAS int*)(F.lds + CTRL_OFF + 256)};
    pg8::gemm_phase<EpiDown, MoeOrder, true, true>(F.lds, g, S, E, F.wave, F.lane);
}
__device__ __forceinline__ void p11_combine(Frame& F) {
    const int gw = F.vcu * NWAVES + F.wave, NGW = F.G * NWAVES, lane = F.lane;
    for (int t0 = gw * 2; t0 < T; t0 += NGW * 2) {
        v2u w[2][2][4]; f32x4 x[2][2][2];
#pragma unroll
        for (int tt = 0; tt < 2; ++tt)
#pragma unroll
            for (int j = 0; j < 2; ++j) { const int col = j * 512 + lane * 8;
#pragma unroll
                for (int k = 0; k < 4; ++k) w[tt][j][k] = *(const v2u*)((const unsigned char*)F.SLOT() + (size_t)((t0 + tt) * 4 + k) * D + col);
                x[tt][j][0] = *(const f32x4*)(F.out + (size_t)(t0 + tt) * D + col); x[tt][j][1] = *(const f32x4*)(F.out + (size_t)(t0 + tt) * D + col + 4); }
        const float* g2 = F.modf() + (t0 >> 12) * 6144 + 5120;
#pragma unroll
        for (int j = 0; j < 2; ++j) { const int col = j * 512 + lane * 8;
            const f32x4 g0 = *(const f32x4*)(g2 + col), g1 = *(const f32x4*)(g2 + col + 4);
#pragma unroll
            for (int tt = 0; tt < 2; ++tt) { float sm[8];
#pragma unroll
                for (int i = 0; i < 8; ++i) sm[i] = 0.f;
#pragma unroll
                for (int k = 0; k < 4; ++k) { const v2u q = w[tt][j][k];
                    const f32x2_t p0 = __builtin_amdgcn_cvt_pk_f32_fp8(q.x, false), p1 = __builtin_amdgcn_cvt_pk_f32_fp8(q.x, true), p2 = __builtin_amdgcn_cvt_pk_f32_fp8(q.y, false), p3 = __builtin_amdgcn_cvt_pk_f32_fp8(q.y, true);
                    sm[0] += p0[0]; sm[1] += p0[1]; sm[2] += p1[0]; sm[3] += p1[1]; sm[4] += p2[0]; sm[5] += p2[1]; sm[6] += p3[0]; sm[7] += p3[1]; }
#pragma unroll
                for (int i = 0; i < 8; ++i) sm[i] *= (1.f / 16.f);
                f32x4 x0 = x[tt][j][0], x1 = x[tt][j][1];
                x0.x += g0.x * sm[0]; x0.y += g0.y * sm[1]; x0.z += g0.z * sm[2]; x0.w += g0.w * sm[3]; x1.x += g1.x * sm[4]; x1.y += g1.y * sm[5]; x1.z += g1.z * sm[6]; x1.w += g1.w * sm[7];
                if (PROBE_A >= 0) { const float dtus = (float)(__hip_atomic_load(F.ctl + CW_TS + PROBE_A + 1, RLX_AGENT) - __hip_atomic_load(F.ctl + CW_TS + PROBE_A, RLX_AGENT)) * 0.01f; const float sc = 1.f + sqrtf(dtus * PROBE_SCALE); x0 = x0 * sc; x1 = x1 * sc; }
                if (PROBE_B >= 0 && t0 + tt == 0 && lane == 0 && j == 0) { const float dtus = (float)(__hip_atomic_load(F.ctl + CW_TS + PROBE_B + 1, RLX_AGENT) - __hip_atomic_load(F.ctl + CW_TS + PROBE_B, RLX_AGENT)) * 0.01f; x0.x += 1.f + dtus * 0.01f; }
                f32x4* op = (f32x4*)(F.out + (size_t)(t0 + tt) * D + col); op[0] = x0; op[1] = x1; } }
    }
}

__global__ void __launch_bounds__(NWAVES * 64, 2) fwd_kernel(Args args) {
    extern __shared__ __attribute__((aligned(16))) unsigned char lds[];
    Frame F;
    F.lds = (LAS unsigned char*)lds;
    F.MISC = (volatile LAS unsigned*)(F.lds + CTRL_OFF);
    F.wave = __builtin_amdgcn_readfirstlane((int)threadIdx.x >> 6); F.refresh();
    F.G = gridDim.x; { const int bx = blockIdx.x; F.vcu = (F.G % 8 == 0) ? (bx % 8) * (F.G / 8) + bx / 8 : bx; }
    for (int u = F.tid; u < 32; u += NWAVES * 64) ((LAS unsigned*)(F.lds + CTRL_OFF))[u] = 0u;
    __syncthreads();
    XcdBarrier bar; bar.bar = (unsigned*)(F.ctl + CW_BAR); bar.x = 0; bar.st = nullptr;
    if (N_LAUNCHES == 1) bar = xcd_barrier_post((unsigned*)(F.ctl + CW_BAR), F.MISC + 8, (unsigned)F.wave);
    const int lo = args.ph_lo, hi = args.ph_hi;
#ifndef PHASE_MASK
#define PHASE_MASK 0xFFFu
#endif
#define IN(k) (((PHASE_MASK >> (k)) & 1u) && lo <= (k) && (k) < hi)
#define SEAM(k) do { if (IN(k) && IN((k) + 1)) xcd_barrier(bar); if ((PROBE_A >= 0 || PROBE_B >= 0) && blockIdx.x == 0 && F.tid == 0) __hip_atomic_store(F.ctl + CW_TS + (k) + 1, (unsigned)rt(), RLX_AGENT); } while (0)

#ifndef DUP_MASK
#define DUP_MASK 0u
#endif
#define DUP(k) ((DUP_MASK >> (k)) & 1u)
    if ((PROBE_A >= 0 || PROBE_B >= 0) && blockIdx.x == 0 && F.tid == 0) __hip_atomic_store(F.ctl + CW_TS, (unsigned)rt(), RLX_AGENT);
    if (IN(0)) { F.refresh(); for (int st = blockIdx.x; st < 48; st += F.G) quant_in_item(F, st); __syncthreads(); p0_prologue(F); if (DUP(0)) { xcd_barrier(bar); p0_prologue(F); } SEAM(0); }
    if (IN(1)) { F.refresh(); p1_hrows(F); if (DUP(1)) { xcd_barrier(bar); p1_hrows(F); } SEAM(1); }
    if (IN(2)) { F.refresh(); p2_proj(F); if (DUP(2)) { xcd_barrier(bar); p2_proj(F); } SEAM(2); }
    if (IN(3)) { F.refresh(); p34_mix(F, bar); if (IN(3) && IN(5)) xcd_barrier(bar); if ((PROBE_A >= 0 || PROBE_B >= 0) && blockIdx.x == 0 && F.tid == 0) { __hip_atomic_store(F.ctl + CW_TS + 4, (unsigned)rt(), RLX_AGENT); __hip_atomic_store(F.ctl + CW_TS + 5, (unsigned)rt(), RLX_AGENT); } }
    if (IN(5)) { F.refresh(); p5_dnnorm(F); if (DUP(5)) { xcd_barrier(bar); p5_dnnorm(F); } SEAM(5); }
    if (IN(6)) { F.refresh(); p6_outproj(F); if (DUP(6)) { xcd_barrier(bar); p6_outproj(F); } SEAM(6); }
    if (IN(7)) { F.refresh(); p7_router(F); if (IN(7) && IN(9)) xcd_barrier(bar); if ((PROBE_A >= 0 || PROBE_B >= 0) && blockIdx.x == 0 && F.tid == 0) { __hip_atomic_store(F.ctl + CW_TS + 8, (unsigned)rt(), RLX_AGENT); __hip_atomic_store(F.ctl + CW_TS + 9, (unsigned)rt(), RLX_AGENT); } }
    if (IN(9)) { F.refresh(); p9_up(F); if (DUP(9)) { xcd_barrier(bar); p9_up(F); } SEAM(9); }
    if (IN(10)) { F.refresh(); p10_down(F, IN(9)); SEAM(10); }
    if (IN(11)) { F.refresh(); p11_combine(F); }
#undef IN
#undef SEAM
}

extern "C" void kernel_launch(void* const* d_in, const int* in_sizes, int n_in, void* d_out, int out_size, void* d_ws, size_t ws_size, hipStream_t stream) {
    static int grid = 0;
    if (grid == 0) {
        if (n_in != 21 || out_size != T * D || ws_size < WS_END) { fprintf(stderr, "kernel_launch: unexpected shapes (n_in %d out %d ws %zu)\n", n_in, out_size, ws_size); grid = -1; return; }
        int dev = 0, cus = 0;
        if (hipGetDevice(&dev) != hipSuccess || hipDeviceGetAttribute(&cus, hipDeviceAttributeMultiprocessorCount, dev) != hipSuccess) { grid = -1; return; }
        if (hipFuncSetAttribute((const void*)fwd_kernel, hipFuncAttributeMaxDynamicSharedMemorySize, LDS_BYTES) != hipSuccess) { fprintf(stderr, "kernel_launch: hipFuncSetAttribute failed\n"); grid = -1; return; }
        int per_cu = 0;
        if (hipOccupancyMaxActiveBlocksPerMultiprocessor(&per_cu, (const void*)fwd_kernel, NWAVES * 64, LDS_BYTES) != hipSuccess || per_cu < 1) fprintf(stderr, "kernel_launch: occupancy query reports %d\n", per_cu);
        (void)hipGetLastError();
        grid = cus;
    }
    if (grid < 0) return;
    if (hipMemsetAsync((char*)d_ws + WS_CTL, 0, CTL_ZERO_BYTES, stream) != hipSuccess) { fprintf(stderr, "kernel_launch: memset failed\n"); return; }
    Args a{};
    for (int i = 0; i < 21; ++i) a.in[i] = (const float*)d_in[i];
    a.out = (float*)d_out; a.ws = (unsigned char*)d_ws;
    for (int li = 0; li < N_LAUNCHES; ++li) {
        a.ph_lo = (N_LAUNCHES == 1) ? 0 : li; a.ph_hi = (N_LAUNCHES == 1) ? NPH : li + 1; a.li = li;
        hipLaunchKernelGGL(fwd_kernel, dim3(grid), dim3(NWAVES * 64), LDS_BYTES, stream, a);
        const hipError_t le = hipPeekAtLastError();
        if (le != hipSuccess) { fprintf(stderr, "kernel_launch: launch %d failed: %s\n", li, hipGetErrorName(le)); break; }
    }
}
```

```cpp
#include <hip/hip_runtime.h>
#include <cstdio>
#include <cstdint>

namespace pg8 {
#define PG8_LAS __attribute__((address_space(3)))
typedef unsigned short bf16_t;
typedef short bf16x8 __attribute__((ext_vector_type(8)));
typedef float f32x4 __attribute__((ext_vector_type(4)));
typedef unsigned u32x4 __attribute__((ext_vector_type(4)));
constexpr int BM = 256, BK = 64, HALF = 128, HTB = HALF * BK * 2  , STAGE_BYTES = 8 * HTB, NXCD = 8, WGM = 8;

__host__ __device__ __forceinline__ int lds_byte(int r, int c) { const int st = (r >> 4) * 2 + (c >> 5), rr = r & 15, cc = c & 31, ob = rr * 64 + cc * 2; return st * 1024 + (ob ^ (((ob >> 9) & 1) << 5)); }
__host__ __device__ __forceinline__ void stage_rc(int b, int& R, int& C) { const int st = b / 1024, sb = b % 1024, swz = sb ^ (((sb >> 9) & 1) << 5); R = (st >> 1) * 16 + swz / 64; C = (st & 1) * 32 + (swz % 64) / 2; }
__host__ __device__ __forceinline__ int perm32(int rho) { const int n = rho >> 4, i = rho & 15; return 8 * (i >> 2) + 4 * n + (i & 3); }

struct Unit { int pm, pn, e, l0; };
typedef int i32x4 __attribute__((ext_vector_type(4)));
typedef int i32x8 __attribute__((ext_vector_type(8)));
__device__ __forceinline__ bf16x8 frag_lo(i32x8 v) { return __builtin_bit_cast(bf16x8, __builtin_shufflevector(v, v, 0, 1, 2, 3)); }
__device__ __forceinline__ bf16x8 frag_hi(i32x8 v) { return __builtin_bit_cast(bf16x8, __builtin_shufflevector(v, v, 4, 5, 6, 7)); }
struct MmaBf16 { typedef f32x4 acc_t; static __device__ __forceinline__ acc_t mma(i32x8 a, i32x8 b, acc_t c) {
    c = __builtin_amdgcn_mfma_f32_16x16x32_bf16(frag_lo(a), frag_lo(b), c, 0, 0, 0); return __builtin_amdgcn_mfma_f32_16x16x32_bf16(frag_hi(a), frag_hi(b), c, 0, 0, 0); } };
struct MmaI8 { typedef i32x4 acc_t; static __device__ __forceinline__ acc_t mma(i32x8 a, i32x8 b, acc_t c) {
    c = __builtin_amdgcn_mfma_i32_16x16x64_i8(__builtin_shufflevector(a, a, 0, 1, 2, 3), __builtin_shufflevector(b, b, 0, 1, 2, 3), c, 0, 0, 0);
    return __builtin_amdgcn_mfma_i32_16x16x64_i8(__builtin_shufflevector(a, a, 4, 5, 6, 7), __builtin_shufflevector(b, b, 4, 5, 6, 7), c, 0, 0, 0); } };
typedef long i64x4v __attribute__((ext_vector_type(4)));
struct MmaFp8 { typedef f32x4 acc_t; static __device__ __forceinline__ acc_t mma(i32x8 a, i32x8 b, acc_t c) {
    asm volatile("v_mfma_f32_16x16x128_f8f6f4 %0, %1, %2, %0" : "+v"(c) : "v"(a), "v"(b)); return c; } };
struct Gemm { const bf16_t* A; const bf16_t* Bt; int M, N, K; };

__device__ __forceinline__ unsigned cvt_pk_bf16(float lo, float hi) { unsigned r; asm volatile("v_cvt_pk_bf16_f32 %0, %1, %2" : "=v"(r) : "v"(lo), "v"(hi)); return r; }
typedef float f32x2 __attribute__((ext_vector_type(2)));
__device__ __forceinline__ f32x2 gelu_pk(f32x2 v) {
    const f32x2 av = __builtin_elementwise_abs(v), d = av * 0.2316418882f + 1.0f;
    f32x2 t; t.x = __builtin_amdgcn_rcpf(d.x); t.y = __builtin_amdgcn_rcpf(d.y);
    f32x2 q = t * 0.5307027145f + (-0.7265760135f); q = q * t + 0.7107068705f; q = q * t + (-0.142248368f); q = q * t + 0.127414796f; q = q * t;
    const f32x2 s = (v * v) * (-0.72134752044f);
    f32x2 e; e.x = __builtin_amdgcn_exp2f(s.x); e.y = __builtin_amdgcn_exp2f(s.y);
    const f32x2 m = v * (q * e), r = v - m;
    f32x2 o; o.x = v.x < 0.f ? m.x : r.x; o.y = v.y < 0.f ? m.y : r.y; return o;
}

template <int ACT  > struct EpiBf16 {
    typedef MmaBf16 Mma; static constexpr bool PERM = true, AFTER_DRAIN = false; static_assert(ACT == 0 || ACT == 1, "EpiBf16: ACT is 0 (none) or 1 (gelu_pk)");
    bf16_t* O; int ldc; const float* bias; int split_cols; size_t split_stride; float scale0;
    __device__ __forceinline__ void operator()(const f32x4 (&acc)[2][2][4][2], const Unit& u, int wr, int wc, int fr, int fq) const {
        const int row0 = u.pm * BM + wr * 64 + fr; int colt = u.pn * BM; bf16_t* base = O;
        float sc = 1.f; if (split_cols) { const int t = colt / split_cols; base += (size_t)t * split_stride; colt -= t * split_cols; if (t == 0) sc = scale0; }
        const int col0 = colt + wc * 32 + 8 * fq, bcol0 = u.pn * BM + wc * 32 + 8 * fq;
        f32x4 bv[2][2];
#pragma unroll
        for (int bj = 0; bj < 2; ++bj)
#pragma unroll
            for (int n = 0; n < 2; ++n) bv[bj][n] = bias ? *(const f32x4*)(bias + bcol0 + bj * HALF + 4 * n) : (f32x4){0.f, 0.f, 0.f, 0.f};
#pragma unroll
        for (int ai = 0; ai < 2; ++ai)
#pragma unroll
            for (int m = 0; m < 4; ++m) { bf16_t* rowp = base + (size_t)(row0 + ai * HALF + m * 16) * ldc + col0;
#pragma unroll
                for (int bj = 0; bj < 2; ++bj) { f32x4 v0 = acc[ai][bj][m][0] + bv[bj][0], v1 = acc[ai][bj][m][1] + bv[bj][1];
                    if (ACT == 1) { f32x2 a = gelu_pk((f32x2){v0[0], v0[1]}), b = gelu_pk((f32x2){v0[2], v0[3]}), c = gelu_pk((f32x2){v1[0], v1[1]}), d = gelu_pk((f32x2){v1[2], v1[3]});
                        v0 = (f32x4){a.x, a.y, b.x, b.y}; v1 = (f32x4){c.x, c.y, d.x, d.y}; }
                    v0 = v0 * sc; v1 = v1 * sc; u32x4 w; w.x = cvt_pk_bf16(v0[0], v0[1]); w.y = cvt_pk_bf16(v0[2], v0[3]); w.z = cvt_pk_bf16(v1[0], v1[1]); w.w = cvt_pk_bf16(v1[2], v1[3]);
                    *(u32x4*)(rowp + bj * HALF) = w; } }
    }
};

template <class Epi, class Sched, bool ALIGN_EPI = false, bool SP2 = false>
__device__ __forceinline__ void gemm_phase(PG8_LAS unsigned char* lds, const Gemm g, const Sched& S, const Epi& E, const int wid, const int lane) {
    const int tid = wid * 64 + lane, wr = wid >> 2, wc = wid & 3, fr = lane & 15, fq = lane >> 4;
    const int K = g.K, nt = K / BK;
    unsigned voffB[2];
#pragma unroll
    for (int i = 0; i < 2; ++i) { int R, C; stage_rc(tid * 16 + i * 8192, R, C); const int Rb = Epi::PERM ? ((R & ~31) + perm32(R & 31)) : R;
        voffB[i] = (unsigned)(Rb * K + C) * 2u; }
    const size_t kstep = (size_t)(BK * 2);
    const size_t hstep = (size_t)HALF * K * 2;
    const unsigned ldsw = (unsigned)wid * 1024u;
    const int aoff = lds_byte(wr * 64 + fr, fq * 8), boff = lds_byte(wc * 32 + fr, fq * 8);
#define PG8_SA(b, h) (((b) * 2 + (h)) * HTB)
#define PG8_SB(b, h) ((4 + (b) * 2 + (h)) * HTB)
#define PG8_STAGE(bufoff, gbase, voff) do { _Pragma("unroll") for (int _i = 0; _i < 2; ++_i) \
        __builtin_amdgcn_global_load_lds((const unsigned*)((const char*)(gbase) + (voff)[_i]), (PG8_LAS unsigned*)(lds + (bufoff) + ldsw + _i * 8192), 16, 0, 0); } while (0)
#define PG8_LDA(dst, b, h) do { _Pragma("unroll") for (int m = 0; m < 4; ++m) { const i32x4 lo_ = *(const PG8_LAS i32x4*)(lds + PG8_SA(b, h) + aoff + m * 2048), hi_ = *(const PG8_LAS i32x4*)(lds + PG8_SA(b, h) + aoff + m * 2048 + 1024); dst[m] = __builtin_shufflevector(lo_, hi_, 0, 1, 2, 3, 4, 5, 6, 7); } } while (0)
#define PG8_LDB(dst, b, h) do { _Pragma("unroll") for (int n = 0; n < 2; ++n) { const i32x4 lo_ = *(const PG8_LAS i32x4*)(lds + PG8_SB(b, h) + boff + n * 2048), hi_ = *(const PG8_LAS i32x4*)(lds + PG8_SB(b, h) + boff + n * 2048 + 1024); dst[n] = __builtin_shufflevector(lo_, hi_, 0, 1, 2, 3, 4, 5, 6, 7); } } while (0)
#define PG8_MMA(ai, bj, At, Bt) do { __builtin_amdgcn_s_setprio(1); _Pragma("unroll") for (int m = 0; m < 4; ++m) _Pragma("unroll") for (int n = 0; n < 2; ++n) \
        acc[ai][bj][m][n] = Epi::Mma::mma(Bt[n], At[m], acc[ai][bj][m][n]); __builtin_amdgcn_s_setprio(0); } while (0)
#define PG8_WAIT_V(n) asm volatile("s_waitcnt vmcnt(" #n ")" ::: "memory")
#define PG8_WAIT_L(n) asm volatile("s_waitcnt lgkmcnt(" #n ")" ::: "memory")
#define PG8_BAR __builtin_amdgcn_s_barrier()
#define PG8_SCHED __builtin_amdgcn_sched_barrier(0)
    Unit cur, nxt; int ui = 0;
    if (!S.next(0, cur)) return;
    typedef typename Epi::Mma::acc_t acc_t;
    acc_t acc[2][2][4][2];
#pragma unroll
    for (int a = 0; a < 2; ++a)
#pragma unroll
        for (int b = 0; b < 2; ++b)
#pragma unroll
            for (int m = 0; m < 4; ++m)
#pragma unroll
                for (int n = 0; n < 2; ++n) acc[a][b][m][n] = acc_t{};
    i32x8 At[4], B0[2], B1[2];
    const char* const A0 = (const char*)g.A; const char* cB = (const char*)g.Bt + S.boff(cur);
    unsigned oA0[2], oA1[2], nA0[2], nA1[2];
    S.a_offsets(cur, oA0, oA1);
    S.a_ready(cur);
    if constexpr (SP2) {
        PG8_STAGE(PG8_SB(0, 0), cB, voffB); PG8_STAGE(PG8_SB(0, 1), cB + hstep, voffB); PG8_STAGE(PG8_SA(0, 0), A0, oA0); PG8_STAGE(PG8_SA(0, 1), A0, oA1);
        if (wr == 1) PG8_BAR;
        PG8_WAIT_V(2); PG8_BAR;
        PG8_STAGE(PG8_SB(1, 0), cB + kstep, voffB); PG8_STAGE(PG8_SA(1, 0), A0 + kstep, oA0); PG8_STAGE(PG8_SB(1, 1), cB + hstep + kstep, voffB);
        PG8_WAIT_V(6); PG8_BAR;
    }
    for (;;) {
        const bool has_next = S.next(ui + 1, nxt);
        const char* nB = has_next ? (const char*)g.Bt + S.boff(nxt) : cB;
        if (has_next) S.a_offsets(nxt, nA0, nA1); else { nA0[0] = oA0[0]; nA0[1] = oA0[1]; nA1[0] = oA1[0]; nA1[1] = oA1[1]; }
#pragma nounroll
        for (int t = 0; t < nt; t += 2) {
            const bool last = (t == nt - 2);
            const char* a1 = A0 + (size_t)(t + 1) * kstep;
            const char* a2 = last ? A0 : A0 + (size_t)(t + 2) * kstep; const char* b2 = last ? nB : cB + (size_t)(t + 2) * kstep;
            unsigned s0[2], s1[2]; s0[0] = last ? nA0[0] : oA0[0]; s0[1] = last ? nA0[1] : oA0[1]; s1[0] = last ? nA1[0] : oA1[0]; s1[1] = last ? nA1[1] : oA1[1];
            const char* a3 = a2 + kstep; const char* b3 = b2 + kstep;
            if (last && has_next) S.a_ready(nxt);
            if constexpr (SP2) {
            PG8_LDB(B0, 0, 0); PG8_LDB(B1, 0, 1); PG8_SCHED; PG8_LDA(At, 0, 0); PG8_STAGE(PG8_SA(1, 1), a1, oA1);
            PG8_WAIT_V(8); PG8_WAIT_L(0); PG8_BAR; PG8_MMA(0, 0, At, B0); PG8_MMA(0, 1, At, B1); PG8_BAR; PG8_SCHED;
            PG8_LDA(At, 0, 1); PG8_STAGE(PG8_SB(0, 0), b2, voffB); PG8_STAGE(PG8_SB(0, 1), b2 + hstep, voffB); PG8_STAGE(PG8_SA(0, 0), a2, s0);
            PG8_WAIT_V(8); PG8_WAIT_L(0); PG8_BAR; PG8_MMA(1, 0, At, B0); PG8_MMA(1, 1, At, B1); PG8_BAR; PG8_SCHED;
            PG8_LDB(B0, 1, 0); PG8_LDB(B1, 1, 1); PG8_SCHED; PG8_LDA(At, 1, 0); PG8_STAGE(PG8_SA(0, 1), a2, s1);
            PG8_WAIT_V(8); PG8_WAIT_L(0); PG8_BAR; PG8_MMA(0, 0, At, B0); PG8_MMA(0, 1, At, B1); PG8_BAR; PG8_SCHED;
            PG8_LDA(At, 1, 1); PG8_STAGE(PG8_SB(1, 0), b3, voffB); PG8_STAGE(PG8_SB(1, 1), b3 + hstep, voffB); PG8_STAGE(PG8_SA(1, 0), a3, s0);
            PG8_WAIT_V(8); PG8_WAIT_L(0); PG8_BAR; PG8_MMA(1, 0, At, B0); PG8_MMA(1, 1, At, B1); PG8_BAR; PG8_SCHED;
            }
        }
        if constexpr (ALIGN_EPI) { if (wr == 0) PG8_BAR; }
        asm volatile("s_nop 7\n\ts_nop 7\n\ts_nop 7" ::: "memory");
        if constexpr (!Epi::AFTER_DRAIN) { E(acc, cur, wr, wc, fr, fq); S.done(cur); }
        if (!has_next) break;
#pragma unroll
        for (int a = 0; a < 2; ++a)
#pragma unroll
            for (int b = 0; b < 2; ++b)
#pragma unroll
                for (int m = 0; m < 4; ++m)
#pragma unroll
                    for (int n = 0; n < 2; ++n) acc[a][b][m][n] = acc_t{};
        cur = nxt; cB = nB; ++ui; oA0[0] = nA0[0]; oA0[1] = nA0[1]; oA1[0] = nA1[0]; oA1[1] = nA1[1];
        if constexpr (ALIGN_EPI) { if (wr == 1) PG8_BAR; }
    }
    PG8_WAIT_V(0);
    if constexpr (!ALIGN_EPI) { if (wr == 0) PG8_BAR; }
    PG8_BAR;
    if constexpr (Epi::AFTER_DRAIN) { E.fused(acc, cur, wr, wc, fr, fq, lds, wid, lane); S.done(cur); }
#undef PG8_SA
#undef PG8_SB
#undef PG8_STAGE
#undef PG8_LDA
#undef PG8_LDB
#undef PG8_MMA
#undef PG8_WAIT_V
#undef PG8_WAIT_L
#undef PG8_BAR
#undef PG8_SCHED
}
}

#define GAS __attribute__((address_space(1)))
#define LAS __attribute__((address_space(3)))
typedef unsigned short bf16;
typedef unsigned v4u __attribute__((ext_vector_type(4)));
typedef float f32x4 __attribute__((ext_vector_type(4)));
typedef short bf16x8 __attribute__((ext_vector_type(8)));
typedef GAS unsigned gu32;
typedef GAS unsigned long long gu64;
#define RLX_AGENT __ATOMIC_RELAXED, __HIP_MEMORY_SCOPE_AGENT
#define LDS_WAIT() asm volatile("s_waitcnt lgkmcnt(0)" ::: "memory")
#define VM_WAIT() asm volatile("s_waitcnt vmcnt(0)" ::: "memory")
__device__ __forceinline__ unsigned long long rt() { return __builtin_amdgcn_s_memrealtime(); }
__device__ __forceinline__ unsigned f2bf(float f) { unsigned u = __builtin_bit_cast(unsigned, f); return (u + 0x7fffu + ((u >> 16) & 1u)) >> 16; }
typedef float f32x2_t __attribute__((ext_vector_type(2))); typedef __bf16 bf16x2_t __attribute__((ext_vector_type(2)));
__device__ __forceinline__ unsigned pk2(float lo, float hi) { const f32x2_t v = {lo, hi}; const bf16x2_t b = __builtin_convertvector(v, bf16x2_t); return __builtin_bit_cast(unsigned, b); }

#define XB_TMO      128
#define XB_XCNT(j)  (256  + 64 * (j))
#define XB_XSUB(j)  (1280 + 64 * (j))
#define XB_XGEN(j)  (2304 + 64 * (j))
#define XB_TOP      3328
#define XB_TOPGEN   3392
#define XCD_BAR_WORDS 3456
#define XB_SPIN_CAP (1u << 18)

__device__ __forceinline__ unsigned xb_ld(unsigned* p)              { return __hip_atomic_load(p, __ATOMIC_RELAXED, __HIP_MEMORY_SCOPE_AGENT); }
__device__ __forceinline__ unsigned xb_add(unsigned* p, unsigned v) { return __hip_atomic_fetch_add(p, v, __ATOMIC_RELAXED, __HIP_MEMORY_SCOPE_AGENT); }
__device__ __forceinline__ unsigned xb_xcc_id() { return (unsigned)__builtin_amdgcn_s_getreg((3 << 11) | 20) & 0xFu; }
#define XB_SPIN(cond, bar) do { unsigned _sp = 0; while (cond) { __builtin_amdgcn_s_sleep(1); \
    if ((++_sp & 255u) == 0u) { if (xb_ld(&(bar)[XB_TMO])) break; if (_sp > XB_SPIN_CAP) { atomicAdd(&(bar)[XB_TMO], 1u); break; } } } } while (0)

struct XcdBarrier {
    unsigned wv;
    unsigned* bar; unsigned x;
    volatile LAS unsigned* st;
};

__device__ __forceinline__ int lane_now() { int l; asm volatile("v_mbcnt_lo_u32_b32 %0, -1, 0\n\tv_mbcnt_hi_u32_b32 %0, -1, %0" : "=v"(l)); return l; }
__device__ __forceinline__ XcdBarrier xcd_barrier_post(unsigned* bar, volatile LAS unsigned* st, unsigned wv) {
    XcdBarrier b; b.wv = wv; b.bar = bar; b.x = xb_xcc_id(); b.st = st;
    if (wv == 0u && lane_now() == 0) (void)xb_add(&bar[XB_XCNT(b.x)], 1u);
    return b;
}
__device__ __forceinline__ void xcd_barrier_complete(unsigned* bar, unsigned x, unsigned& nloc, unsigned& nx) {
    const unsigned G = gridDim.x * gridDim.y * gridDim.z;
    unsigned sum, cnt, mine, sp = 0u;
    for (;;) {
        sum = 0u; cnt = 0u; mine = 0u;
#pragma unroll
        for (unsigned j = 0; j < 16; ++j) { const unsigned c = xb_ld(&bar[XB_XCNT(j)]); sum += c; cnt += (c > 0u) ? 1u : 0u; mine = (j == x) ? c : mine; }
        if (sum == G) break;
        __builtin_amdgcn_s_sleep(1);
        if ((++sp & 255u) == 0u) { if (xb_ld(&bar[XB_TMO])) break; if (sp > XB_SPIN_CAP) { atomicAdd(&bar[XB_TMO], 1u); break; } }
    }
    nloc = mine > 0u ? mine : 1u; nx = cnt > 0u ? cnt : 1u;
}

__device__ __forceinline__ void xcd_barrier(const XcdBarrier& b) {
    asm volatile("s_waitcnt vmcnt(0)" ::: "memory");
    __syncthreads();
    if (b.wv == 0u && lane_now() == 0) {
        unsigned* bar = b.bar;
        __builtin_amdgcn_s_waitcnt(0);
        unsigned nloc = b.st[0], nx = b.st[1];
        if (nloc == 0u) { xcd_barrier_complete(bar, b.x, nloc, nx); b.st[0] = nloc; b.st[1] = nx; }
        const unsigned old = xb_add(&bar[XB_XSUB(b.x)], 1u);
        const unsigned gen = old / nloc;
        if (old + 1u == (gen + 1u) * nloc) {
            __builtin_amdgcn_fence(__ATOMIC_RELEASE, "agent");
            asm volatile("s_waitcnt vmcnt(0)" ::: "memory");
            const unsigned og = xb_add(&bar[XB_TOP], 1u);
            const unsigned tg = og / nx;
            if (og + 1u == (tg + 1u) * nx) xb_add(&bar[XB_TOPGEN], 1u);
            else XB_SPIN(xb_ld(&bar[XB_TOPGEN]) == tg, bar);
            __builtin_amdgcn_fence(__ATOMIC_ACQUIRE, "agent");
            xb_add(&bar[XB_XGEN(b.x)], 1u);
            asm volatile("s_waitcnt vmcnt(0)" ::: "memory");
        } else {
            XB_SPIN(xb_ld(&bar[XB_XGEN(b.x)]) == gen, bar);
            __builtin_amdgcn_fence(__ATOMIC_ACQUIRE, "agent");
            asm volatile("s_waitcnt vmcnt(0)" ::: "memory");
        }
    }
    __syncthreads();
}


constexpr int NWAVES = 8;
constexpr int NPH = 12;
#ifndef MK_N_LAUNCHES
#define MK_N_LAUNCHES 1
#endif
constexpr int N_LAUNCHES = MK_N_LAUNCHES;

constexpr int BATCH = 4, SEQ = 4096, D = 1024, T = BATCH * SEQ;
constexpr int DN_H = 4, DK = 128, CH = 64, NCH = SEQ / CH;
constexpr int SW_H = 8, SW_KV = 2, HD = 64, WIN = 128, NB = SEQ / WIN;
constexpr int IN_COLS = 2824, NPROJ = 3072, PC_AB = 2816;
constexpr int PC_Z = 1536, PC_SQ = 2048, PC_SK = 2560, PC_SV = 2688;
constexpr int NE = 32, TOPK = 4, DFF = 1024;
constexpr int MAXTILES = 288, NPADMAX = MAXTILES * 256;
constexpr float EPS = 1e-6f;
constexpr int DNP_STRIDE = 36928;

constexpr size_t MiB = 1u << 20;
constexpr size_t WS_CTL = 0, CTL_ZERO_BYTES = 1 * MiB;
constexpr size_t WS_MODP = 18 * MiB;
constexpr int KSPLIT = 32; static_assert(KSPLIT == 32, "the adaLN GEMV items hold 1024 / KSPLIT = 32 weight rows in registers");
constexpr size_t WS_MODF = 2 * MiB;
constexpr size_t WS_GB = 3 * MiB;
constexpr size_t WS_WIN = 4 * MiB;
constexpr size_t WS_WOUT = 10 * MiB;
constexpr size_t WS_LSLOT = 12 * MiB;
constexpr size_t WS_LGATE = 14 * MiB;
constexpr size_t WS_LHS = 22 * MiB;
constexpr size_t WS_RSLOT = 16 * MiB;
constexpr size_t WS_RGATE = 17 * MiB;
constexpr size_t WS_H = 32 * MiB;
constexpr size_t WS_PROJ = 64 * MiB;
constexpr size_t WS_MIXED = 300 * MiB;
constexpr size_t WS_RSTAT = 297 * MiB;
constexpr size_t WS_ODN = 184 * MiB;
constexpr size_t WS_DNIMG = 216 * MiB;
constexpr size_t WS_DNUT = 280 * MiB;
constexpr size_t WS_DEC = 296 * MiB;
constexpr int IMG_W = 0, IMG_Q = 17408, IMG_K = 34816, IMG_A = 52224, IMG_U = 60928, IMG_UHALF = 8704, IMG_KS = 136;
constexpr int GI_U = 32768, IMG_BYTES = 65536; constexpr float IMG_SC = 16.f;
constexpr int IMG_LDS = IMG_U + IMG_UHALF;
constexpr size_t WS_WUP = 384 * MiB;
constexpr size_t WS_WDN = 512 * MiB;
constexpr size_t WS_XS = 576 * MiB;
constexpr size_t WS_ACT = 720 * MiB;
constexpr size_t WS_SLOT = 864 * MiB;
constexpr size_t WS_END = 992 * MiB;
static_assert(WS_XS + (size_t)NPADMAX * 1024 * 2 <= WS_ACT && WS_ACT + (size_t)NPADMAX * 1024 * 2 <= WS_SLOT, "xs/act");
constexpr int CW_CNT = 8192;
constexpr int CW_BAR = 4096;
constexpr int CW_SWAQ = 12288;
constexpr int CW_FLAG = 16384;
constexpr int CW_TS = 128;
#ifndef PROBE_A
#define PROBE_A -1
#endif
#ifndef PROBE_B
#define PROBE_B -1
#endif
#ifndef PROBE_SCALE
#define PROBE_SCALE 1.0e-6f
#endif

constexpr int WR_STRIDE = 1032;
constexpr int LDS_BYTES = 147456;
constexpr int CTRL_OFF = LDS_BYTES - 4096;
constexpr int SCRATCH_BYTES = CTRL_OFF;

struct Args { const float* in[21]; float* out; unsigned char* ws; int ph_lo, ph_hi, li, pad; };
struct Frame {
    LAS unsigned char* lds;
    volatile LAS unsigned* MISC;
    gu32* ctl;
    int tid, lane, wave, vcu, G;
    __device__ __forceinline__ void refresh() {
        lane = lane_now(); tid = wave * 64 + lane;
        const __attribute__((address_space(4))) Args* ap = (const __attribute__((address_space(4))) Args*)__builtin_amdgcn_kernarg_segment_ptr();
        asm volatile("" : "+s"(ap));
        x = ap->in[0]; c = ap->in[1]; w_ada = ap->in[2]; b_ada = ap->in[3]; norm1_w = ap->in[4]; w_in = ap->in[5]; conv_w = ap->in[6]; a_log = ap->in[7]; dt_bias = ap->in[8];
        dn_norm_w = ap->in[9]; q_norm_w = ap->in[10]; k_norm_w = ap->in[11]; sinks = ap->in[12]; w_out = ap->in[13]; norm2_w = ap->in[14]; w_router = ap->in[15]; b_router = ap->in[16];
        w_up = ap->in[17]; b_up = ap->in[18]; w_down = ap->in[19]; b_down = ap->in[20]; out = ap->out; ws = ap->ws; ctl = (gu32*)(ap->ws + WS_CTL);
    }
    const float *x, *c, *w_ada, *b_ada, *norm1_w, *w_in, *conv_w, *a_log, *dt_bias, *dn_norm_w, *q_norm_w, *k_norm_w, *sinks, *w_out, *norm2_w, *w_router, *b_router, *w_up, *b_up, *w_down, *b_down;
    float* out; unsigned char* ws;
    __device__ __forceinline__ float* modp() const { return (float*)(ws + WS_MODP); }
    __device__ __forceinline__ float* modf() const { return (float*)(ws + WS_MODF); }
    __device__ __forceinline__ bf16* wrimg() const { return (bf16*)(ws + WS_GB + 600 * 1024); }
    __device__ __forceinline__ float* odn() const { return (float*)(ws + WS_ODN); }
    __device__ __forceinline__ float* lgate() const { return (float*)(ws + WS_LGATE); }
    __device__ __forceinline__ float* lhs() const { return (float*)(ws + WS_LHS); }
    __device__ __forceinline__ int* lslot() const { return (int*)(ws + WS_LSLOT); }
    __device__ __forceinline__ unsigned char* dnimg() const { return (unsigned char*)(ws + WS_DNIMG); }
    __device__ __forceinline__ float* rstat() const { return (float*)(ws + WS_RSTAT); }
    __device__ __forceinline__ signed char* Hq() const { return (signed char*)(ws + WS_H); }
    __device__ __forceinline__ signed char* Win8() const { return (signed char*)(ws + WS_WIN); }
    __device__ __forceinline__ float* hscale1() const { return (float*)(ws + WS_GB); }
    __device__ __forceinline__ float* inscale() const { return (float*)(ws + WS_GB + 512 * 1024); }
    __device__ __forceinline__ signed char* H8() const { return (signed char*)(ws + WS_XS); }
    __device__ __forceinline__ signed char* Wup8() const { return (signed char*)(ws + WS_WUP); }
    __device__ __forceinline__ float* upscale() const { return (float*)(ws + WS_RSLOT); }
    __device__ __forceinline__ float* hscale() const { return (float*)(ws + WS_RGATE); }
    __device__ __forceinline__ bf16* Wout_t() const { return (bf16*)(ws + WS_WOUT); }
    __device__ __forceinline__ bf16* Wdn_t() const { return (bf16*)(ws + WS_WDN); }
    __device__ __forceinline__ bf16* PROJ() const { return (bf16*)(ws + WS_PROJ); }
    __device__ __forceinline__ bf16* MIXED() const { return (bf16*)(ws + WS_MIXED); }
    __device__ __forceinline__ bf16* ACT() const { return (bf16*)(ws + WS_ACT); }
    __device__ __forceinline__ bf16* SLOT() const { return (bf16*)(ws + WS_SLOT); }
};

typedef unsigned v2u __attribute__((ext_vector_type(2)));
__device__ __forceinline__ void st_wt8(void* p, unsigned lo, unsigned hi) { __hip_atomic_store((unsigned long long*)p, ((unsigned long long)hi << 32) | lo, __ATOMIC_RELAXED, __HIP_MEMORY_SCOPE_AGENT); }
__device__ __forceinline__ unsigned fp8x4(float a, float b, float c, float d) { unsigned w = __builtin_amdgcn_cvt_pk_fp8_f32(a, b, 0u, false); return __builtin_amdgcn_cvt_pk_fp8_f32(c, d, w, true); }
__device__ __forceinline__ void st_wt4(void* p, unsigned v) { __hip_atomic_store((unsigned*)p, v, __ATOMIC_RELAXED, __HIP_MEMORY_SCOPE_AGENT); }
__device__ __forceinline__ float bf2f(bf16 v) { return __uint_as_float((unsigned)v << 16); }
__device__ __forceinline__ float bflo(unsigned w) { return __uint_as_float(w << 16); }
__device__ __forceinline__ float bfhi(unsigned w) { return __uint_as_float(w & 0xffff0000u); }
__device__ __forceinline__ float wave_sum(float v) {
#pragma unroll
    for (int o = 1; o < 64; o <<= 1) v += __shfl_xor(v, o);
    return v;
}
__device__ __forceinline__ float siluf(float v) { return v / (1.f + __expf(-v)); }

struct DenseOrder {
    int nM, nN, nwg, G, c, tid; size_t tstep;
    __device__ void init(int M, int N, int K, int G_, int c_, int tid_) { nM = M / 256; nN = N / 256; nwg = nM * nN; G = G_; c = c_; tid = tid_; tstep = (size_t)256 * K * 2; }
    __device__ bool next(int i, pg8::Unit& u) const {
        const long L = (long)i * G + c; if (L >= nwg) return false;
        int wgid = (int)L; { const int q = nwg / 8, r = nwg % 8, xcd = wgid % 8, off = wgid / 8; wgid = (xcd < r ? xcd * (q + 1) : r * (q + 1) + (xcd - r) * q) + off; }
        const int nig = 8 * nN, gid = wgid / nig, fm = gid * 8, gsz = (nM - fm) < 8 ? (nM - fm) : 8;
        u.pm = fm + ((wgid % nig) % gsz); u.pn = (wgid % nig) / gsz; u.e = 0; return true;
    }
    __device__ __forceinline__ void a_offsets(const pg8::Unit& u, unsigned (&o0)[2], unsigned (&o1)[2]) const {
#pragma unroll
        for (int i = 0; i < 2; ++i) { int R, C; pg8::stage_rc(tid * 16 + i * 8192, R, C); o0[i] = (unsigned)((size_t)u.pm * tstep) + (unsigned)(R * (int)(tstep / 512) + C) * 2u; o1[i] = o0[i] + (unsigned)(tstep / 2); } }
    __device__ __forceinline__ size_t boff(const pg8::Unit& u) const { return (size_t)u.pn * tstep; }
    __device__ __forceinline__ void a_ready(const pg8::Unit&) const {}
    __device__ __forceinline__ void done(const pg8::Unit&) const {}
};
constexpr int PL_CNT = 0, PL_NT = 32, PL_TS = 64, PL_GN = 96, PL_GE = 104;
struct MoeOrder {
    int nN, lcn, lc, grp, rows_per_e, rowbytes; const LAS int* P; const int* lslot; bool gather; int tid;
    __device__ bool next(int i, pg8::Unit& u) const {
        int uidx = i * lcn + lc; const int n = P[PL_GN + grp];
        for (int k = 0; k < n; ++k) { const int e = P[PL_GE + grp * 16 + k], U = P[PL_NT + e] * nN;
            if (uidx < U) { const int tile = uidx / nN; u.e = __builtin_amdgcn_readfirstlane(e); u.pn = __builtin_amdgcn_readfirstlane(uidx - tile * nN); u.pm = __builtin_amdgcn_readfirstlane(P[PL_TS + e] + tile); u.l0 = __builtin_amdgcn_readfirstlane(tile * 256); return true; }
            uidx -= U; }
        return false;
    }
    __device__ __forceinline__ void a_offsets(const pg8::Unit& u, unsigned (&o0)[2], unsigned (&o1)[2]) const {
        const int cnt = P[PL_CNT + u.e];
#pragma unroll
        for (int i = 0; i < 2; ++i) { int R, C; pg8::stage_rc(tid * 16 + i * 8192, R, C);
            if (gather) { const int l0 = u.l0 + R, l1 = l0 + 128;
                const int t0 = (l0 < cnt) ? (lslot[u.e * T + l0] >> 2) : 0, t1 = (l1 < cnt) ? (lslot[u.e * T + l1] >> 2) : 0;
                o0[i] = (unsigned)t0 * (unsigned)rowbytes + (unsigned)C * 2u; o1[i] = (unsigned)t1 * (unsigned)rowbytes + (unsigned)C * 2u; }
            else { o0[i] = (unsigned)(u.pm * 256 + R) * (unsigned)rowbytes + (unsigned)C * 2u; o1[i] = o0[i] + 128u * (unsigned)rowbytes; } }
    }
    __device__ __forceinline__ size_t boff(const pg8::Unit& u) const { return ((size_t)u.e * rows_per_e + (size_t)u.pn * 256) * (size_t)rowbytes; }
    __device__ __forceinline__ void a_ready(const pg8::Unit&) const {}
    __device__ __forceinline__ void done(const pg8::Unit&) const {}
};

struct EpiProjI8 {
    typedef pg8::MmaI8 Mma; static constexpr bool PERM = true, AFTER_DRAIN = false;
    bf16* O; const float* hs; const float* ws;
    __device__ __forceinline__ void operator()(const pg8::i32x4 (&acc)[2][2][4][2], const pg8::Unit& u, int wr, int wc, int fr, int fq) const {
        const int row0 = u.pm * 256 + wr * 64 + fr, col0 = u.pn * 256 + wc * 32 + 8 * fq;
        float h[2][4]; f32x4 sc[2][2];
#pragma unroll
        for (int bj = 0; bj < 2; ++bj) { sc[bj][0] = *(const f32x4*)(ws + col0 + bj * 128); sc[bj][1] = *(const f32x4*)(ws + col0 + bj * 128 + 4); }
#pragma unroll
        for (int ai = 0; ai < 2; ++ai)
#pragma unroll
            for (int m = 0; m < 4; ++m) h[ai][m] = hs[row0 + ai * 128 + m * 16];
#pragma unroll
        for (int ai = 0; ai < 2; ++ai)
#pragma unroll
            for (int m = 0; m < 4; ++m) { const int row = row0 + ai * 128 + m * 16; bf16* rowp = O + (size_t)row * NPROJ + col0;
#pragma unroll
                for (int bj = 0; bj < 2; ++bj) {
                    const f32x4 c0 = __builtin_convertvector(acc[ai][bj][m][0], f32x4) * h[ai][m] * sc[bj][0], c1 = __builtin_convertvector(acc[ai][bj][m][1], f32x4) * h[ai][m] * sc[bj][1];
                    v4u w; w.x = pk2(c0[0], c0[1]); w.y = pk2(c0[2], c0[3]); w.z = pk2(c1[0], c1[1]); w.w = pk2(c1[2], c1[3]);
                    *(v4u*)(rowp + bj * 128) = w; } }
    }
};
struct EpiX1 {
    typedef pg8::MmaBf16 Mma; static constexpr bool PERM = false, AFTER_DRAIN = false;
    const float* x; float* out; const float* modf; float* rstat;
    __device__ __forceinline__ void operator()(const f32x4 (&acc)[2][2][4][2], const pg8::Unit& u, int wr, int wc, int fr, int fq) const {
        const int row0 = u.pm * 256 + wr * 64 + fr, col0 = u.pn * 256 + wc * 32 + 4 * fq, b = u.pm >> 4;
        f32x4 gv[2][2], av[2][2];
#pragma unroll
        for (int bj = 0; bj < 2; ++bj)
#pragma unroll
            for (int n = 0; n < 2; ++n) { gv[bj][n] = *(const f32x4*)(modf + b * 6144 + 2048 + col0 + bj * 128 + n * 16); av[bj][n] = *(const f32x4*)(modf + 32768 + b * 1024 + col0 + bj * 128 + n * 16); }
        f32x4 xv[2][2][2][2];
#define X1_LOAD(buf, sl, r) do { const size_t off_ = (size_t)(row0 + ((r) >> 2) * 128 + ((r) & 3) * 16) * D + col0; \
            _Pragma("unroll") for (int bj = 0; bj < 2; ++bj) _Pragma("unroll") for (int n = 0; n < 2; ++n) xv[buf][sl][bj][n] = *(const f32x4*)(x + off_ + bj * 128 + n * 16); } while (0)
#define X1_ROW(buf, sl, r) do { const int ai = (r) >> 2, m = (r) & 3, row = row0 + ai * 128 + m * 16; const size_t off = (size_t)row * D + col0; float ss = 0.f, ma = 0.f; \
            _Pragma("unroll") for (int bj = 0; bj < 2; ++bj) _Pragma("unroll") for (int n = 0; n < 2; ++n) { const f32x4 r_ = xv[buf][sl][bj][n] + gv[bj][n] * acc[ai][bj][m][n]; *(f32x4*)(out + off + bj * 128 + n * 16) = r_; \
                ss += (r_.x * r_.x + r_.y * r_.y) + (r_.z * r_.z + r_.w * r_.w); const f32x4 q = r_ * av[bj][n]; \
                ma = fmaxf(fmaxf(ma, fmaxf(fabsf(q.x), fabsf(q.y))), fmaxf(fabsf(q.z), fabsf(q.w))); } \
            ss += __shfl_xor(ss, 16); ss += __shfl_xor(ss, 32); ma = fmaxf(ma, __shfl_xor(ma, 16)); ma = fmaxf(ma, __shfl_xor(ma, 32)); \
            if (fq == 0) { float* rp = rstat + ((size_t)row * 16 + u.pn * 4 + wc) * 2; rp[0] = ss; rp[1] = ma; } } while (0)
        X1_LOAD(0, 0, 0); X1_LOAD(1, 0, 1);
        X1_ROW(0, 0, 0); X1_LOAD(0, 0, 2); X1_LOAD(0, 1, 3);
        X1_ROW(1, 0, 1); X1_LOAD(1, 0, 4); X1_LOAD(1, 1, 5);
        X1_ROW(0, 0, 2); X1_ROW(0, 1, 3); X1_LOAD(0, 0, 6); X1_LOAD(0, 1, 7);
        X1_ROW(1, 0, 4); X1_ROW(1, 1, 5);
        X1_ROW(0, 0, 6); X1_ROW(0, 1, 7);
#undef X1_ROW
#undef X1_LOAD
    }
};
struct EpiSwiglu {
    typedef pg8::MmaI8 Mma; static constexpr bool PERM = true, AFTER_DRAIN = false;
    unsigned char* act; const float* b_up; const float* wscale; const float* lhs; const LAS int* P;
    __device__ __forceinline__ void operator()(const pg8::i32x4 (&acc)[2][2][4][2], const pg8::Unit& u, int wr, int wc, int fr, int fq) const {
        const int row0 = u.pm * 256 + wr * 64 + fr, colw = u.pn * 128 + wc * 32 + 8 * fq, l00 = u.l0 + wr * 64 + fr, cnt = P[PL_CNT + u.e];
        const float* bg = b_up + (size_t)u.e * 2048 + colw; const float* bl = bg + 1024;
        const float* sg = wscale + (size_t)u.e * 2048 + u.pn * 256 + wc * 32 + 8 * fq; const float* sl = sg + 128;
        float hsv[2][4];
#pragma unroll
        for (int ai = 0; ai < 2; ++ai)
#pragma unroll
            for (int m = 0; m < 4; ++m) hsv[ai][m] = lhs[u.e * T + l00 + ai * 128 + m * 16];
        f32x4 bgv[2], blv[2], sgv[2], slv[2];
#pragma unroll
        for (int n = 0; n < 2; ++n) { bgv[n] = *(const f32x4*)(bg + 4 * n); blv[n] = *(const f32x4*)(bl + 4 * n); sgv[n] = *(const f32x4*)(sg + 4 * n); slv[n] = *(const f32x4*)(sl + 4 * n); }
#pragma unroll
        for (int ai = 0; ai < 2; ++ai)
#pragma unroll
            for (int m = 0; m < 4; ++m) { const int l = l00 + ai * 128 + m * 16; const float hs = (l < cnt) ? hsv[ai][m] : 0.f;
                float r[8];
                const f32x2_t hs2 = (f32x2_t){hs, hs};
#pragma unroll
                for (int n = 0; n < 2; ++n) {
#pragma unroll
                    for (int i = 0; i < 4; i += 2) {
                        const f32x2_t ag = (f32x2_t){(float)acc[ai][0][m][n][i], (float)acc[ai][0][m][n][i + 1]}, al = (f32x2_t){(float)acc[ai][1][m][n][i], (float)acc[ai][1][m][n][i + 1]};
                        const f32x2_t g0 = ag * hs2 * (f32x2_t){sgv[n][i], sgv[n][i + 1]} + (f32x2_t){bgv[n][i], bgv[n][i + 1]}, l0 = al * hs2 * (f32x2_t){slv[n][i], slv[n][i + 1]} + (f32x2_t){blv[n][i], blv[n][i + 1]};
                        const f32x2_t g = (f32x2_t){fminf(g0[0], 7.0f), fminf(g0[1], 7.0f)}, l1 = (f32x2_t){fminf(fmaxf(l0[0], -7.0f), 7.0f), fminf(fmaxf(l0[1], -7.0f), 7.0f)};
                        const f32x2_t ex = g * (f32x2_t){-1.702f * 1.44269504f, -1.702f * 1.44269504f};
                        const f32x2_t den = (f32x2_t){__builtin_amdgcn_exp2f(ex[0]), __builtin_amdgcn_exp2f(ex[1])} + (f32x2_t){1.f, 1.f};
                        const f32x2_t rc = (f32x2_t){__builtin_amdgcn_rcpf(den[0]), __builtin_amdgcn_rcpf(den[1])};
                        const f32x2_t o = g * rc * (l1 + (f32x2_t){1.f, 1.f});
                        r[4 * n + i] = o[0]; r[4 * n + i + 1] = o[1]; } }
                unsigned w0 = __builtin_amdgcn_cvt_pk_fp8_f32(r[0], r[1], 0u, false); w0 = __builtin_amdgcn_cvt_pk_fp8_f32(r[2], r[3], w0, true);
                unsigned w1 = __builtin_amdgcn_cvt_pk_fp8_f32(r[4], r[5], 0u, false); w1 = __builtin_amdgcn_cvt_pk_fp8_f32(r[6], r[7], w1, true);
                *(v2u*)(act + (size_t)(row0 + ai * 128 + m * 16) * DFF + colw) = (v2u){w0, w1}; }
    }
};
struct EpiDown {
    typedef pg8::MmaFp8 Mma; static constexpr bool PERM = true, AFTER_DRAIN = false;
    unsigned char* slot; const int* lslot; const float* lgate; const float* b_down; const LAS int* P;
    __device__ __forceinline__ void operator()(const f32x4 (&acc)[2][2][4][2], const pg8::Unit& u, int wr, int wc, int fr, int fq) const {
        const int l00 = u.l0 + wr * 64 + fr, col0 = u.pn * 256 + wc * 32 + 8 * fq, cnt = P[PL_CNT + u.e];
        const float* bb = b_down + (size_t)u.e * 1024 + col0;
        f32x4 bv[2][2];
#pragma unroll
        for (int bj = 0; bj < 2; ++bj)
#pragma unroll
            for (int n = 0; n < 2; ++n) bv[bj][n] = *(const f32x4*)(bb + bj * 128 + 4 * n);
        int sx[2][4]; float gx[2][4];
#pragma unroll
        for (int ai = 0; ai < 2; ++ai)
#pragma unroll
            for (int m = 0; m < 4; ++m) { const int l = l00 + ai * 128 + m * 16; sx[ai][m] = lslot[u.e * T + l]; gx[ai][m] = lgate[u.e * T + l]; }
#pragma unroll
        for (int ai = 0; ai < 2; ++ai)
#pragma unroll
            for (int m = 0; m < 4; ++m) { const int l = l00 + ai * 128 + m * 16;
                if (l < cnt) { const int sidx = sx[ai][m]; const float gt = gx[ai][m];
#pragma unroll
                    for (int bj = 0; bj < 2; ++bj) { const f32x4 v0 = (acc[ai][bj][m][0] * (1.f / 64.f) + bv[bj][0]) * (gt * 16.f), v1 = (acc[ai][bj][m][1] * (1.f / 64.f) + bv[bj][1]) * (gt * 16.f);
                        unsigned w0 = __builtin_amdgcn_cvt_pk_fp8_f32(v0[0], v0[1], 0u, false); w0 = __builtin_amdgcn_cvt_pk_fp8_f32(v0[2], v0[3], w0, true);
                        unsigned w1 = __builtin_amdgcn_cvt_pk_fp8_f32(v1[0], v1[1], 0u, false); w1 = __builtin_amdgcn_cvt_pk_fp8_f32(v1[2], v1[3], w1, true);
                        *(v2u*)(slot + (size_t)sidx * 1024 + col0 + bj * 128) = (v2u){w0, w1}; } } }
    }
};

__device__ __forceinline__ void p0_transpose_item(const float* W, int ldw, int K, bf16* WT, int src_col0, int dst_row0, int k0, LAS float* scr, int lane) {
#pragma unroll 8
    for (int i = 0; i < 32; ++i) { const int kk = 2 * i + (lane >> 5); scr[kk * 33 + (lane & 31)] = W[(size_t)(k0 + kk) * ldw + src_col0 + (lane & 31)]; }
    LDS_WAIT(); asm volatile("" ::: "memory");
    const int c = lane & 7;
#pragma unroll
    for (int j = 0; j < 4; ++j) { const int n = (lane >> 3) + 8 * j; const LAS float* s = scr + (8 * c) * 33 + n;
        v4u o; o.x = pk2(s[0 * 33], s[1 * 33]); o.y = pk2(s[2 * 33], s[3 * 33]); o.z = pk2(s[4 * 33], s[5 * 33]); o.w = pk2(s[6 * 33], s[7 * 33]);
        *(GAS v4u*)(WT + (size_t)(dst_row0 + n) * K + k0 + 8 * c) = o; }
    LDS_WAIT(); asm volatile("" ::: "memory");
}
__device__ __forceinline__ void p0_prologue(Frame& F) {
    LAS float* scr = (LAS float*)(F.lds + F.wave * 14336);
    if ((int)blockIdx.x < 48 && F.G > 96) return;
    const int first = (F.G > 96) ? 48 : 0, gw = ((int)blockIdx.x - first) * NWAVES + F.wave, NGW = (F.G - first) * NWAVES;
    for (int e = (int)blockIdx.x - first; e < 32; e += F.G - first) {
        bf16* img = F.wrimg();
        for (int k = F.tid; k < 1024; k += NWAVES * 64) { const float w = F.w_router[k * 32 + e]; const unsigned hi = pk2(w, 0.f) & 0xffffu; const float rem = w - __uint_as_float(hi << 16);
            img[e * WR_STRIDE + k] = (bf16)hi; img[(32 + e) * WR_STRIDE + k] = (bf16)(pk2(rem, 0.f) & 0xffffu); } }
    LAS float* SCL = (LAS float*)(F.lds + 8 * 16384 - 16384);
    __syncthreads();
    for (int i = F.tid; i < 4096; i += NWAVES * 64) { const int bb = i >> 10, k = i & 1023; SCL[k * 4 + bb] = siluf(F.c[i]); }
    __syncthreads();
    for (int it0 = gw; it0 < 96 * KSPLIT; it0 += 2 * NGW) {
        const int it1 = it0 + NGW; const bool two = it1 < 96 * KSPLIT;
        const int s0 = it0 % 96, q0 = it0 / 96, c0 = s0 * 64 + F.lane, s1 = two ? it1 % 96 : s0, q1 = two ? it1 / 96 : q0, c1 = s1 * 64 + F.lane;
        float w0[32], w1[32];
#pragma unroll
        for (int k = 0; k < 32; ++k) w0[k] = F.w_ada[(size_t)(q0 * 32 + k) * 6144 + c0];
        if (two) {
#pragma unroll
            for (int k = 0; k < 32; ++k) w1[k] = F.w_ada[(size_t)(q1 * 32 + k) * 6144 + c1]; }
        { f32x4 a = (f32x4){0.f, 0.f, 0.f, 0.f};
#pragma unroll
          for (int k = 0; k < 32; ++k) a = a + *(const LAS f32x4*)(SCL + (q0 * 32 + k) * 4) * w0[k];
          float* mp = F.modp() + (size_t)c0 * KSPLIT + q0; mp[0] = a.x; mp[(size_t)6144 * KSPLIT] = a.y; mp[(size_t)2 * 6144 * KSPLIT] = a.z; mp[(size_t)3 * 6144 * KSPLIT] = a.w; }
        if (two) { f32x4 a = (f32x4){0.f, 0.f, 0.f, 0.f};
#pragma unroll
          for (int k = 0; k < 32; ++k) a = a + *(const LAS f32x4*)(SCL + (q1 * 32 + k) * 4) * w1[k];
          float* mp = F.modp() + (size_t)c1 * KSPLIT + q1; mp[0] = a.x; mp[(size_t)6144 * KSPLIT] = a.y; mp[(size_t)2 * 6144 * KSPLIT] = a.z; mp[(size_t)3 * 6144 * KSPLIT] = a.w; }
    }
    __syncthreads();
    constexpr int I_IN = 0, I_OUT = 16 * 32, NITEMS = I_IN + I_OUT;
    for (int it = gw; it < NITEMS; it += NGW) {
        int r = it;
        { const int kb = r / 32, nb = r % 32; p0_transpose_item(F.w_out, D, D, F.Wout_t(), 32 * nb, 32 * nb, 64 * kb, scr, F.lane); }
    }
}
__device__ __forceinline__ void transpose64_item(const float* W, int ldw, int K, bf16* WT, int src_col0, int dst_row0, int k0, LAS float* scr, int lane) {
    const int r4 = lane >> 4, cg = lane & 15;
    f32x4 v[16];
#pragma unroll
    for (int i = 0; i < 16; ++i) v[i] = *(const GAS f32x4*)(W + (size_t)(k0 + 4 * i + r4) * ldw + src_col0 + 4 * cg);
#pragma unroll
    for (int i = 0; i < 16; ++i) { LAS float* p = scr + (4 * i + r4) * 65 + 4 * cg; p[0] = v[i].x; p[1] = v[i].y; p[2] = v[i].z; p[3] = v[i].w; }
    LDS_WAIT(); asm volatile("" ::: "memory");
    const int c = lane & 7;
#pragma unroll
    for (int j = 0; j < 8; ++j) { const int n = (lane >> 3) + 8 * j; const LAS float* sp = scr + (8 * c) * 65 + n;
        v4u o; o.x = pk2(sp[0 * 65], sp[1 * 65]); o.y = pk2(sp[2 * 65], sp[3 * 65]); o.z = pk2(sp[4 * 65], sp[5 * 65]); o.w = pk2(sp[6 * 65], sp[7 * 65]);
        *(GAS v4u*)(WT + (size_t)(dst_row0 + n) * K + k0 + 8 * c) = o; }
    LDS_WAIT(); asm volatile("" ::: "memory");
}
__device__ __forceinline__ void quant_strip(Frame& F, const float* W, const int ldw, signed char* out8, float* sout) {
    const int lane = F.lane, r4 = lane >> 4, cg = lane & 15;
    LAS float* scr = (LAS float*)(F.lds + F.wave * 16640); LAS float* cmax = (LAS float*)(F.lds + 8 * 16640); LAS float* scl = cmax + 512;
    __syncthreads();
    f32x4 v[2][16];
#pragma unroll
    for (int tt = 0; tt < 2; ++tt) { const int k0 = 64 * (F.wave + 8 * tt);
#pragma unroll
        for (int i = 0; i < 16; ++i) v[tt][i] = *(const GAS f32x4*)(W + (size_t)(k0 + 4 * i + r4) * ldw + 4 * cg); }
    float m0 = 0.f, m1 = 0.f, m2 = 0.f, m3 = 0.f;
#pragma unroll
    for (int tt = 0; tt < 2; ++tt)
#pragma unroll
        for (int i = 0; i < 16; ++i) { m0 = fmaxf(m0, fabsf(v[tt][i].x)); m1 = fmaxf(m1, fabsf(v[tt][i].y)); m2 = fmaxf(m2, fabsf(v[tt][i].z)); m3 = fmaxf(m3, fabsf(v[tt][i].w)); }
    m0 = fmaxf(m0, __shfl_xor(m0, 16)); m0 = fmaxf(m0, __shfl_xor(m0, 32)); m1 = fmaxf(m1, __shfl_xor(m1, 16)); m1 = fmaxf(m1, __shfl_xor(m1, 32));
    m2 = fmaxf(m2, __shfl_xor(m2, 16)); m2 = fmaxf(m2, __shfl_xor(m2, 32)); m3 = fmaxf(m3, __shfl_xor(m3, 16)); m3 = fmaxf(m3, __shfl_xor(m3, 32));
    if (r4 == 0) { LAS float* cm = cmax + F.wave * 64 + 4 * cg; cm[0] = m0; cm[1] = m1; cm[2] = m2; cm[3] = m3; }
    __syncthreads();
    if (F.tid < 64) { float m = 1e-30f;
#pragma unroll
        for (int w = 0; w < 8; ++w) m = fmaxf(m, cmax[w * 64 + F.tid]);
        scl[F.tid] = 127.f / m; sout[F.tid] = m * (1.f / 127.f); }
    __syncthreads();
#pragma unroll
    for (int tt = 0; tt < 2; ++tt) { const int k0 = 64 * (F.wave + 8 * tt);
#pragma unroll
        for (int i = 0; i < 16; ++i) { LAS float* p = scr + (4 * i + r4) * 65 + 4 * cg; p[0] = v[tt][i].x; p[1] = v[tt][i].y; p[2] = v[tt][i].z; p[3] = v[tt][i].w; }
        LDS_WAIT(); asm volatile("" ::: "memory");
        const int c = lane & 7;
#pragma unroll
        for (int jj = 0; jj < 8; ++jj) { const int n = (lane >> 3) + 8 * jj; const LAS float* sp = scr + (8 * c) * 65 + n; const float q = scl[n];
            const int q0 = (int)rintf(sp[0 * 65] * q), q1 = (int)rintf(sp[1 * 65] * q), q2 = (int)rintf(sp[2 * 65] * q), q3 = (int)rintf(sp[3 * 65] * q), q4 = (int)rintf(sp[4 * 65] * q), q5 = (int)rintf(sp[5 * 65] * q), q6 = (int)rintf(sp[6 * 65] * q), q7 = (int)rintf(sp[7 * 65] * q);
            const unsigned lo = (unsigned)(q0 & 255) | ((unsigned)(q1 & 255) << 8) | ((unsigned)(q2 & 255) << 16) | ((unsigned)(q3 & 255) << 24);
            const unsigned hi = (unsigned)(q4 & 255) | ((unsigned)(q5 & 255) << 8) | ((unsigned)(q6 & 255) << 16) | ((unsigned)(q7 & 255) << 24);
            *(GAS v2u*)(out8 + (size_t)n * 1024 + k0 + 8 * c) = (v2u){lo, hi}; }
        LDS_WAIT(); asm volatile("" ::: "memory"); }
}
__device__ __forceinline__ void quant_up_item(Frame& F, int it) {
    const int e = it >> 5, strip = it & 31, dr = 64 * strip, pn = dr >> 8, bj = (dr >> 7) & 1, j = dr & 127;
    quant_strip(F, F.w_up + (size_t)e * 1024 * 2048 + bj * 1024 + pn * 128 + j, 2048, F.Wup8() + ((size_t)e * 2048 + dr) * 1024, F.upscale() + (size_t)e * 2048 + dr);
}
__device__ __forceinline__ void quant_up_pipe(Frame& F, int first) {
    const int lane = F.lane, r4 = lane >> 4, cg = lane & 15, step = F.G - first; const unsigned voff = (unsigned)(r4 * 8192 + 16 * cg);
    LAS float* scr = (LAS float*)(F.lds + F.wave * 16640); LAS float* cmax = (LAS float*)(F.lds + 8 * 16640); LAS float* scl = cmax + 512;
    int it = (int)blockIdx.x - first;
    if (it >= 32 * 32) return;
    __syncthreads();
    f32x4 v[2][16];
    const float* W; { const int e = it >> 5, dr = 64 * (it & 31); W = F.w_up + (size_t)e * 1024 * 2048 + ((dr >> 7) & 1) * 1024 + (dr >> 8) * 128 + (dr & 127); }
#pragma unroll
    for (int tt = 0; tt < 2; ++tt) { const int k0 = 64 * (F.wave + 8 * tt);
#pragma unroll
        for (int i = 0; i < 16; ++i) v[tt][i] = *(const GAS f32x4*)((const GAS char*)(W + (size_t)(k0 + 4 * i) * 2048) + voff); }
    for (;;) {
        const int e = it >> 5, dr = 64 * (it & 31), nit = it + step; const bool more = nit < 32 * 32;
        signed char* out8 = F.Wup8() + ((size_t)e * 2048 + dr) * 1024; float* sout = F.upscale() + (size_t)e * 2048 + dr;
        { const int en = nit >> 5, drn = 64 * (nit & 31); W = F.w_up + (size_t)en * 1024 * 2048 + ((drn >> 7) & 1) * 1024 + (drn >> 8) * 128 + (drn & 127); }
        float m0 = 0.f, m1 = 0.f, m2 = 0.f, m3 = 0.f;
#pragma unroll
        for (int tt = 0; tt < 2; ++tt)
#pragma unroll
            for (int i = 0; i < 16; ++i) { m0 = fmaxf(m0, fabsf(v[tt][i].x)); m1 = fmaxf(m1, fabsf(v[tt][i].y)); m2 = fmaxf(m2, fabsf(v[tt][i].z)); m3 = fmaxf(m3, fabsf(v[tt][i].w)); }
        m0 = fmaxf(m0, __shfl_xor(m0, 16)); m0 = fmaxf(m0, __shfl_xor(m0, 32)); m1 = fmaxf(m1, __shfl_xor(m1, 16)); m1 = fmaxf(m1, __shfl_xor(m1, 32));
        m2 = fmaxf(m2, __shfl_xor(m2, 16)); m2 = fmaxf(m2, __shfl_xor(m2, 32)); m3 = fmaxf(m3, __shfl_xor(m3, 16)); m3 = fmaxf(m3, __shfl_xor(m3, 32));
        if (r4 == 0) { LAS float* cm = cmax + F.wave * 64 + 4 * cg; cm[0] = m0; cm[1] = m1; cm[2] = m2; cm[3] = m3; }
        __syncthreads();
        if (F.tid < 64) { float m = 1e-30f;
#pragma unroll
            for (int w = 0; w < 8; ++w) m = fmaxf(m, cmax[w * 64 + F.tid]);
            scl[F.tid] = 127.f / m; sout[F.tid] = m * (1.f / 127.f); }
        __syncthreads();
#pragma unroll
        for (int tt = 0; tt < 2; ++tt) { const int k0 = 64 * (F.wave + 8 * tt);
#pragma unroll
            for (int i = 0; i < 16; ++i) { LAS float* p = scr + (4 * i + r4) * 65 + 4 * cg; p[0] = v[tt][i].x; p[1] = v[tt][i].y; p[2] = v[tt][i].z; p[3] = v[tt][i].w; }
            LDS_WAIT(); asm volatile("" ::: "memory");
            if (more) {
#pragma unroll
                for (int i = 0; i < 16; ++i) v[tt][i] = *(const GAS f32x4*)((const GAS char*)(W + (size_t)(k0 + 4 * i) * 2048) + voff); }
            const int c = lane & 7;
#pragma unroll
            for (int jj = 0; jj < 8; ++jj) { const int n = (lane >> 3) + 8 * jj; const LAS float* sp = scr + (8 * c) * 65 + n; const float q = scl[n];
                const int q0 = (int)rintf(sp[0 * 65] * q), q1 = (int)rintf(sp[1 * 65] * q), q2 = (int)rintf(sp[2 * 65] * q), q3 = (int)rintf(sp[3 * 65] * q), q4 = (int)rintf(sp[4 * 65] * q), q5 = (int)rintf(sp[5 * 65] * q), q6 = (int)rintf(sp[6 * 65] * q), q7 = (int)rintf(sp[7 * 65] * q);
                const unsigned lo = (unsigned)(q0 & 255) | ((unsigned)(q1 & 255) << 8) | ((unsigned)(q2 & 255) << 16) | ((unsigned)(q3 & 255) << 24);
                const unsigned hi = (unsigned)(q4 & 255) | ((unsigned)(q5 & 255) << 8) | ((unsigned)(q6 & 255) << 16) | ((unsigned)(q7 & 255) << 24);
                *(GAS v2u*)(out8 + (size_t)n * 1024 + k0 + 8 * c) = (v2u){lo, hi}; }
            LDS_WAIT(); asm volatile("" ::: "memory"); }
        if (!more) break;
        it = nit;
    }
}
__device__ __forceinline__ void quant_in_item(Frame& F, int strip) {
    const int dr = 64 * strip, sc = dr < 2048 ? dr : (dr < 2816 ? dr + 8 : dr - 2816 + 2048);
    quant_strip(F, F.w_in + sc, IN_COLS, F.Win8() + (size_t)dr * 1024, F.inscale() + dr);
}
__device__ __forceinline__ void transpose64_fp8_item(const float* W, int ldw, unsigned char* WT, int src_col0, int dst_row0, int k0, LAS float* scr, int lane) {
    const int r4 = lane >> 4, cg = lane & 15;
    f32x4 v[16];
#pragma unroll
    for (int i = 0; i < 16; ++i) v[i] = *(const GAS f32x4*)(W + (size_t)(k0 + 4 * i + r4) * ldw + src_col0 + 4 * cg);
#pragma unroll
    for (int i = 0; i < 16; ++i) { LAS float* p = scr + (4 * i + r4) * 65 + 4 * cg; p[0] = v[i].x * 64.f; p[1] = v[i].y * 64.f; p[2] = v[i].z * 64.f; p[3] = v[i].w * 64.f; }
    LDS_WAIT(); asm volatile("" ::: "memory");
    const int c = lane & 7;
#pragma unroll
    for (int j = 0; j < 8; ++j) { const int n = (lane >> 3) + 8 * j; const LAS float* sp = scr + (8 * c) * 65 + n;
        unsigned w0 = __builtin_amdgcn_cvt_pk_fp8_f32(sp[0 * 65], sp[1 * 65], 0u, false); w0 = __builtin_amdgcn_cvt_pk_fp8_f32(sp[2 * 65], sp[3 * 65], w0, true);
        unsigned w1 = __builtin_amdgcn_cvt_pk_fp8_f32(sp[4 * 65], sp[5 * 65], 0u, false); w1 = __builtin_amdgcn_cvt_pk_fp8_f32(sp[6 * 65], sp[7 * 65], w1, true);
        *(GAS v2u*)(WT + (size_t)(dst_row0 + n) * 1024 + k0 + 8 * c) = (v2u){w0, w1}; }
    LDS_WAIT(); asm volatile("" ::: "memory");
}
__device__ __forceinline__ void expert_transposes(Frame& F, int first) {
    quant_up_pipe(F, first);
    __syncthreads();
    LAS float* scr = (LAS float*)(F.lds + F.wave * 16640);
    const int gw = ((int)blockIdx.x - first) * NWAVES + F.wave, NGW = (F.G - first) * NWAVES;
    { const int lane = F.lane, r4 = lane >> 4, cg = lane & 15, c = lane & 7; const unsigned voff = (unsigned)(r4 * 4096 + 16 * cg);
      int r = gw;
      if (r < 32 * 256) {
        f32x4 v[16];
        { const int e = r >> 8, rr = r & 255, kb = rr >> 4, nb = rr & 15; const float* W = F.w_down + (size_t)e * 1024 * 1024 + (size_t)(64 * kb) * 1024 + 64 * nb;
#pragma unroll
          for (int i = 0; i < 16; ++i) v[i] = *(const GAS f32x4*)((const GAS char*)(W + (size_t)(4 * i) * 1024) + voff); }
        for (;;) {
            const int e = r >> 8, rr = r & 255, kb = rr >> 4, nb = rr & 15, rn = r + NGW; const bool more = rn < 32 * 256;
            unsigned char* WT = (unsigned char*)F.Wdn_t() + (size_t)e * 1024 * 1024 + (size_t)(64 * nb) * 1024 + 64 * kb;
#pragma unroll
            for (int i = 0; i < 16; ++i) { LAS float* p = scr + (4 * i + r4) * 65 + 4 * cg; p[0] = v[i].x * 64.f; p[1] = v[i].y * 64.f; p[2] = v[i].z * 64.f; p[3] = v[i].w * 64.f; }
            LDS_WAIT(); asm volatile("" ::: "memory");
            if (more) { const int en = rn >> 8, rrn = rn & 255, kbn = rrn >> 4, nbn = rrn & 15; const float* W = F.w_down + (size_t)en * 1024 * 1024 + (size_t)(64 * kbn) * 1024 + 64 * nbn;
#pragma unroll
                for (int i = 0; i < 16; ++i) v[i] = *(const GAS f32x4*)((const GAS char*)(W + (size_t)(4 * i) * 1024) + voff); }
#pragma unroll
            for (int j = 0; j < 8; ++j) { const int n = (lane >> 3) + 8 * j; const LAS float* sp = scr + (8 * c) * 65 + n;
                unsigned w0 = __builtin_amdgcn_cvt_pk_fp8_f32(sp[0 * 65], sp[1 * 65], 0u, false); w0 = __builtin_amdgcn_cvt_pk_fp8_f32(sp[2 * 65], sp[3 * 65], w0, true);
                unsigned w1 = __builtin_amdgcn_cvt_pk_fp8_f32(sp[4 * 65], sp[5 * 65], 0u, false); w1 = __builtin_amdgcn_cvt_pk_fp8_f32(sp[6 * 65], sp[7 * 65], w1, true);
                *(GAS v2u*)(WT + (size_t)n * 1024 + 8 * c) = (v2u){w0, w1}; }
            LDS_WAIT(); asm volatile("" ::: "memory");
            if (!more) break;
            r = rn;
        } } }
}

__device__ __forceinline__ float mod_sum(Frame& F, int b, int col) {
    const f32x4* p = (const f32x4*)(F.modp() + ((size_t)b * 6144 + col) * KSPLIT); f32x4 a = p[0];
#pragma unroll
    for (int i = 1; i < KSPLIT / 4; ++i) a = a + p[i];
    return F.b_ada[col] + ((a.x + a.y) + (a.z + a.w));
}
__device__ __forceinline__ void mod_tables(Frame& F, LAS float* A, LAS float* Bv, const float* norm_w, int b, int sh_col) {
    for (int k = F.tid; k < 1024; k += NWAVES * 64) { A[k] = norm_w[k] * (1.f + mod_sum(F, b, sh_col + 1024 + k)); Bv[k] = mod_sum(F, b, sh_col + k); }
}
__device__ __forceinline__ void p1_hrows(Frame& F) {
    LAS float* A1 = (LAS float*)F.lds; LAS float* B1 = A1 + 1024;
    f32x4 xv[8][4];
    if ((int)blockIdx.x < 256) {
#pragma unroll
        for (int i = 0; i < 8; ++i) { const GAS f32x4* xr = (const GAS f32x4*)(F.x + (size_t)((int)blockIdx.x * 64 + F.wave + 8 * i) * D) + F.lane;
#pragma unroll
            for (int j = 0; j < 4; ++j) xv[i][j] = xr[64 * j]; } }
    for (int blk = blockIdx.x; blk < 256; blk += F.G) {
        if (F.tid < 96) { const int idx = blk * 96 + F.tid; F.modf()[idx] = mod_sum(F, idx / 6144, idx % 6144); }
        else if (F.tid < 128) { const int idx = blk * 32 + F.tid - 96, b2 = idx >> 11, k = idx & 1023;
            if (((idx >> 10) & 1) == 0) F.modf()[32768 + b2 * 1024 + k] = F.norm2_w[k] * (1.f + mod_sum(F, b2, 4096 + k)); else F.modf()[32768 + 4096 + b2 * 1024 + k] = mod_sum(F, b2, 3072 + k); } }
    for (int rg = blockIdx.x; rg < 256; rg += F.G) {
        const int b = rg >> 6;
        __syncthreads();
        mod_tables(F, A1, B1, F.norm1_w, b, 0);
        __syncthreads();
        if (rg != (int)blockIdx.x) {
#pragma unroll
            for (int i = 0; i < 8; ++i) { const GAS f32x4* xr = (const GAS f32x4*)(F.x + (size_t)(rg * 64 + F.wave + 8 * i) * D) + F.lane;
#pragma unroll
                for (int j = 0; j < 4; ++j) xv[i][j] = xr[64 * j]; } }
#pragma unroll
        for (int ri = 0; ri < 8; ++ri) { const int rr = F.wave + 8 * ri;
            const int t = rg * 64 + rr;
            f32x4 v[4];
#pragma unroll
            for (int j = 0; j < 4; ++j) v[j] = xv[ri][j];
            float ss = 0.f;
#pragma unroll
            for (int j = 0; j < 4; ++j) ss += (v[j].x * v[j].x + v[j].y * v[j].y) + (v[j].z * v[j].z + v[j].w * v[j].w);
            const float rstd = rsqrtf(wave_sum(ss) * (1.f / D) + EPS);
            f32x4 hv[4]; float am = 0.f;
#pragma unroll
            for (int j = 0; j < 4; ++j) { const int k = 4 * F.lane + 256 * j;
                const f32x4 a = *(const LAS f32x4*)(A1 + k), bb = *(const LAS f32x4*)(B1 + k);
                hv[j] = v[j] * rstd * a + bb; am = fmaxf(fmaxf(am, fmaxf(fabsf(hv[j].x), fabsf(hv[j].y))), fmaxf(fabsf(hv[j].z), fabsf(hv[j].w))); }
#pragma unroll
            for (int o = 1; o < 64; o <<= 1) am = fmaxf(am, __shfl_xor(am, o));
            am = fmaxf(am, 1e-30f); const float qs = 127.f / am; if (F.lane == 0) F.hscale1()[t] = am * (1.f / 127.f);
            GAS unsigned* o4 = (GAS unsigned*)(F.Hq() + (size_t)t * D) + F.lane;
#pragma unroll
            for (int j = 0; j < 4; ++j) { const int q0 = (int)rintf(hv[j].x * qs), q1 = (int)rintf(hv[j].y * qs), q2 = (int)rintf(hv[j].z * qs), q3 = (int)rintf(hv[j].w * qs);
                o4[64 * j] = (unsigned)(q0 & 255) | ((unsigned)(q1 & 255) << 8) | ((unsigned)(q2 & 255) << 16) | ((unsigned)(q3 & 255) << 24); }
        }
    }
}

__device__ __forceinline__ bf16x8 lda_frag(const LAS unsigned char* p) {
    const v2u lo = *(const LAS v2u*)p, hi = *(const LAS v2u*)(p + 32);
    const v4u w = (v4u){lo.x, lo.y, hi.x, hi.y}; return __builtin_bit_cast(bf16x8, w);
}
__device__ __forceinline__ bf16x8 pack_frag(const f32x4 a, const f32x4 b) { const v4u w = (v4u){pk2(a.x, a.y), pk2(a.z, a.w), pk2(b.x, b.y), pk2(b.z, b.w)}; return __builtin_bit_cast(bf16x8, w); }
constexpr int PQ_OFF = 0, PK_OFF = 17408, PKT_OFF = 34816, PVT_OFF = 53248, PAF_OFF = 71680, PTF_OFF = 88320, PTU_OFF = 104960, PTW_OFF = 114176, PMF_OFF = 123392, PSC_OFF = 129536;
__device__ __forceinline__ void dn_prep_item(Frame& F, int item, bool loadcw) {
    const int b = item >> 8, n = (item >> 2) & 63, h = item & 3, t0 = b * SEQ + n * CH, tid = F.tid, lane = F.lane, r16 = lane & 15, q4 = lane >> 4, wv = F.wave;
    LAS unsigned char* L = F.lds;
    LAS bf16* Qr = (LAS bf16*)(L + PQ_OFF); LAS bf16* Kr = (LAS bf16*)(L + PK_OFF); LAS bf16* Kt = (LAS bf16*)(L + PKT_OFF); LAS bf16* Vt = (LAS bf16*)(L + PVT_OFF);
    LAS float* Af = (LAS float*)(L + PAF_OFF); LAS float* Tf = (LAS float*)(L + PTF_OFF); LAS bf16* Tu = (LAS bf16*)(L + PTU_OFF); LAS bf16* Tw = (LAS bf16*)(L + PTW_OFF);
    LAS float* Mf = (LAS float*)(L + PMF_OFF); LAS float* gc = (LAS float*)(L + PSC_OFF); LAS float* bt = gc + 64; LAS float* eg = bt + 64; LAS float* e2 = eg + 64;
    unsigned char* img = F.dnimg() + (size_t)item * IMG_BYTES;
    __syncthreads();
    const int g16 = tid >> 4, l16 = tid & 15, cp = g16 >> 3, r8 = 8 * (g16 & 7), chan0 = cp * 512 + h * 128 + 8 * l16;
    v4u cin[11];
    if (g16 < 24) {
#pragma unroll
        for (int jj = 0; jj < 11; ++jj) { const int pos = n * CH + r8 - 3 + jj; cin[jj] = (v4u){0u, 0u, 0u, 0u}; if (pos >= 0) cin[jj] = *(const v4u*)(F.PROJ() + (size_t)(b * SEQ + pos) * NPROJ + chan0); }
    }
    LAS float* CWL = (LAS float*)(L + PSC_OFF + 1024);
    if (loadcw && tid < 384) { const int cpw = tid >> 7, rem = tid & 127, lw = rem >> 3, jw = (rem >> 1) & 3, hw = rem & 1;
        *(LAS f32x4*)(CWL + (cpw * 16 + lw) * 32 + jw * 8 + 4 * hw) = *(const f32x4*)(F.conv_w + jw * 1536 + cpw * 512 + h * 128 + 8 * lw + 4 * hw); }
    if (wv == 0) { const bf16* pab = F.PROJ() + (size_t)(t0 + lane) * NPROJ + PC_AB + h; const float za = bf2f(pab[0]) + F.dt_bias[h], zb = bf2f(pab[4]);
        float g = -__expf(F.a_log[h]) * (fmaxf(za, 0.f) + log1pf(__expf(-fabsf(za))));
#pragma unroll
        for (int o = 1; o < 64; o <<= 1) { const float tt = __shfl_up(g, o); if (lane >= o) g += tt; }
        const float gl = __shfl(g, 63);
        gc[lane] = g; bt[lane] = 1.f / (1.f + __expf(-zb)); eg[lane] = __expf(g); e2[lane] = __expf(gl - g);
        if (lane == 63) { const float dcy = __expf(gl); st_wt4(img + GI_U + 128, __float_as_uint(dcy)); st_wt4(img + GI_U + IMG_UHALF + 128, __float_as_uint(dcy)); } }
    for (int i = tid; i < 64 * 65; i += NWAVES * 64) Tf[i] = 0.f;
    __syncthreads();
    if (g16 < 24) {
#pragma unroll
      for (int rp = 0; rp < 4; ++rp) { const int r0 = r8 + 2 * rp;
        float xin[5][8];
#pragma unroll
        for (int jj = 0; jj < 5; ++jj) { const v4u w = cin[2 * rp + jj];
            xin[jj][0] = bflo(w.x); xin[jj][1] = bfhi(w.x); xin[jj][2] = bflo(w.y); xin[jj][3] = bfhi(w.y); xin[jj][4] = bflo(w.z); xin[jj][5] = bfhi(w.z); xin[jj][6] = bflo(w.w); xin[jj][7] = bfhi(w.w); }
        float y0[8], y1[8];
#pragma unroll
        for (int i = 0; i < 8; ++i) { y0[i] = 0.f; y1[i] = 0.f; }
#pragma unroll
        for (int j = 0; j < 4; ++j) { const f32x4 ca = *(const LAS f32x4*)(CWL + (cp * 16 + l16) * 32 + j * 8), cb = *(const LAS f32x4*)(CWL + (cp * 16 + l16) * 32 + j * 8 + 4); const float cw[8] = {ca.x, ca.y, ca.z, ca.w, cb.x, cb.y, cb.z, cb.w};
#pragma unroll
            for (int i = 0; i < 8; ++i) { y0[i] += cw[i] * xin[j][i]; y1[i] += cw[i] * xin[j + 1][i]; } }
        float s0 = 0.f, s1 = 0.f;
#pragma unroll
        for (int i = 0; i < 8; ++i) { y0[i] = siluf(y0[i]); y1[i] = siluf(y1[i]); s0 += y0[i] * y0[i]; s1 += y1[i] * y1[i]; }
        if (cp < 2) {
            s0 += __shfl_xor(s0, 1); s0 += __shfl_xor(s0, 2); s0 += __shfl_xor(s0, 4); s0 += __shfl_xor(s0, 8);
            s1 += __shfl_xor(s1, 1); s1 += __shfl_xor(s1, 2); s1 += __shfl_xor(s1, 4); s1 += __shfl_xor(s1, 8);
            const float f = (cp == 0) ? 0.08838834764831845f : 1.f, n0 = rsqrtf(s0 + EPS) * f, n1 = rsqrtf(s1 + EPS) * f;
#pragma unroll
            for (int i = 0; i < 8; ++i) { y0[i] *= n0; y1[i] *= n1; }
        }
        const v4u w0 = (v4u){pk2(y0[0], y0[1]), pk2(y0[2], y0[3]), pk2(y0[4], y0[5]), pk2(y0[6], y0[7])}, w1 = (v4u){pk2(y1[0], y1[1]), pk2(y1[2], y1[3]), pk2(y1[4], y1[5]), pk2(y1[6], y1[7])};
        if (cp == 0) { *(LAS v4u*)(Qr + r0 * 136 + 8 * l16) = w0; *(LAS v4u*)(Qr + (r0 + 1) * 136 + 8 * l16) = w1;
            const float g0 = eg[r0] * IMG_SC, g1 = eg[r0 + 1] * IMG_SC;
            unsigned char* q0p = img + IMG_Q / 2 + r0 * 136 + 8 * l16; unsigned char* q1p = q0p + 136;
            st_wt8(q0p, fp8x4(y0[0] * g0, y0[1] * g0, y0[2] * g0, y0[3] * g0), fp8x4(y0[4] * g0, y0[5] * g0, y0[6] * g0, y0[7] * g0));
            st_wt8(q1p, fp8x4(y1[0] * g1, y1[1] * g1, y1[2] * g1, y1[3] * g1), fp8x4(y1[4] * g1, y1[5] * g1, y1[6] * g1, y1[7] * g1)); }
        else if (cp == 1) { *(LAS v4u*)(Kr + r0 * 136 + 8 * l16) = w0; *(LAS v4u*)(Kr + (r0 + 1) * 136 + 8 * l16) = w1;
#pragma unroll
            for (int i = 0; i < 8; ++i) *(LAS unsigned*)(Kt + (8 * l16 + i) * 72 + r0) = pk2(y0[i], y1[i]); }
        else {
#pragma unroll
            for (int i = 0; i < 8; ++i) *(LAS unsigned*)(Vt + (8 * l16 + i) * 72 + r0) = pk2(y0[i], y1[i]); }
        __builtin_amdgcn_sched_barrier(0);
      } }
    __syncthreads();
    { const int dk = tid >> 2, cc = (tid & 3) * 16;
      const v4u ka = *(const LAS v4u*)(Kt + dk * 72 + cc), kb = *(const LAS v4u*)(Kt + dk * 72 + cc + 8);
      const unsigned kw[8] = {ka.x, ka.y, ka.z, ka.w, kb.x, kb.y, kb.z, kb.w};
      float kf[16];
#pragma unroll
      for (int i = 0; i < 8; ++i) { kf[2 * i] = bflo(kw[i]) * e2[cc + 2 * i] * IMG_SC; kf[2 * i + 1] = bfhi(kw[i]) * e2[cc + 2 * i + 1] * IMG_SC; }
      unsigned char* kp = img + IMG_K / 2 + dk * (IMG_KS / 2) + cc;
#pragma unroll
      for (int i = 0; i < 4; ++i) st_wt4(kp + 4 * i, fp8x4(kf[4 * i], kf[4 * i + 1], kf[4 * i + 2], kf[4 * i + 3])); }
    { const int mt = wv >> 1;
      bf16x8 ak[4];
#pragma unroll
      for (int ks = 0; ks < 4; ++ks) ak[ks] = *(const LAS bf16x8*)(Kr + (16 * mt + r16) * 136 + 32 * ks + 8 * q4);
#pragma unroll
      for (int u = 0; u < 2; ++u) { const int nt = 2 * (wv & 1) + u;
        f32x4 akk = (f32x4){0.f, 0.f, 0.f, 0.f}, aqk = (f32x4){0.f, 0.f, 0.f, 0.f};
#pragma unroll
        for (int ks = 0; ks < 4; ++ks) { const bf16x8 bk = *(const LAS bf16x8*)(Kr + (16 * nt + r16) * 136 + 32 * ks + 8 * q4), bq = *(const LAS bf16x8*)(Qr + (16 * nt + r16) * 136 + 32 * ks + 8 * q4);
            akk = __builtin_amdgcn_mfma_f32_16x16x32_bf16(ak[ks], bk, akk, 0, 0, 0); aqk = __builtin_amdgcn_mfma_f32_16x16x32_bf16(ak[ks], bq, aqk, 0, 0, 0); }
        const int col = 16 * nt + r16; const float gcol = gc[col]; float o[4];
#pragma unroll
        for (int i = 0; i < 4; ++i) { const int row = 16 * mt + 4 * q4 + i; const float grow = gc[row];
            Af[row * 65 + col] = (col < row) ? bt[row] * akk[i] * __expf(grow - gcol) : 0.f;
            o[i] = (row <= col) ? aqk[i] * __expf(gcol - grow) : 0.f; }
        st_wt4(img + IMG_A / 2 + col * (IMG_KS / 2) + 16 * mt + 4 * q4, fp8x4(o[0] * IMG_SC, o[1] * IMG_SC, o[2] * IMG_SC, o[3] * IMG_SC)); } }
    __syncthreads();
    if (tid < 64) { const int blk = tid >> 4, c = tid & 15; float x[16];
#pragma unroll
        for (int i = 0; i < 16; ++i) { float r = (i == c) ? 1.f : 0.f;
#pragma unroll
            for (int j = 0; j < i; ++j) r -= Af[(16 * blk + i) * 65 + 16 * blk + j] * x[j];
            x[i] = r; }
#pragma unroll
        for (int i = 0; i < 16; ++i) Tf[(16 * blk + i) * 65 + 16 * blk + c] = x[i]; }
    __syncthreads();
    if (wv < 2) { const int lo = 32 * wv; f32x4 m = (f32x4){0.f, 0.f, 0.f, 0.f};
#pragma unroll
      for (int ks = 0; ks < 4; ++ks) m = __builtin_amdgcn_mfma_f32_16x16x4f32(Af[(lo + 16 + r16) * 65 + lo + 4 * ks + q4], Tf[(lo + 4 * ks + q4) * 65 + lo + r16], m, 0, 0, 0);
#pragma unroll
      for (int i = 0; i < 4; ++i) Mf[wv * 272 + (4 * q4 + i) * 17 + r16] = m[i];
      LDS_WAIT(); asm volatile("" ::: "memory");
      f32x4 x = (f32x4){0.f, 0.f, 0.f, 0.f};
#pragma unroll
      for (int ks = 0; ks < 4; ++ks) x = __builtin_amdgcn_mfma_f32_16x16x4f32(Tf[(lo + 16 + r16) * 65 + lo + 16 + 4 * ks + q4], Mf[wv * 272 + (4 * ks + q4) * 17 + r16], x, 0, 0, 0);
#pragma unroll
      for (int i = 0; i < 4; ++i) Tf[(lo + 16 + 4 * q4 + i) * 65 + lo + r16] = -x[i]; }
    __syncthreads();
    { const int ti = (wv >> 1) & 1, tj = wv & 1; f32x4 m = (f32x4){0.f, 0.f, 0.f, 0.f};
      if (wv < 4) {
#pragma unroll
        for (int ks = 0; ks < 8; ++ks) m = __builtin_amdgcn_mfma_f32_16x16x4f32(Af[(32 + 16 * ti + r16) * 65 + 4 * ks + q4], Tf[(4 * ks + q4) * 65 + 16 * tj + r16], m, 0, 0, 0);
#pragma unroll
        for (int i = 0; i < 4; ++i) Mf[544 + (16 * ti + 4 * q4 + i) * 33 + 16 * tj + r16] = m[i]; }
      __syncthreads();
      if (wv < 4) { f32x4 x = (f32x4){0.f, 0.f, 0.f, 0.f};
#pragma unroll
        for (int ks = 0; ks < 8; ++ks) x = __builtin_amdgcn_mfma_f32_16x16x4f32(Tf[(32 + 16 * ti + r16) * 65 + 32 + 4 * ks + q4], Mf[544 + (4 * ks + q4) * 33 + 16 * tj + r16], x, 0, 0, 0);
#pragma unroll
        for (int i = 0; i < 4; ++i) Tf[(32 + 16 * ti + 4 * q4 + i) * 65 + 16 * tj + r16] = -x[i]; } }
    __syncthreads();
    for (int idx = tid; idx < 4096; idx += NWAVES * 64) { const int i = idx >> 6, c = idx & 63; const float tv = Tf[i * 65 + c] * bt[c];
        Tu[i * 72 + c] = (bf16)f2bf(tv); Tw[i * 72 + c] = (bf16)f2bf(tv * eg[c]); }
    __syncthreads();
    { bf16x8 bv[2], akt[2];
#pragma unroll
      for (int ks = 0; ks < 2; ++ks) { bv[ks] = *(const LAS bf16x8*)(Vt + (16 * wv + r16) * 72 + 32 * ks + 8 * q4); akt[ks] = *(const LAS bf16x8*)(Kt + (16 * wv + r16) * 72 + 32 * ks + 8 * q4); }
#pragma unroll
      for (int t4 = 0; t4 < 4; ++t4) {
        f32x4 au = (f32x4){0.f, 0.f, 0.f, 0.f}, aw = (f32x4){0.f, 0.f, 0.f, 0.f};
#pragma unroll
        for (int ks = 0; ks < 2; ++ks) { const bf16x8 tu = *(const LAS bf16x8*)(Tu + (16 * t4 + r16) * 72 + 32 * ks + 8 * q4), tw = *(const LAS bf16x8*)(Tw + (16 * t4 + r16) * 72 + 32 * ks + 8 * q4);
            au = __builtin_amdgcn_mfma_f32_16x16x32_bf16(tu, bv[ks], au, 0, 0, 0);
            aw = __builtin_amdgcn_mfma_f32_16x16x32_bf16(akt[ks], tw, aw, 0, 0, 0); }
        st_wt8(img + GI_U + (16 * wv + r16) * 136 + (16 * t4 + 4 * q4) * 2, pk2(au[0], au[1]), pk2(au[2], au[3]));
        st_wt4(img + IMG_W / 2 + (16 * t4 + r16) * 136 + 16 * wv + 4 * q4, fp8x4(aw[0] * IMG_SC, aw[1] * IMG_SC, aw[2] * IMG_SC, aw[3] * IMG_SC)); } }
    asm volatile("s_waitcnt vmcnt(0)" ::: "memory");
    __syncthreads();
    if (tid == 0) __hip_atomic_store(F.ctl + CW_FLAG + item, 1u, RLX_AGENT);
}
constexpr int SWK_STRIDE = 72, SWV_STRIDE = 264;
__device__ __forceinline__ void swa_item(Frame& F, int item) {
    const int b = item >> 6, nb = (item >> 1) & 31, kvh = item & 1, tid = F.tid, lane = F.lane, r16 = lane & 15, q4 = lane >> 4;
    LAS bf16* Ks = (LAS bf16*)F.lds; LAS bf16* Vt = Ks + 256 * SWK_STRIDE;
    const int g = F.wave & 3, qh = F.wave >> 2, hq = kvh * 4 + g;
    __syncthreads();
    v4u qa[4], qc[4];
#pragma unroll
    for (int m = 0; m < 4; ++m) { const bf16* qp = F.PROJ() + (size_t)(b * SEQ + nb * WIN + 64 * qh + 16 * m + r16) * NPROJ + PC_SQ + hq * 64 + 8 * q4; qa[m] = *(const v4u*)qp; qc[m] = *(const v4u*)(qp + 32); }
    const f32x4 qw0 = *(const f32x4*)(F.q_norm_w + 8 * q4), qw1 = *(const f32x4*)(F.q_norm_w + 8 * q4 + 4), qw2 = *(const f32x4*)(F.q_norm_w + 32 + 8 * q4), qw3 = *(const f32x4*)(F.q_norm_w + 32 + 8 * q4 + 4);
    const float sinkv = F.sinks[hq];
    {
        const int slot = tid >> 1, half = tid & 1, pos = nb * WIN - WIN + slot;
        float kv[32], vv[32]; float ss = 0.f;
        if (pos >= 0) {
            const v4u* kp = (const v4u*)(F.PROJ() + (size_t)(b * SEQ + pos) * NPROJ + PC_SK + kvh * 64 + half * 32);
            const v4u* vp = (const v4u*)(F.PROJ() + (size_t)(b * SEQ + pos) * NPROJ + PC_SV + kvh * 64 + half * 32);
#pragma unroll
            for (int i = 0; i < 4; ++i) { const v4u a = kp[i], c = vp[i];
                kv[8 * i + 0] = bflo(a.x); kv[8 * i + 1] = bfhi(a.x); kv[8 * i + 2] = bflo(a.y); kv[8 * i + 3] = bfhi(a.y); kv[8 * i + 4] = bflo(a.z); kv[8 * i + 5] = bfhi(a.z); kv[8 * i + 6] = bflo(a.w); kv[8 * i + 7] = bfhi(a.w);
                vv[8 * i + 0] = bflo(c.x); vv[8 * i + 1] = bfhi(c.x); vv[8 * i + 2] = bflo(c.y); vv[8 * i + 3] = bfhi(c.y); vv[8 * i + 4] = bflo(c.z); vv[8 * i + 5] = bfhi(c.z); vv[8 * i + 6] = bflo(c.w); vv[8 * i + 7] = bfhi(c.w); }
        } else {
#pragma unroll
            for (int i = 0; i < 32; ++i) { kv[i] = 0.f; vv[i] = 0.f; }
        }
#pragma unroll
        for (int i = 0; i < 32; ++i) ss += kv[i] * kv[i];
        ss += __shfl_xor(ss, 1);
        const float rs = rsqrtf(ss * (1.f / 64.f) + EPS);
#pragma unroll
        for (int i = 0; i < 4; ++i) { const f32x4 w0 = *(const f32x4*)(F.k_norm_w + half * 32 + 8 * i), w1 = *(const f32x4*)(F.k_norm_w + half * 32 + 8 * i + 4);
            *(LAS v4u*)(Ks + slot * SWK_STRIDE + half * 32 + 8 * i) = (v4u){pk2(kv[8 * i] * rs * w0.x, kv[8 * i + 1] * rs * w0.y), pk2(kv[8 * i + 2] * rs * w0.z, kv[8 * i + 3] * rs * w0.w),
                                                                             pk2(kv[8 * i + 4] * rs * w1.x, kv[8 * i + 5] * rs * w1.y), pk2(kv[8 * i + 6] * rs * w1.z, kv[8 * i + 7] * rs * w1.w)}; }
#pragma unroll
        for (int i = 0; i < 32; ++i) Vt[(half * 32 + i) * SWV_STRIDE + slot] = (bf16)f2bf(vv[i]);
    }
    __syncthreads();
    const float LOG2E = 1.4426950408889634f;
    const float slope2 = exp2f(-(float)(hq + 1)) * LOG2E, sink2 = sinkv * LOG2E;
#pragma nounroll
    for (int m = 0; m < 4; ++m) {
        const int i0 = 64 * qh + 16 * m, iq = i0 + r16, t = nb * WIN + iq;
        bf16x8 qf[2];
        {
            const v4u a = qa[0], c = qc[0];
            qa[0] = qa[1]; qa[1] = qa[2]; qa[2] = qa[3]; qc[0] = qc[1]; qc[1] = qc[2]; qc[2] = qc[3];
            float x[16] = {bflo(a.x), bfhi(a.x), bflo(a.y), bfhi(a.y), bflo(a.z), bfhi(a.z), bflo(a.w), bfhi(a.w), bflo(c.x), bfhi(c.x), bflo(c.y), bfhi(c.y), bflo(c.z), bfhi(c.z), bflo(c.w), bfhi(c.w)};
            float ss = 0.f;
#pragma unroll
            for (int i = 0; i < 16; ++i) ss += x[i] * x[i];
            ss += __shfl_xor(ss, 16); ss += __shfl_xor(ss, 32);
            const float rs = rsqrtf(ss * (1.f / 64.f) + EPS) * 0.125f * LOG2E;
            const f32x4 w0 = qw0, w1 = qw1, w2 = qw2, w3 = qw3;
            const v4u f0 = (v4u){pk2(x[0] * rs * w0.x, x[1] * rs * w0.y), pk2(x[2] * rs * w0.z, x[3] * rs * w0.w), pk2(x[4] * rs * w1.x, x[5] * rs * w1.y), pk2(x[6] * rs * w1.z, x[7] * rs * w1.w)};
            const v4u f1 = (v4u){pk2(x[8] * rs * w2.x, x[9] * rs * w2.y), pk2(x[10] * rs * w2.z, x[11] * rs * w2.w), pk2(x[12] * rs * w3.x, x[13] * rs * w3.y), pk2(x[14] * rs * w3.z, x[15] * rs * w3.w)};
            qf[0] = __builtin_bit_cast(bf16x8, f0); qf[1] = __builtin_bit_cast(bf16x8, f1);
        }
        const int kt0 = 2 * (2 * qh + (m >> 1));
        f32x4 st[10]; float mx = sink2;
#pragma unroll
        for (int kk = 0; kk < 10; ++kk) {
            const int kt = kt0 + kk;
            f32x4 a4 = (f32x4){0.f, 0.f, 0.f, 0.f};
#pragma unroll
            for (int ks = 0; ks < 2; ++ks) { const bf16x8 kf = *(const LAS bf16x8*)(Ks + (16 * kt + r16) * SWK_STRIDE + 32 * ks + 8 * q4); a4 = __builtin_amdgcn_mfma_f32_16x16x32_bf16(kf, qf[ks], a4, 0, 0, 0); }
#pragma unroll
            for (int i = 0; i < 4; ++i) { const int j = 16 * kt + 4 * q4 + i, dlt = j - iq;
                const bool ok = (dlt >= 1) && (dlt <= 128) && (nb > 0 || j >= 128);
                const float v = ok ? a4[i] - slope2 * (float)(128 - dlt) : -3.0e38f;
                a4[i] = v; mx = fmaxf(mx, v); }
            st[kk] = a4;
        }
        mx = fmaxf(mx, __shfl_xor(mx, 16)); mx = fmaxf(mx, __shfl_xor(mx, 32));
        float sum = 0.f;
#pragma unroll
        for (int kk = 0; kk < 10; ++kk)
#pragma unroll
            for (int i = 0; i < 4; ++i) { const float p = __builtin_amdgcn_exp2f(st[kk][i] - mx); st[kk][i] = p; sum += p; }
        sum += __shfl_xor(sum, 16); sum += __shfl_xor(sum, 32);
        const float inv = 1.f / (sum + __builtin_amdgcn_exp2f(sink2 - mx));
        f32x4 o[4];
#pragma unroll
        for (int dt = 0; dt < 4; ++dt) o[dt] = (f32x4){0.f, 0.f, 0.f, 0.f};
#pragma unroll
        for (int s2 = 0; s2 < 5; ++s2) { const bf16x8 pf = pack_frag(st[2 * s2], st[2 * s2 + 1]);
#pragma unroll
            for (int dt = 0; dt < 4; ++dt) { const bf16x8 vf = lda_frag((const LAS unsigned char*)(Vt + (16 * dt + r16) * SWV_STRIDE + 16 * kt0 + 32 * s2 + 4 * q4)); o[dt] = __builtin_amdgcn_mfma_f32_16x16x32_bf16(vf, pf, o[dt], 0, 0, 0); } }
        bf16* op = F.MIXED() + (size_t)(b * SEQ + t) * D + 512 + hq * 64 + 4 * q4;
#pragma unroll
        for (int dt = 0; dt < 4; ++dt) *(v2u*)(op + 16 * dt) = (v2u){pk2(o[dt][0] * inv, o[dt][1] * inv), pk2(o[dt][2] * inv, o[dt][3] * inv)};
    }
}
constexpr int SCAN_NCW = 4;
__device__ __forceinline__ void scan_step(const int n, const LAS unsigned char* cur, f32x4 (&S)[8], float* op, const int ulo, const int c16, const int q4) {
    bf16x8 sf[4];
#pragma unroll
    for (int s2 = 0; s2 < 4; ++s2) sf[s2] = pack_frag(S[2 * s2], S[2 * s2 + 1]);
    f32x4 Pm[4], Om[4];
#pragma unroll
    for (int mt = 0; mt < 4; ++mt) { Pm[mt] = (f32x4){0.f, 0.f, 0.f, 0.f}; Om[mt] = (f32x4){0.f, 0.f, 0.f, 0.f}; }
#pragma unroll
    for (int mt = 0; mt < 4; ++mt)
#pragma unroll
        for (int s2 = 0; s2 < 4; ++s2) {
            const bf16x8 aw = lda_frag(cur + IMG_W + (16 * mt + c16) * 272 + (32 * s2 + 4 * q4) * 2);
            const bf16x8 aq = lda_frag(cur + IMG_Q + (16 * mt + c16) * 272 + (32 * s2 + 4 * q4) * 2);
            Pm[mt] = __builtin_amdgcn_mfma_f32_16x16x32_bf16(aw, sf[s2], Pm[mt], 0, 0, 0);
            Om[mt] = __builtin_amdgcn_mfma_f32_16x16x32_bf16(aq, sf[s2], Om[mt], 0, 0, 0);
        }
    const float dec = *(const LAS float*)(cur + IMG_U + 128);
    f32x4 Vm[4];
#pragma unroll
    for (int mt = 0; mt < 4; ++mt) { const v2u uc = *(const LAS v2u*)(cur + ulo + 32 * mt); const f32x4 u4 = (f32x4){bflo(uc.x), bfhi(uc.x), bflo(uc.y), bfhi(uc.y)}; Vm[mt] = u4 - Pm[mt] * (1.f / IMG_SC); }
    bf16x8 vf[2], vg[2];
    vf[0] = pack_frag(Vm[0], Vm[1]); vf[1] = pack_frag(Vm[2], Vm[3]);
    vg[0] = pack_frag(Vm[0] * (1.f / IMG_SC), Vm[1] * (1.f / IMG_SC)); vg[1] = pack_frag(Vm[2] * (1.f / IMG_SC), Vm[3] * (1.f / IMG_SC));
#pragma unroll
    for (int mt = 0; mt < 4; ++mt)
#pragma unroll
        for (int s2 = 0; s2 < 2; ++s2) {
            const bf16x8 aa = lda_frag(cur + IMG_A + (16 * mt + c16) * IMG_KS + (32 * s2 + 4 * q4) * 2);
            Om[mt] = __builtin_amdgcn_mfma_f32_16x16x32_bf16(aa, vf[s2], Om[mt], 0, 0, 0);
        }
#pragma unroll
    for (int m8 = 0; m8 < 8; ++m8) { S[m8] = S[m8] * dec;
#pragma unroll
        for (int s2 = 0; s2 < 2; ++s2) {
            const bf16x8 ak = lda_frag(cur + IMG_K + (16 * m8 + c16) * IMG_KS + (32 * s2 + 4 * q4) * 2);
            S[m8] = __builtin_amdgcn_mfma_f32_16x16x32_bf16(ak, vg[s2], S[m8], 0, 0, 0);
        } }
    float* o2 = op + (size_t)n * CH * 512;
#pragma unroll
    for (int mt = 0; mt < 4; ++mt)
#pragma unroll
        for (int i = 0; i < 4; ++i) o2[(size_t)(16 * mt + i) * 512] = Om[mt][i] * (1.f / IMG_SC);
    asm volatile("s_waitcnt lgkmcnt(0)" ::: "memory"); __builtin_amdgcn_s_barrier(); asm volatile("" ::: "memory");
}
constexpr int SC_NP = 11;
#define SC_LD(R, nn) do { const int n_ = ((nn) < NCH) ? (nn) : NCH - 1; const unsigned char* q_ = img + (size_t)n_ * istep; \
    { unsigned sp_ = 0; while (n_ >= ready) { const unsigned long long m_ = __ballot(__hip_atomic_load(flagp + lane * 4, RLX_AGENT) != 0u); ready = (m_ == ~0ull) ? 64 : __builtin_ctzll(~m_); \
        if (n_ >= ready) { __builtin_amdgcn_s_sleep(8); if (++sp_ > (1u << 20)) break; } } } \
    _Pragma("unroll") for (int p_ = 0; p_ < SC_NP; ++p_) { if (p_ < 8) asm volatile("global_load_dwordx4 %0, %1, %2" : "=v"(R[p_]) : "v"(vmain), "s"(q_ + p_ * 4096) : "memory"); \
        else asm volatile("global_load_dwordx4 %0, %1, %2" : "=v"(R[p_]) : "v"(vmain), "s"(q_ + GI_U + upart + (p_ - 8) * 4096) : "memory"); } } while (0)
#define SC_WAITR(R, CNT) asm volatile("s_waitcnt vmcnt(" #CNT ")" : "+v"(R[0]), "+v"(R[1]), "+v"(R[2]), "+v"(R[3]), "+v"(R[4]), "+v"(R[5]), "+v"(R[6]), "+v"(R[7]), "+v"(R[8]), "+v"(R[9]), "+v"(R[10]) :: "memory")
__device__ __forceinline__ void sc_cvt_store(LAS unsigned char* dst, const v4u q) {
    const unsigned qq[4] = {q.x, q.y, q.z, q.w}; unsigned o[8];
#pragma unroll
    for (int j = 0; j < 4; ++j) { const f32x2_t p0 = __builtin_amdgcn_cvt_pk_f32_fp8(qq[j], false), p1 = __builtin_amdgcn_cvt_pk_f32_fp8(qq[j], true); o[2 * j] = pk2(p0[0], p0[1]); o[2 * j + 1] = pk2(p1[0], p1[1]); }
    *(LAS v4u*)dst = (v4u){o[0], o[1], o[2], o[3]}; *(LAS v4u*)(dst + 16) = (v4u){o[4], o[5], o[6], o[7]};
}
#define SC_ST(R, buf) do { LAS unsigned char* b_ = (buf); _Pragma("unroll") for (int p_ = 0; p_ < 8; ++p_) if (p_ < 7 || hl * 16 < IMG_U / 2 - 7 * 4096) sc_cvt_store(b_ + 2 * (p_ * 4096 + hl * 16), R[p_]); \
    _Pragma("unroll") for (int p_ = 8; p_ < SC_NP; ++p_) if (p_ < 10 || hl * 16 < IMG_UHALF - 2 * 4096) *(LAS v4u*)(b_ + IMG_U + (p_ - 8) * 4096 + hl * 16) = R[p_]; \
    asm volatile("s_waitcnt lgkmcnt(0)" ::: "memory"); } while (0)
#define SC_BAR() do { __builtin_amdgcn_s_barrier(); asm volatile("" ::: "memory"); } while (0)
__device__ __forceinline__ void scan_item(Frame& F, int item) {
    static_assert(SCAN_NCW == 4 && 2 * IMG_LDS <= SCRATCH_BYTES && 8 * 4096 >= IMG_U / 2 && 7 * 4096 < IMG_U / 2 && GI_U + 2 * IMG_UHALF + 4096 <= IMG_BYTES, "scan geometry");
    constexpr int NSPLIT = 8 / SCAN_NCW;
    const int bh = item / NSPLIT, part = item % NSPLIT, b = bh >> 2, h = bh & 3, tid = F.tid, lane = F.lane, c16 = lane & 15, q4 = lane >> 4;
    const bool comp = F.wave < SCAN_NCW;
    LAS unsigned char* bufs = F.lds;
    const size_t istep = (size_t)4 * IMG_BYTES;
    const unsigned char* img = F.dnimg() + (size_t)((b * 64) * 4 + h) * IMG_BYTES;
    __syncthreads();
    if (comp) {
        const int dv0 = (part * SCAN_NCW + F.wave) * 16;
        const int ulo = IMG_U + (F.wave * 16 + c16) * 136 + 8 * q4;
        float* op = F.odn() + (size_t)(b * SEQ + 4 * q4) * 512 + h * 128 + dv0 + c16;
        f32x4 S[8];
#pragma unroll
        for (int i = 0; i < 8; ++i) S[i] = (f32x4){0.f, 0.f, 0.f, 0.f};
        SC_BAR();
        for (int n = 0; n < NCH; n += 2) { scan_step(n, bufs, S, op, ulo, c16, q4); scan_step(n + 1, bufs + IMG_LDS, S, op, ulo, c16, q4); }
    } else {
        const int hl = tid - 256;
        gu32* flagp = F.ctl + CW_FLAG + (b * 64) * 4 + h;
        int ready = 0;
        const unsigned vmain = (unsigned)hl * 16u; const int upart = part * IMG_UHALF;
        v4u R0[SC_NP], R1[SC_NP];
        SC_LD(R0, 0); SC_LD(R1, 1);
        SC_WAITR(R0, 11); SC_ST(R0, bufs); SC_LD(R0, 2); SC_BAR();
        for (int n = 0; n < NCH - 2; n += 2) {
            SC_WAITR(R1, 11); SC_ST(R1, bufs + IMG_LDS); SC_LD(R1, n + 3); SC_BAR();
            SC_WAITR(R0, 11); SC_ST(R0, bufs); SC_LD(R0, n + 4); SC_BAR();
        }
        SC_WAITR(R1, 11); SC_ST(R1, bufs + IMG_LDS); SC_LD(R1, NCH + 1); SC_BAR();
        SC_BAR();
        SC_WAITR(R0, 0); SC_WAITR(R1, 0);
    }
}
__device__ __forceinline__ void p34_mix(Frame& F, const XcdBarrier& bar) {
    constexpr int NSCAN = 16 * (8 / SCAN_NCW);
    if (F.G > NSCAN + 32) {
        if ((int)blockIdx.x < NSCAN) {
#ifndef NO_SCAN
            scan_item(F, (int)blockIdx.x);
#endif
        } else { const int np = F.G - NSCAN;
#ifndef NO_PREP
            int lasth = -1;
            for (int k = (int)blockIdx.x - NSCAN; k < 1024; k += np) { const int n = k >> 4, bh = k & 15; dn_prep_item(F, ((bh >> 2) * 64 + n) * 4 + (bh & 3), (bh & 3) != lasth); lasth = bh & 3; }
#endif
#ifndef NO_TR
            __syncthreads(); expert_transposes(F, NSCAN);
#endif
        }
#ifndef NO_SWA
        for (;;) { __syncthreads(); if (F.tid == 0) F.MISC[20] = __hip_atomic_fetch_add(F.ctl + CW_SWAQ, 1u, RLX_AGENT); __syncthreads(); const int it = (int)F.MISC[20]; if (it >= 256) break; swa_item(F, it); }
#endif
    }
}

__device__ __forceinline__ void p5_dnnorm(Frame& F) {
    const int gw = F.vcu * NWAVES + F.wave, NGW = F.G * NWAVES, lane = F.lane, d0 = (lane & 15) * 8;
    for (int t = gw; t < T; t += NGW) {
        const f32x4* op = (const f32x4*)(F.odn() + (size_t)t * 512 + lane * 8);
        const f32x4 a = op[0], c = op[1];
        float ss = (a.x * a.x + a.y * a.y) + (a.z * a.z + a.w * a.w) + (c.x * c.x + c.y * c.y) + (c.z * c.z + c.w * c.w);
        ss += __shfl_xor(ss, 1); ss += __shfl_xor(ss, 2); ss += __shfl_xor(ss, 4); ss += __shfl_xor(ss, 8);
        const float rs = rsqrtf(ss * (1.f / 128.f) + EPS);
        const v4u zz = *(const v4u*)(F.PROJ() + (size_t)t * NPROJ + PC_Z + lane * 8);
        const f32x4 w0 = *(const f32x4*)(F.dn_norm_w + d0), w1 = *(const f32x4*)(F.dn_norm_w + d0 + 4);
        float r[8] = {a.x * rs * w0.x, a.y * rs * w0.y, a.z * rs * w0.z, a.w * rs * w0.w, c.x * rs * w1.x, c.y * rs * w1.y, c.z * rs * w1.z, c.w * rs * w1.w};
        const float z[8] = {bflo(zz.x), bfhi(zz.x), bflo(zz.y), bfhi(zz.y), bflo(zz.z), bfhi(zz.z), bflo(zz.w), bfhi(zz.w)};
#pragma unroll
        for (int i = 0; i < 8; ++i) r[i] *= siluf(z[i]);
        v4u w; w.x = pk2(r[0], r[1]); w.y = pk2(r[2], r[3]); w.z = pk2(r[4], r[5]); w.w = pk2(r[6], r[7]);
        *(v4u*)(F.MIXED() + (size_t)t * D + lane * 8) = w;
    }
}

__device__ __forceinline__ void p7_router(Frame& F) {
    LAS bf16* Wh = (LAS bf16*)F.lds; LAS bf16* Wl = Wh + 32 * WR_STRIDE; LAS float* LG = (LAS float*)(F.lds + 2 * 32 * WR_STRIDE * 2);
    const int lane = F.lane, r16 = lane & 15, q4 = lane >> 4, wq = F.wave & 3, eh = F.wave >> 2;
    __syncthreads();
    { const v4u* src = (const v4u*)F.wrimg(); LAS v4u* dst = (LAS v4u*)Wh;
#pragma unroll 4
      for (int i = F.tid; i < 2 * 32 * WR_STRIDE / 8; i += NWAVES * 64) dst[i] = src[i]; }
    for (int rg = blockIdx.x; rg < 256; rg += F.G) {
        const int b = rg >> 6, t = rg * 64 + wq * 16 + r16;
        const float* m2a = F.modf() + 32768 + b * 1024; const float* m2b = F.modf() + 32768 + 4096 + b * 1024;
        __syncthreads();
        for (int i = F.tid; i < 64 * 33; i += NWAVES * 64) LG[i] = 0.f;
        float mB2;
        { float m = fmaxf(fabsf(m2b[F.tid]), fabsf(m2b[F.tid + 512]));
#pragma unroll
          for (int o = 1; o < 64; o <<= 1) m = fmaxf(m, __shfl_xor(m, o));
          LAS float* red = (LAS float*)(LG + 64 * 33 + 64);
          if (lane == 0) red[F.wave] = m;
          __syncthreads();
          mB2 = fmaxf(fmaxf(fmaxf(red[0], red[1]), fmaxf(red[2], red[3])), fmaxf(fmaxf(red[4], red[5]), fmaxf(red[6], red[7])));
          __syncthreads(); }
        const float* xr = F.out + (size_t)t * D + 8 * q4;
        float ss = 0.f, ma = 0.f;
        { const f32x4* rp = (const f32x4*)(F.rstat() + (size_t)t * 32);
#pragma unroll
          for (int i = 0; i < 8; ++i) { const f32x4 q = rp[i]; ss += q.x + q.z; ma = fmaxf(ma, fmaxf(q.y, q.w)); } }
        const float rstd = rsqrtf(ss * (1.f / D) + EPS);
        const float amax = fmaxf(rstd * ma + mB2, 1e-30f), qs = 127.f / amax;
        if (eh == 0 && q4 == 0) { F.hscale()[t] = amax * (1.f / 127.f); ((LAS float*)(LG + 64 * 33 + 96))[wq * 16 + r16] = amax * (1.f / 127.f); }
        f32x4 acc0 = (f32x4){0.f, 0.f, 0.f, 0.f}, acc1 = acc0;
        const LAS bf16* whp = Wh + r16 * WR_STRIDE + 8 * q4; const LAS bf16* wlp = Wl + r16 * WR_STRIDE + 8 * q4;
        signed char* qrow = F.H8() + (size_t)t * D + 8 * q4;
#pragma unroll 4
        for (int s3 = 0; s3 < 16; ++s3) { const int s2 = 16 * eh + s3;
            const f32x4 a = *(const f32x4*)(xr + 32 * s2), c = *(const f32x4*)(xr + 32 * s2 + 4);
            const f32x4 a0 = *(const f32x4*)(m2a + 32 * s2 + 8 * q4), a1 = *(const f32x4*)(m2a + 32 * s2 + 8 * q4 + 4), b0 = *(const f32x4*)(m2b + 32 * s2 + 8 * q4), b1 = *(const f32x4*)(m2b + 32 * s2 + 8 * q4 + 4);
            const f32x4 h0 = a * rstd * a0 + b0, h1 = c * rstd * a1 + b1;
            float hv[8] = {h0.x, h0.y, h0.z, h0.w, h1.x, h1.y, h1.z, h1.w}; unsigned hw[4], lw[4];
#pragma unroll
            for (int i = 0; i < 4; ++i) { hw[i] = pk2(hv[2 * i], hv[2 * i + 1]); lw[i] = pk2(hv[2 * i] - bflo(hw[i]), hv[2 * i + 1] - bfhi(hw[i])); }
            const v4u xhw = (v4u){hw[0], hw[1], hw[2], hw[3]};
            const v4u xlw = (v4u){lw[0], lw[1], lw[2], lw[3]};
            { int q[8];
#pragma unroll
              for (int i = 0; i < 8; ++i) q[i] = (int)rintf(hv[i] * qs);
              const unsigned lo = (unsigned)(q[0] & 255) | ((unsigned)(q[1] & 255) << 8) | ((unsigned)(q[2] & 255) << 16) | ((unsigned)(q[3] & 255) << 24);
              const unsigned hi = (unsigned)(q[4] & 255) | ((unsigned)(q[5] & 255) << 8) | ((unsigned)(q[6] & 255) << 16) | ((unsigned)(q[7] & 255) << 24);
              *(v2u*)(qrow + 32 * s2) = (v2u){lo, hi}; }
            const bf16x8 xh = __builtin_bit_cast(bf16x8, xhw), xl = __builtin_bit_cast(bf16x8, xlw);
            const bf16x8 wh0 = *(const LAS bf16x8*)(whp + 32 * s2), wl0 = *(const LAS bf16x8*)(wlp + 32 * s2), wh1 = *(const LAS bf16x8*)(whp + 16 * WR_STRIDE + 32 * s2), wl1 = *(const LAS bf16x8*)(wlp + 16 * WR_STRIDE + 32 * s2);
            acc0 = __builtin_amdgcn_mfma_f32_16x16x32_bf16(wh0, xh, acc0, 0, 0, 0); acc1 = __builtin_amdgcn_mfma_f32_16x16x32_bf16(wh1, xh, acc1, 0, 0, 0);
            acc0 = __builtin_amdgcn_mfma_f32_16x16x32_bf16(wh0, xl, acc0, 0, 0, 0); acc1 = __builtin_amdgcn_mfma_f32_16x16x32_bf16(wh1, xl, acc1, 0, 0, 0);
            acc0 = __builtin_amdgcn_mfma_f32_16x16x32_bf16(wl0, xh, acc0, 0, 0, 0); acc1 = __builtin_amdgcn_mfma_f32_16x16x32_bf16(wl1, xh, acc1, 0, 0, 0);
        }
#pragma unroll
        for (int i = 0; i < 4; ++i) { atomicAdd((float*)(LG + (wq * 16 + r16) * 33 + 4 * q4 + i), acc0[i] + (eh == 0 ? F.b_router[4 * q4 + i] : 0.f)); atomicAdd((float*)(LG + (wq * 16 + r16) * 33 + 16 + 4 * q4 + i), acc1[i] + (eh == 0 ? F.b_router[16 + 4 * q4 + i] : 0.f)); }
        __syncthreads();
        LAS unsigned* lc = (LAS unsigned*)(LG + 64 * 33); LAS unsigned* lbase = lc + 32;
        if (F.tid < 32) lc[F.tid] = 0u;
        __syncthreads();
        float tv[4]; int ti[4]; unsigned rk[4];
        if (F.wave == 0) {
#pragma unroll
            for (int r = 0; r < 4; ++r) { float bv = -3.0e38f; int bi = 0;
                for (int e = 0; e < 32; ++e) { const float v = LG[lane * 33 + e]; const bool taken = (r > 0 && ti[0] == e) || (r > 1 && ti[1] == e) || (r > 2 && ti[2] == e); if (!taken && v > bv) { bv = v; bi = e; } }
                tv[r] = bv; ti[r] = bi; rk[r] = atomicAdd((unsigned*)(lc + bi), 1u); }
        }
        __syncthreads();
        if (F.tid < 32) lbase[F.tid] = atomicAdd((unsigned*)(F.ctl + CW_CNT + 64 * F.tid), lc[F.tid]);
        __syncthreads();
        if (F.wave == 0) {
            const int tt = rg * 64 + lane;
            const float e1 = __expf(tv[1] - tv[0]), e2 = __expf(tv[2] - tv[0]), e3 = __expf(tv[3] - tv[0]), inv = 1.f / (1.f + e1 + e2 + e3);
            const float gts[4] = {inv, e1 * inv, e2 * inv, e3 * inv}; const float hsr = ((const LAS float*)(LG + 64 * 33 + 96))[lane];
#pragma unroll
            for (int r = 0; r < 4; ++r) { const unsigned pos = lbase[ti[r]] + rk[r]; F.lslot()[ti[r] * T + pos] = tt * 4 + r; F.lgate()[ti[r] * T + pos] = gts[r]; F.lhs()[ti[r] * T + pos] = hsr; }
        }
    }
}

__device__ __forceinline__ void moe_plan(Frame& F) {
    LAS int* P = (LAS int*)(F.lds + CTRL_OFF + 256); LAS int* ord = P + PL_GE + 128;
    __syncthreads();
    if (F.tid < NE) { const int c = (int)__hip_atomic_load(F.ctl + CW_CNT + 64 * F.tid, RLX_AGENT); P[PL_CNT + F.tid] = c; P[PL_NT + F.tid] = (c + 255) >> 8; }
    if (F.tid < 8) P[PL_GN + F.tid] = 0;
    __syncthreads();
    if (F.tid < NE) { const int e = F.tid, k = P[PL_NT + e]; int rank = 0, ts = 0;
        for (int o = 0; o < NE; ++o) { const int ko = P[PL_NT + o]; rank += (ko > k || (ko == k && o < e)) ? 1 : 0; ts += (o < e) ? ko : 0; }
        ord[rank] = e; P[PL_TS + e] = ts; }
    __syncthreads();
    if (F.tid == 0) {
        int load[8], gn[8];
#pragma unroll
        for (int g = 0; g < 8; ++g) { load[g] = 0; gn[g] = 0; }
        for (int it = 0; it < NE; ++it) { const int be = ord[it], bk = P[PL_NT + be];
            int bg = 0, bl = load[0];
#pragma unroll
            for (int g = 1; g < 8; ++g) if (load[g] < bl) { bl = load[g]; bg = g; }
            int n = 0;
#pragma unroll
            for (int g = 0; g < 8; ++g) if (g == bg) { n = gn[g]; load[g] += bk; gn[g] += 1; }
            P[PL_GE + bg * 16 + n] = be; }
#pragma unroll
        for (int g = 0; g < 8; ++g) P[PL_GN + g] = gn[g];
    }
    __syncthreads();
}

__device__ __forceinline__ void p2_proj(Frame& F) {
    pg8::Gemm g{(const bf16*)F.Hq(), (const bf16*)F.Win8(), T, NPROJ, D / 2}; DenseOrder S; S.init(T, NPROJ, D / 2, F.G, (int)blockIdx.x, F.tid);
    EpiProjI8 E{F.PROJ(), F.hscale1(), F.inscale()};
    pg8::gemm_phase<EpiProjI8, DenseOrder, true, true>(F.lds, g, S, E, F.wave, F.lane);
}
__device__ __forceinline__ void p6_outproj(Frame& F) {
    pg8::Gemm g{F.MIXED(), F.Wout_t(), T, D, D}; DenseOrder S; S.init(T, D, D, F.G, (int)blockIdx.x, F.tid);
    EpiX1 E{F.x, F.out, F.modf(), F.rstat()};
    pg8::gemm_phase<EpiX1, DenseOrder, true, true>(F.lds, g, S, E, F.wave, F.lane);
}
__device__ __forceinline__ void p9_up(Frame& F) {
    moe_plan(F);
    pg8::Gemm g{(const bf16*)F.H8(), (const bf16*)F.Wup8(), 0, 0, D / 2};
    MoeOrder S{8, F.G / 8, (int)blockIdx.x / 8, (int)blockIdx.x % 8, 2048, 1024, (const LAS int*)(F.lds + CTRL_OFF + 256), F.lslot(), true, F.tid};
    EpiSwiglu E{(unsigned char*)F.ACT(), F.b_up, F.upscale(), F.lhs(), (const LAS int*)(F.lds + CTRL_OFF + 256)};
    pg8::gemm_phase<EpiSwiglu, MoeOrder, true, true>(F.lds, g, S, E, F.wave, F.lane);
}
__device__ __forceinline__ void p10_down(Frame& F, bool have_plan) {
    if (!have_plan) moe_plan(F);
    pg8::Gemm g{F.ACT(), F.Wdn_t(), 0, 0, DFF / 2};
    MoeOrder S{4, F.G / 8, (int)blockIdx.x / 8, (int)blockIdx.x % 8, 1024, 1024, (const LAS int*)(F.lds + CTRL_OFF + 256), F.lslot(), false, F.tid};
    EpiDown E{(unsigned char*)F.SLOT(), F.lslot(), F.lgate(), F.b_down, (const LAS int*)(F.lds + CTRL_OFF + 256)};
    pg8::gemm_phase<EpiDown, MoeOrder, true, true>(F.lds, g, S, E, F.wave, F.lane);
}
__device__ __forceinline__ void p11_combine(Frame& F) {
    const int gw = F.vcu * NWAVES + F.wave, NGW = F.G * NWAVES, lane = F.lane;
    for (int t0 = gw * 2; t0 < T; t0 += NGW * 2) {
        v2u w[2][2][4]; f32x4 x[2][2][2];
#pragma unroll
        for (int tt = 0; tt < 2; ++tt)
#pragma unroll
            for (int j = 0; j < 2; ++j) { const int col = j * 512 + lane * 8;
#pragma unroll
                for (int k = 0; k < 4; ++k) w[tt][j][k] = *(const v2u*)((const unsigned char*)F.SLOT() + (size_t)((t0 + tt) * 4 + k) * D + col);
                x[tt][j][0] = *(const f32x4*)(F.out + (size_t)(t0 + tt) * D + col); x[tt][j][1] = *(const f32x4*)(F.out + (size_t)(t0 + tt) * D + col + 4); }
        const float* g2 = F.modf() + (t0 >> 12) * 6144 + 5120;
#pragma unroll
        for (int j = 0; j < 2; ++j) { const int col = j * 512 + lane * 8;
            const f32x4 g0 = *(const f32x4*)(g2 + col), g1 = *(const f32x4*)(g2 + col + 4);
#pragma unroll
            for (int tt = 0; tt < 2; ++tt) { float sm[8];
#pragma unroll
                for (int i = 0; i < 8; ++i) sm[i] = 0.f;
#pragma unroll
                for (int k = 0; k < 4; ++k) { const v2u q = w[tt][j][k];
                    const f32x2_t p0 = __builtin_amdgcn_cvt_pk_f32_fp8(q.x, false), p1 = __builtin_amdgcn_cvt_pk_f32_fp8(q.x, true), p2 = __builtin_amdgcn_cvt_pk_f32_fp8(q.y, false), p3 = __builtin_amdgcn_cvt_pk_f32_fp8(q.y, true);
                    sm[0] += p0[0]; sm[1] += p0[1]; sm[2] += p1[0]; sm[3] += p1[1]; sm[4] += p2[0]; sm[5] += p2[1]; sm[6] += p3[0]; sm[7] += p3[1]; }
#pragma unroll
                for (int i = 0; i < 8; ++i) sm[i] *= (1.f / 16.f);
                f32x4 x0 = x[tt][j][0], x1 = x[tt][j][1];
                x0.x += g0.x * sm[0]; x0.y += g0.y * sm[1]; x0.z += g0.z * sm[2]; x0.w += g0.w * sm[3]; x1.x += g1.x * sm[4]; x1.y += g1.y * sm[5]; x1.z += g1.z * sm[6]; x1.w += g1.w * sm[7];
                if (PROBE_A >= 0) { const float dtus = (float)(__hip_atomic_load(F.ctl + CW_TS + PROBE_A + 1, RLX_AGENT) - __hip_atomic_load(F.ctl + CW_TS + PROBE_A, RLX_AGENT)) * 0.01f; const float sc = 1.f + sqrtf(dtus * PROBE_SCALE); x0 = x0 * sc; x1 = x1 * sc; }
                if (PROBE_B >= 0 && t0 + tt == 0 && lane == 0 && j == 0) { const float dtus = (float)(__hip_atomic_load(F.ctl + CW_TS + PROBE_B + 1, RLX_AGENT) - __hip_atomic_load(F.ctl + CW_TS + PROBE_B, RLX_AGENT)) * 0.01f; x0.x += 1.f + dtus * 0.01f; }
                f32x4* op = (f32x4*)(F.out + (size_t)(t0 + tt) * D + col); op[0] = x0; op[1] = x1; } }
    }
}

__global__ void __launch_bounds__(NWAVES * 64, 2) fwd_kernel(Args args) {
    extern __shared__ __attribute__((aligned(16))) unsigned char lds[];
    Frame F;
    F.lds = (LAS unsigned char*)lds;
    F.MISC = (volatile LAS unsigned*)(F.lds + CTRL_OFF);
    F.wave = __builtin_amdgcn_readfirstlane((int)threadIdx.x >> 6); F.refresh();
    F.G = gridDim.x; { const int bx = blockIdx.x; F.vcu = (F.G % 8 == 0) ? (bx % 8) * (F.G / 8) + bx / 8 : bx; }
    for (int u = F.tid; u < 32; u += NWAVES * 64) ((LAS unsigned*)(F.lds + CTRL_OFF))[u] = 0u;
    __syncthreads();
    XcdBarrier bar; bar.bar = (unsigned*)(F.ctl + CW_BAR); bar.x = 0; bar.st = nullptr;
    if (N_LAUNCHES == 1) bar = xcd_barrier_post((unsigned*)(F.ctl + CW_BAR), F.MISC + 8, (unsigned)F.wave);
    const int lo = args.ph_lo, hi = args.ph_hi;
#ifndef PHASE_MASK
#define PHASE_MASK 0xFFFu
#endif
#define IN(k) (((PHASE_MASK >> (k)) & 1u) && lo <= (k) && (k) < hi)
#define SEAM(k) do { if (IN(k) && IN((k) + 1)) xcd_barrier(bar); if ((PROBE_A >= 0 || PROBE_B >= 0) && blockIdx.x == 0 && F.tid == 0) __hip_atomic_store(F.ctl + CW_TS + (k) + 1, (unsigned)rt(), RLX_AGENT); } while (0)

#ifndef DUP_MASK
#define DUP_MASK 0u
#endif
#define DUP(k) ((DUP_MASK >> (k)) & 1u)
    if ((PROBE_A >= 0 || PROBE_B >= 0) && blockIdx.x == 0 && F.tid == 0) __hip_atomic_store(F.ctl + CW_TS, (unsigned)rt(), RLX_AGENT);
    if (IN(0)) { F.refresh(); for (int st = blockIdx.x; st < 48; st += F.G) quant_in_item(F, st); __syncthreads(); p0_prologue(F); if (DUP(0)) { xcd_barrier(bar); p0_prologue(F); } SEAM(0); }
    if (IN(1)) { F.refresh(); p1_hrows(F); if (DUP(1)) { xcd_barrier(bar); p1_hrows(F); } SEAM(1); }
    if (IN(2)) { F.refresh(); p2_proj(F); if (DUP(2)) { xcd_barrier(bar); p2_proj(F); } SEAM(2); }
    if (IN(3)) { F.refresh(); p34_mix(F, bar); if (IN(3) && IN(5)) xcd_barrier(bar); if ((PROBE_A >= 0 || PROBE_B >= 0) && blockIdx.x == 0 && F.tid == 0) { __hip_atomic_store(F.ctl + CW_TS + 4, (unsigned)rt(), RLX_AGENT); __hip_atomic_store(F.ctl + CW_TS + 5, (unsigned)rt(), RLX_AGENT); } }
    if (IN(5)) { F.refresh(); p5_dnnorm(F); if (DUP(5)) { xcd_barrier(bar); p5_dnnorm(F); } SEAM(5); }
    if (IN(6)) { F.refresh(); p6_outproj(F); if (DUP(6)) { xcd_barrier(bar); p6_outproj(F); } SEAM(6); }
    if (IN(7)) { F.refresh(); p7_router(F); if (IN(7) && IN(9)) xcd_barrier(bar); if ((PROBE_A >= 0 || PROBE_B >= 0) && blockIdx.x == 0 && F.tid == 0) { __hip_atomic_store(F.ctl + CW_TS + 8, (unsigned)rt(), RLX_AGENT); __hip_atomic_store(F.ctl + CW_TS + 9, (unsigned)rt(), RLX_AGENT); } }
    if (IN(9)) { F.refresh(); p9_up(F); if (DUP(9)) { xcd_barrier(bar); p9_up(F); } SEAM(9); }
    if (IN(10)) { F.refresh(); p10_down(F, IN(9)); SEAM(10); }
    if (IN(11)) { F.refresh(); p11_combine(F); }
#undef IN
#undef SEAM
}

extern "C" void kernel_launch(void* const* d_in, const int* in_sizes, int n_in, void* d_out, int out_size, void* d_ws, size_t ws_size, hipStream_t stream) {
    static int grid = 0;
    if (grid == 0) {
        if (n_in != 21 || out_size != T * D || ws_size < WS_END) { fprintf(stderr, "kernel_launch: unexpected shapes (n_in %d out %d ws %zu)\n", n_in, out_size, ws_size); grid = -1; return; }
        int dev = 0, cus = 0;
        if (hipGetDevice(&dev) != hipSuccess || hipDeviceGetAttribute(&cus, hipDeviceAttributeMultiprocessorCount, dev) != hipSuccess) { grid = -1; return; }
        if (hipFuncSetAttribute((const void*)fwd_kernel, hipFuncAttributeMaxDynamicSharedMemorySize, LDS_BYTES) != hipSuccess) { fprintf(stderr, "kernel_launch: hipFuncSetAttribute failed\n"); grid = -1; return; }
        int per_cu = 0;
        if (hipOccupancyMaxActiveBlocksPerMultiprocessor(&per_cu, (const void*)fwd_kernel, NWAVES * 64, LDS_BYTES) != hipSuccess || per_cu < 1) fprintf(stderr, "kernel_launch: occupancy query reports %d\n", per_cu);
        (void)hipGetLastError();
        grid = cus;
    }
    if (grid < 0) return;
    if (hipMemsetAsync((char*)d_ws + WS_CTL, 0, CTL_ZERO_BYTES, stream) != hipSuccess) { fprintf(stderr, "kernel_launch: memset failed\n"); return; }
    Args a{};
    for (int i = 0; i < 21; ++i) a.in[i] = (const float*)d_in[i];
    a.out = (float*)d_out; a.ws = (unsigned char*)d_ws;
    for (int li = 0; li < N_LAUNCHES; ++li) {
        a.ph_lo = (N_LAUNCHES == 1) ? 0 : li; a.ph_hi = (N_LAUNCHES == 1) ? NPH : li + 1; a.li = li;
        hipLaunchKernelGGL(fwd_kernel, dim3(grid), dim3(NWAVES * 64), LDS_BYTES, stream, a);
        const hipError_t le = hipPeekAtLastError();
        if (le != hipSuccess) { fprintf(stderr, "kernel_launch: launch %d failed: %s\n", li, hipGetErrorName(le)); break; }
    }
}
```

```cpp
#include <hip/hip_runtime.h>
#include <cstdio>
#include <cstdint>

namespace pg8 {
#define PG8_LAS __attribute__((address_space(3)))
typedef unsigned short bf16_t;
typedef short bf16x8 __attribute__((ext_vector_type(8)));
typedef float f32x4 __attribute__((ext_vector_type(4)));
typedef unsigned u32x4 __attribute__((ext_vector_type(4)));
constexpr int BM = 256, BK = 64, HALF = 128, HTB = HALF * BK * 2  , STAGE_BYTES = 8 * HTB, NXCD = 8, WGM = 8;

__host__ __device__ __forceinline__ int lds_byte(int r, int c) { const int st = (r >> 4) * 2 + (c >> 5), rr = r & 15, cc = c & 31, ob = rr * 64 + cc * 2; return st * 1024 + (ob ^ (((ob >> 9) & 1) << 5)); }
__host__ __device__ __forceinline__ void stage_rc(int b, int& R, int& C) { const int st = b / 1024, sb = b % 1024, swz = sb ^ (((sb >> 9) & 1) << 5); R = (st >> 1) * 16 + swz / 64; C = (st & 1) * 32 + (swz % 64) / 2; }
__host__ __device__ __forceinline__ int perm32(int rho) { const int n = rho >> 4, i = rho & 15; return 8 * (i >> 2) + 4 * n + (i & 3); }

struct Unit { int pm, pn, e, l0; };
typedef int i32x4 __attribute__((ext_vector_type(4)));
typedef int i32x8 __attribute__((ext_vector_type(8)));
__device__ __forceinline__ bf16x8 frag_lo(i32x8 v) { return __builtin_bit_cast(bf16x8, __builtin_shufflevector(v, v, 0, 1, 2, 3)); }
__device__ __forceinline__ bf16x8 frag_hi(i32x8 v) { return __builtin_bit_cast(bf16x8, __builtin_shufflevector(v, v, 4, 5, 6, 7)); }
struct MmaBf16 { typedef f32x4 acc_t; static __device__ __forceinline__ acc_t mma(i32x8 a, i32x8 b, acc_t c) {
    c = __builtin_amdgcn_mfma_f32_16x16x32_bf16(frag_lo(a), frag_lo(b), c, 0, 0, 0); return __builtin_amdgcn_mfma_f32_16x16x32_bf16(frag_hi(a), frag_hi(b), c, 0, 0, 0); } };
struct MmaI8 { typedef i32x4 acc_t; static __device__ __forceinline__ acc_t mma(i32x8 a, i32x8 b, acc_t c) {
    c = __builtin_amdgcn_mfma_i32_16x16x64_i8(__builtin_shufflevector(a, a, 0, 1, 2, 3), __builtin_shufflevector(b, b, 0, 1, 2, 3), c, 0, 0, 0);
    return __builtin_amdgcn_mfma_i32_16x16x64_i8(__builtin_shufflevector(a, a, 4, 5, 6, 7), __builtin_shufflevector(b, b, 4, 5, 6, 7), c, 0, 0, 0); } };
typedef long i64x4v __attribute__((ext_vector_type(4)));
struct MmaFp8 { typedef f32x4 acc_t; static __device__ __forceinline__ acc_t mma(i32x8 a, i32x8 b, acc_t c) {
    asm volatile("v_mfma_f32_16x16x128_f8f6f4 %0, %1, %2, %0" : "+v"(c) : "v"(a), "v"(b)); return c; } };
struct Gemm { const bf16_t* A; const bf16_t* Bt; int M, N, K; };

__device__ __forceinline__ unsigned cvt_pk_bf16(float lo, float hi) { unsigned r; asm volatile("v_cvt_pk_bf16_f32 %0, %1, %2" : "=v"(r) : "v"(lo), "v"(hi)); return r; }
typedef float f32x2 __attribute__((ext_vector_type(2)));
__device__ __forceinline__ f32x2 gelu_pk(f32x2 v) {
    const f32x2 av = __builtin_elementwise_abs(v), d = av * 0.2316418882f + 1.0f;
    f32x2 t; t.x = __builtin_amdgcn_rcpf(d.x); t.y = __builtin_amdgcn_rcpf(d.y);
    f32x2 q = t * 0.5307027145f + (-0.7265760135f); q = q * t + 0.7107068705f; q = q * t + (-0.142248368f); q = q * t + 0.127414796f; q = q * t;
    const f32x2 s = (v * v) * (-0.72134752044f);
    f32x2 e; e.x = __builtin_amdgcn_exp2f(s.x); e.y = __builtin_amdgcn_exp2f(s.y);
    const f32x2 m = v * (q * e), r = v - m;
    f32x2 o; o.x = v.x < 0.f ? m.x : r.x; o.y = v.y < 0.f ? m.y : r.y; return o;
}

template <int ACT  > struct EpiBf16 {
    typedef MmaBf16 Mma; static constexpr bool PERM = true, AFTER_DRAIN = false; static_assert(ACT == 0 || ACT == 1, "EpiBf16: ACT is 0 (none) or 1 (gelu_pk)");
    bf16_t* O; int ldc; const float* bias; int split_cols; size_t split_stride; float scale0;
    __device__ __forceinline__ void operator()(const f32x4 (&acc)[2][2][4][2], const Unit& u, int wr, int wc, int fr, int fq) const {
        const int row0 = u.pm * BM + wr * 64 + fr; int colt = u.pn * BM; bf16_t* base = O;
        float sc = 1.f; if (split_cols) { const int t = colt / split_cols; base += (size_t)t * split_stride; colt -= t * split_cols; if (t == 0) sc = scale0; }
        const int col0 = colt + wc * 32 + 8 * fq, bcol0 = u.pn * BM + wc * 32 + 8 * fq;
        f32x4 bv[2][2];
#pragma unroll
        for (int bj = 0; bj < 2; ++bj)
#pragma unroll
            for (int n = 0; n < 2; ++n) bv[bj][n] = bias ? *(const f32x4*)(bias + bcol0 + bj * HALF + 4 * n) : (f32x4){0.f, 0.f, 0.f, 0.f};
#pragma unroll
        for (int ai = 0; ai < 2; ++ai)
#pragma unroll
            for (int m = 0; m < 4; ++m) { bf16_t* rowp = base + (size_t)(row0 + ai * HALF + m * 16) * ldc + col0;
#pragma unroll
                for (int bj = 0; bj < 2; ++bj) { f32x4 v0 = acc[ai][bj][m][0] + bv[bj][0], v1 = acc[ai][bj][m][1] + bv[bj][1];
                    if (ACT == 1) { f32x2 a = gelu_pk((f32x2){v0[0], v0[1]}), b = gelu_pk((f32x2){v0[2], v0[3]}), c = gelu_pk((f32x2){v1[0], v1[1]}), d = gelu_pk((f32x2){v1[2], v1[3]});
                        v0 = (f32x4){a.x, a.y, b.x, b.y}; v1 = (f32x4){c.x, c.y, d.x, d.y}; }
                    v0 = v0 * sc; v1 = v1 * sc; u32x4 w; w.x = cvt_pk_bf16(v0[0], v0[1]); w.y = cvt_pk_bf16(v0[2], v0[3]); w.z = cvt_pk_bf16(v1[0], v1[1]); w.w = cvt_pk_bf16(v1[2], v1[3]);
                    *(u32x4*)(rowp + bj * HALF) = w; } }
    }
};

template <class Epi, class Sched, bool ALIGN_EPI = false, bool SP2 = false>
__device__ __forceinline__ void gemm_phase(PG8_LAS unsigned char* lds, const Gemm g, const Sched& S, const Epi& E, const int wid, const int lane) {
    const int tid = wid * 64 + lane, wr = wid >> 2, wc = wid & 3, fr = lane & 15, fq = lane >> 4;
    const int K = g.K, nt = K / BK;
    unsigned voffB[2];
#pragma unroll
    for (int i = 0; i < 2; ++i) { int R, C; stage_rc(tid * 16 + i * 8192, R, C); const int Rb = Epi::PERM ? ((R & ~31) + perm32(R & 31)) : R;
        voffB[i] = (unsigned)(Rb * K + C) * 2u; }
    const size_t kstep = (size_t)(BK * 2);
    const size_t hstep = (size_t)HALF * K * 2;
    const unsigned ldsw = (unsigned)wid * 1024u;
    const int aoff = lds_byte(wr * 64 + fr, fq * 8), boff = lds_byte(wc * 32 + fr, fq * 8);
#define PG8_SA(b, h) (((b) * 2 + (h)) * HTB)
#define PG8_SB(b, h) ((4 + (b) * 2 + (h)) * HTB)
#define PG8_STAGE(bufoff, gbase, voff) do { _Pragma("unroll") for (int _i = 0; _i < 2; ++_i) \
        __builtin_amdgcn_global_load_lds((const unsigned*)((const char*)(gbase) + (voff)[_i]), (PG8_LAS unsigned*)(lds + (bufoff) + ldsw + _i * 8192), 16, 0, 0); } while (0)
#define PG8_LDA(dst, b, h) do { _Pragma("unroll") for (int m = 0; m < 4; ++m) { const i32x4 lo_ = *(const PG8_LAS i32x4*)(lds + PG8_SA(b, h) + aoff + m * 2048), hi_ = *(const PG8_LAS i32x4*)(lds + PG8_SA(b, h) + aoff + m * 2048 + 1024); dst[m] = __builtin_shufflevector(lo_, hi_, 0, 1, 2, 3, 4, 5, 6, 7); } } while (0)
#define PG8_LDB(dst, b, h) do { _Pragma("unroll") for (int n = 0; n < 2; ++n) { const i32x4 lo_ = *(const PG8_LAS i32x4*)(lds + PG8_SB(b, h) + boff + n * 2048), hi_ = *(const PG8_LAS i32x4*)(lds + PG8_SB(b, h) + boff + n * 2048 + 1024); dst[n] = __builtin_shufflevector(lo_, hi_, 0, 1, 2, 3, 4, 5, 6, 7); } } while (0)
#define PG8_MMA(ai, bj, At, Bt) do { __builtin_amdgcn_s_setprio(1); _Pragma("unroll") for (int m = 0; m < 4; ++m) _Pragma("unroll") for (int n = 0; n < 2; ++n) \
        acc[ai][bj][m][n] = Epi::Mma::mma(Bt[n], At[m], acc[ai][bj][m][n]); __builtin_amdgcn_s_setprio(0); } while (0)
#define PG8_WAIT_V(n) asm volatile("s_waitcnt vmcnt(" #n ")" ::: "memory")
#define PG8_WAIT_L(n) asm volatile("s_waitcnt lgkmcnt(" #n ")" ::: "memory")
#define PG8_BAR __builtin_amdgcn_s_barrier()
#define PG8_SCHED __builtin_amdgcn_sched_barrier(0)
    Unit cur, nxt; int ui = 0;
    if (!S.next(0, cur)) return;
    typedef typename Epi::Mma::acc_t acc_t;
    acc_t acc[2][2][4][2];
#pragma unroll
    for (int a = 0; a < 2; ++a)
#pragma unroll
        for (int b = 0; b < 2; ++b)
#pragma unroll
            for (int m = 0; m < 4; ++m)
#pragma unroll
                for (int n = 0; n < 2; ++n) acc[a][b][m][n] = acc_t{};
    i32x8 At[4], B0[2], B1[2];
    const char* const A0 = (const char*)g.A; const char* cB = (const char*)g.Bt + S.boff(cur);
    unsigned oA0[2], oA1[2], nA0[2], nA1[2];
    S.a_offsets(cur, oA0, oA1);
    S.a_ready(cur);
    if constexpr (SP2) {
        PG8_STAGE(PG8_SB(0, 0), cB, voffB); PG8_STAGE(PG8_SB(0, 1), cB + hstep, voffB); PG8_STAGE(PG8_SA(0, 0), A0, oA0); PG8_STAGE(PG8_SA(0, 1), A0, oA1);
        if (wr == 1) PG8_BAR;
        PG8_WAIT_V(2); PG8_BAR;
        PG8_STAGE(PG8_SB(1, 0), cB + kstep, voffB); PG8_STAGE(PG8_SA(1, 0), A0 + kstep, oA0); PG8_STAGE(PG8_SB(1, 1), cB + hstep + kstep, voffB);
        PG8_WAIT_V(6); PG8_BAR;
    }
    for (;;) {
        const bool has_next = S.next(ui + 1, nxt);
        const char* nB = has_next ? (const char*)g.Bt + S.boff(nxt) : cB;
        if (has_next) S.a_offsets(nxt, nA0, nA1); else { nA0[0] = oA0[0]; nA0[1] = oA0[1]; nA1[0] = oA1[0]; nA1[1] = oA1[1]; }
#pragma nounroll
        for (int t = 0; t < nt; t += 2) {
            const bool last = (t == nt - 2);
            const char* a1 = A0 + (size_t)(t + 1) * kstep;
            const char* a2 = last ? A0 : A0 + (size_t)(t + 2) * kstep; const char* b2 = last ? nB : cB + (size_t)(t + 2) * kstep;
            unsigned s0[2], s1[2]; s0[0] = last ? nA0[0] : oA0[0]; s0[1] = last ? nA0[1] : oA0[1]; s1[0] = last ? nA1[0] : oA1[0]; s1[1] = last ? nA1[1] : oA1[1];
            const char* a3 = a2 + kstep; const char* b3 = b2 + kstep;
            if (last && has_next) S.a_ready(nxt);
            if constexpr (SP2) {
            PG8_LDB(B0, 0, 0); PG8_LDB(B1, 0, 1); PG8_SCHED; PG8_LDA(At, 0, 0); PG8_STAGE(PG8_SA(1, 1), a1, oA1);
            PG8_WAIT_V(8); PG8_WAIT_L(0); PG8_BAR; PG8_MMA(0, 0, At, B0); PG8_MMA(0, 1, At, B1); PG8_BAR; PG8_SCHED;
            PG8_LDA(At, 0, 1); PG8_STAGE(PG8_SB(0, 0), b2, voffB); PG8_STAGE(PG8_SB(0, 1), b2 + hstep, voffB); PG8_STAGE(PG8_SA(0, 0), a2, s0);
            PG8_WAIT_V(8); PG8_WAIT_L(0); PG8_BAR; PG8_MMA(1, 0, At, B0); PG8_MMA(1, 1, At, B1); PG8_BAR; PG8_SCHED;
            PG8_LDB(B0, 1, 0); PG8_LDB(B1, 1, 1); PG8_SCHED; PG8_LDA(At, 1, 0); PG8_STAGE(PG8_SA(0, 1), a2, s1);
            PG8_WAIT_V(8); PG8_WAIT_L(0); PG8_BAR; PG8_MMA(0, 0, At, B0); PG8_MMA(0, 1, At, B1); PG8_BAR; PG8_SCHED;
            PG8_LDA(At, 1, 1); PG8_STAGE(PG8_SB(1, 0), b3, voffB); PG8_STAGE(PG8_SB(1, 1), b3 + hstep, voffB); PG8_STAGE(PG8_SA(1, 0), a3, s0);
            PG8_WAIT_V(8); PG8_WAIT_L(0); PG8_BAR; PG8_MMA(1, 0, At, B0); PG8_MMA(1, 1, At, B1); PG8_BAR; PG8_SCHED;
            }
        }
        if constexpr (ALIGN_EPI) { if (wr == 0) PG8_BAR; }
        asm volatile("s_nop 7\n\ts_nop 7\n\ts_nop 7" ::: "memory");
        if constexpr (!Epi::AFTER_DRAIN) { E(acc, cur, wr, wc, fr, fq); S.done(cur); }
        if (!has_next) break;
#pragma unroll
        for (int a = 0; a < 2; ++a)
#pragma unroll
            for (int b = 0; b < 2; ++b)
#pragma unroll
                for (int m = 0; m < 4; ++m)
#pragma unroll
                    for (int n = 0; n < 2; ++n) acc[a][b][m][n] = acc_t{};
        cur = nxt; cB = nB; ++ui; oA0[0] = nA0[0]; oA0[1] = nA0[1]; oA1[0] = nA1[0]; oA1[1] = nA1[1];
        if constexpr (ALIGN_EPI) { if (wr == 1) PG8_BAR; }
    }
    PG8_WAIT_V(0);
    if constexpr (!ALIGN_EPI) { if (wr == 0) PG8_BAR; }
    PG8_BAR;
    if constexpr (Epi::AFTER_DRAIN) { E.fused(acc, cur, wr, wc, fr, fq, lds, wid, lane); S.done(cur); }
#undef PG8_SA
#undef PG8_SB
#undef PG8_STAGE
#undef PG8_LDA
#undef PG8_LDB
#undef PG8_MMA
#undef PG8_WAIT_V
#undef PG8_WAIT_L
#undef PG8_BAR
#undef PG8_SCHED
}
}

#define GAS __attribute__((address_space(1)))
#define LAS __attribute__((address_space(3)))
typedef unsigned short bf16;
typedef unsigned v4u __attribute__((ext_vector_type(4)));
typedef float f32x4 __attribute__((ext_vector_type(4)));
typedef short bf16x8 __attribute__((ext_vector_type(8)));
typedef GAS unsigned gu32;
typedef GAS unsigned long long gu64;
#define RLX_AGENT __ATOMIC_RELAXED, __HIP_MEMORY_SCOPE_AGENT
#define LDS_WAIT() asm volatile("s_waitcnt lgkmcnt(0)" ::: "memory")
#define VM_WAIT() asm volatile("s_waitcnt vmcnt(0)" ::: "memory")
__device__ __forceinline__ unsigned long long rt() { return __builtin_amdgcn_s_memrealtime(); }
__device__ __forceinline__ unsigned f2bf(float f) { unsigned u = __builtin_bit_cast(unsigned, f); return (u + 0x7fffu + ((u >> 16) & 1u)) >> 16; }
typedef float f32x2_t __attribute__((ext_vector_type(2))); typedef __bf16 bf16x2_t __attribute__((ext_vector_type(2)));
__device__ __forceinline__ unsigned pk2(float lo, float hi) { const f32x2_t v = {lo, hi}; const bf16x2_t b = __builtin_convertvector(v, bf16x2_t); return __builtin_bit_cast(unsigned, b); }

#define XB_TMO      128
#define XB_XCNT(j)  (256  + 64 * (j))
#define XB_XSUB(j)  (1280 + 64 * (j))
#define XB_XGEN(j)  (2304 + 64 * (j))
#define XB_TOP      3328
#define XB_TOPGEN   3392
#define XCD_BAR_WORDS 3456
#define XB_SPIN_CAP (1u << 18)

__device__ __forceinline__ unsigned xb_ld(unsigned* p)              { return __hip_atomic_load(p, __ATOMIC_RELAXED, __HIP_MEMORY_SCOPE_AGENT); }
__device__ __forceinline__ unsigned xb_add(unsigned* p, unsigned v) { return __hip_atomic_fetch_add(p, v, __ATOMIC_RELAXED, __HIP_MEMORY_SCOPE_AGENT); }
__device__ __forceinline__ unsigned xb_xcc_id() { return (unsigned)__builtin_amdgcn_s_getreg((3 << 11) | 20) & 0xFu; }
#define XB_SPIN(cond, bar) do { unsigned _sp = 0; while (cond) { __builtin_amdgcn_s_sleep(1); \
    if ((++_sp & 255u) == 0u) { if (xb_ld(&(bar)[XB_TMO])) break; if (_sp > XB_SPIN_CAP) { atomicAdd(&(bar)[XB_TMO], 1u); break; } } } } while (0)

struct XcdBarrier {
    unsigned wv;
    unsigned* bar; unsigned x;
    volatile LAS unsigned* st;
};

__device__ __forceinline__ int lane_now() { int l; asm volatile("v_mbcnt_lo_u32_b32 %0, -1, 0\n\tv_mbcnt_hi_u32_b32 %0, -1, %0" : "=v"(l)); return l; }
__device__ __forceinline__ XcdBarrier xcd_barrier_post(unsigned* bar, volatile LAS unsigned* st, unsigned wv) {
    XcdBarrier b; b.wv = wv; b.bar = bar; b.x = xb_xcc_id(); b.st = st;
    if (wv == 0u && lane_now() == 0) (void)xb_add(&bar[XB_XCNT(b.x)], 1u);
    return b;
}
__device__ __forceinline__ void xcd_barrier_complete(unsigned* bar, unsigned x, unsigned& nloc, unsigned& nx) {
    const unsigned G = gridDim.x * gridDim.y * gridDim.z;
    unsigned sum, cnt, mine, sp = 0u;
    for (;;) {
        sum = 0u; cnt = 0u; mine = 0u;
#pragma unroll
        for (unsigned j = 0; j < 16; ++j) { const unsigned c = xb_ld(&bar[XB_XCNT(j)]); sum += c; cnt += (c > 0u) ? 1u : 0u; mine = (j == x) ? c : mine; }
        if (sum == G) break;
        __builtin_amdgcn_s_sleep(1);
        if ((++sp & 255u) == 0u) { if (xb_ld(&bar[XB_TMO])) break; if (sp > XB_SPIN_CAP) { atomicAdd(&bar[XB_TMO], 1u); break; } }
    }
    nloc = mine > 0u ? mine : 1u; nx = cnt > 0u ? cnt : 1u;
}

__device__ __forceinline__ void xcd_barrier(const XcdBarrier& b) {
    asm volatile("s_waitcnt vmcnt(0)" ::: "memory");
    __syncthreads();
    if (b.wv == 0u && lane_now() == 0) {
        unsigned* bar = b.bar;
        __builtin_amdgcn_s_waitcnt(0);
        unsigned nloc = b.st[0], nx = b.st[1];
        if (nloc == 0u) { xcd_barrier_complete(bar, b.x, nloc, nx); b.st[0] = nloc; b.st[1] = nx; }
        const unsigned old = xb_add(&bar[XB_XSUB(b.x)], 1u);
        const unsigned gen = old / nloc;
        if (old + 1u == (gen + 1u) * nloc) {
            __builtin_amdgcn_fence(__ATOMIC_RELEASE, "agent");
            asm volatile("s_waitcnt vmcnt(0)" ::: "memory");
            const unsigned og = xb_add(&bar[XB_TOP], 1u);
            const unsigned tg = og / nx;
            if (og + 1u == (tg + 1u) * nx) xb_add(&bar[XB_TOPGEN], 1u);
            else XB_SPIN(xb_ld(&bar[XB_TOPGEN]) == tg, bar);
            __builtin_amdgcn_fence(__ATOMIC_ACQUIRE, "agent");
            xb_add(&bar[XB_XGEN(b.x)], 1u);
            asm volatile("s_waitcnt vmcnt(0)" ::: "memory");
        } else {
            XB_SPIN(xb_ld(&bar[XB_XGEN(b.x)]) == gen, bar);
            __builtin_amdgcn_fence(__ATOMIC_ACQUIRE, "agent");
            asm volatile("s_waitcnt vmcnt(0)" ::: "memory");
        }
    }
    __syncthreads();
}


constexpr int NWAVES = 8;
constexpr int NPH = 12;
#ifndef MK_N_LAUNCHES
#define MK_N_LAUNCHES 1
#endif
constexpr int N_LAUNCHES = MK_N_LAUNCHES;

constexpr int BATCH = 4, SEQ = 4096, D = 1024, T = BATCH * SEQ;
constexpr int DN_H = 4, DK = 128, CH = 64, NCH = SEQ / CH;
constexpr int SW_H = 8, SW_KV = 2, HD = 64, WIN = 128, NB = SEQ / WIN;
constexpr int IN_COLS = 2824, NPROJ = 3072, PC_AB = 2816;
constexpr int PC_Z = 1536, PC_SQ = 2048, PC_SK = 2560, PC_SV = 2688;
constexpr int NE = 32, TOPK = 4, DFF = 1024;
constexpr int MAXTILES = 288, NPADMAX = MAXTILES * 256;
constexpr float EPS = 1e-6f;
constexpr int DNP_STRIDE = 36928;

constexpr size_t MiB = 1u << 20;
constexpr size_t WS_CTL = 0, CTL_ZERO_BYTES = 1 * MiB;
constexpr size_t WS_MODP = 18 * MiB;
constexpr int KSPLIT = 32; static_assert(KSPLIT == 32, "the adaLN GEMV items hold 1024 / KSPLIT = 32 weight rows in registers");
constexpr size_t WS_MODF = 2 * MiB;
constexpr size_t WS_GB = 3 * MiB;
constexpr size_t WS_WIN = 4 * MiB;
constexpr size_t WS_WOUT = 10 * MiB;
constexpr size_t WS_LSLOT = 12 * MiB;
constexpr size_t WS_LGATE = 14 * MiB;
constexpr size_t WS_LHS = 22 * MiB;
constexpr size_t WS_RSLOT = 16 * MiB;
constexpr size_t WS_RGATE = 17 * MiB;
constexpr size_t WS_H = 32 * MiB;
constexpr size_t WS_PROJ = 64 * MiB;
constexpr size_t WS_MIXED = 300 * MiB;
constexpr size_t WS_RSTAT = 297 * MiB;
constexpr size_t WS_ODN = 184 * MiB;
constexpr size_t WS_DNIMG = 216 * MiB;
constexpr size_t WS_DNUT = 280 * MiB;
constexpr size_t WS_DEC = 296 * MiB;
constexpr int IMG_W = 0, IMG_Q = 17408, IMG_K = 34816, IMG_A = 52224, IMG_U = 60928, IMG_UHALF = 8704, IMG_KS = 136;
constexpr int GI_U = 32768, IMG_BYTES = 65536; constexpr float IMG_SC = 16.f;
constexpr int IMG_LDS = IMG_U + IMG_UHALF;
constexpr size_t WS_WUP = 384 * MiB;
constexpr size_t WS_WDN = 512 * MiB;
constexpr size_t WS_XS = 576 * MiB;
constexpr size_t WS_ACT = 720 * MiB;
constexpr size_t WS_SLOT = 864 * MiB;
constexpr size_t WS_END = 992 * MiB;
static_assert(WS_XS + (size_t)NPADMAX * 1024 * 2 <= WS_ACT && WS_ACT + (size_t)NPADMAX * 1024 * 2 <= WS_SLOT, "xs/act");
constexpr int CW_CNT = 8192;
constexpr int CW_BAR = 4096;
constexpr int CW_SWAQ = 12288;
constexpr int CW_FLAG = 16384;
constexpr int CW_TS = 128;
#ifndef PROBE_A
#define PROBE_A -1
#endif
#ifndef PROBE_B
#define PROBE_B -1
#endif
#ifndef PROBE_SCALE
#define PROBE_SCALE 1.0e-6f
#endif

constexpr int WR_STRIDE = 1032;
constexpr int LDS_BYTES = 147456;
constexpr int CTRL_OFF = LDS_BYTES - 4096;
constexpr int SCRATCH_BYTES = CTRL_OFF;

struct Args { const float* in[21]; float* out; unsigned char* ws; int ph_lo, ph_hi, li, pad; };
struct Frame {
    LAS unsigned char* lds;
    volatile LAS unsigned* MISC;
    gu32* ctl;
    int tid, lane, wave, vcu, G;
    __device__ __forceinline__ void refresh() {
        lane = lane_now(); tid = wave * 64 + lane;
        const __attribute__((address_space(4))) Args* ap = (const __attribute__((address_space(4))) Args*)__builtin_amdgcn_kernarg_segment_ptr();
        asm volatile("" : "+s"(ap));
        x = ap->in[0]; c = ap->in[1]; w_ada = ap->in[2]; b_ada = ap->in[3]; norm1_w = ap->in[4]; w_in = ap->in[5]; conv_w = ap->in[6]; a_log = ap->in[7]; dt_bias = ap->in[8];
        dn_norm_w = ap->in[9]; q_norm_w = ap->in[10]; k_norm_w = ap->in[11]; sinks = ap->in[12]; w_out = ap->in[13]; norm2_w = ap->in[14]; w_router = ap->in[15]; b_router = ap->in[16];
        w_up = ap->in[17]; b_up = ap->in[18]; w_down = ap->in[19]; b_down = ap->in[20]; out = ap->out; ws = ap->ws; ctl = (gu32*)(ap->ws + WS_CTL);
    }
    const float *x, *c, *w_ada, *b_ada, *norm1_w, *w_in, *conv_w, *a_log, *dt_bias, *dn_norm_w, *q_norm_w, *k_norm_w, *sinks, *w_out, *norm2_w, *w_router, *b_router, *w_up, *b_up, *w_down, *b_down;
    float* out; unsigned char* ws;
    __device__ __forceinline__ float* modp() const { return (float*)(ws + WS_MODP); }
    __device__ __forceinline__ float* modf() const { return (float*)(ws + WS_MODF); }
    __device__ __forceinline__ bf16* wrimg() const { return (bf16*)(ws + WS_GB + 600 * 1024); }
    __device__ __forceinline__ float* odn() const { return (float*)(ws + WS_ODN); }
    __device__ __forceinline__ float* lgate() const { return (float*)(ws + WS_LGATE); }
    __device__ __forceinline__ float* lhs() const { return (float*)(ws + WS_LHS); }
    __device__ __forceinline__ int* lslot() const { return (int*)(ws + WS_LSLOT); }
    __device__ __forceinline__ unsigned char* dnimg() const { return (unsigned char*)(ws + WS_DNIMG); }
    __device__ __forceinline__ float* rstat() const { return (float*)(ws + WS_RSTAT); }
    __device__ __forceinline__ signed char* Hq() const { return (signed char*)(ws + WS_H); }
    __device__ __forceinline__ signed char* Win8() const { return (signed char*)(ws + WS_WIN); }
    __device__ __forceinline__ float* hscale1() const { return (float*)(ws + WS_GB); }
    __device__ __forceinline__ float* inscale() const { return (float*)(ws + WS_GB + 512 * 1024); }
    __device__ __forceinline__ signed char* H8() const { return (signed char*)(ws + WS_XS); }
    __device__ __forceinline__ signed char* Wup8() const { return (signed char*)(ws + WS_WUP); }
    __device__ __forceinline__ float* upscale() const { return (float*)(ws + WS_RSLOT); }
    __device__ __forceinline__ float* hscale() const { return (float*)(ws + WS_RGATE); }
    __device__ __forceinline__ bf16* Wout_t() const { return (bf16*)(ws + WS_WOUT); }
    __device__ __forceinline__ bf16* Wdn_t() const { return (bf16*)(ws + WS_WDN); }
    __device__ __forceinline__ bf16* PROJ() const { return (bf16*)(ws + WS_PROJ); }
    __device__ __forceinline__ bf16* MIXED() const { return (bf16*)(ws + WS_MIXED); }
    __device__ __forceinline__ bf16* ACT() const { return (bf16*)(ws + WS_ACT); }
    __device__ __forceinline__ bf16* SLOT() const { return (bf16*)(ws + WS_SLOT); }
};

typedef unsigned v2u __attribute__((ext_vector_type(2)));
__device__ __forceinline__ void st_wt8(void* p, unsigned lo, unsigned hi) { __hip_atomic_store((unsigned long long*)p, ((unsigned long long)hi << 32) | lo, __ATOMIC_RELAXED, __HIP_MEMORY_SCOPE_AGENT); }
__device__ __forceinline__ unsigned fp8x4(float a, float b, float c, float d) { unsigned w = __builtin_amdgcn_cvt_pk_fp8_f32(a, b, 0u, false); return __builtin_amdgcn_cvt_pk_fp8_f32(c, d, w, true); }
__device__ __forceinline__ void st_wt4(void* p, unsigned v) { __hip_atomic_store((unsigned*)p, v, __ATOMIC_RELAXED, __HIP_MEMORY_SCOPE_AGENT); }
__device__ __forceinline__ float bf2f(bf16 v) { return __uint_as_float((unsigned)v << 16); }
__device__ __forceinline__ float bflo(unsigned w) { return __uint_as_float(w << 16); }
__device__ __forceinline__ float bfhi(unsigned w) { return __uint_as_float(w & 0xffff0000u); }
__device__ __forceinline__ float wave_sum(float v) {
#pragma unroll
    for (int o = 1; o < 64; o <<= 1) v += __shfl_xor(v, o);
    return v;
}
__device__ __forceinline__ float siluf(float v) { return v * __builtin_amdgcn_rcpf(1.f + __builtin_amdgcn_exp2f(v * -1.44269504f)); }

struct DenseOrder {
    int nM, nN, nwg, G, c, tid; size_t tstep;
    __device__ void init(int M, int N, int K, int G_, int c_, int tid_) { nM = M / 256; nN = N / 256; nwg = nM * nN; G = G_; c = c_; tid = tid_; tstep = (size_t)256 * K * 2; }
    __device__ bool next(int i, pg8::Unit& u) const {
        const long L = (long)i * G + c; if (L >= nwg) return false;
        int wgid = (int)L; { const int q = nwg / 8, r = nwg % 8, xcd = wgid % 8, off = wgid / 8; wgid = (xcd < r ? xcd * (q + 1) : r * (q + 1) + (xcd - r) * q) + off; }
        const int nig = 8 * nN, gid = wgid / nig, fm = gid * 8, gsz = (nM - fm) < 8 ? (nM - fm) : 8;
        u.pm = fm + ((wgid % nig) % gsz); u.pn = (wgid % nig) / gsz; u.e = 0; return true;
    }
    __device__ __forceinline__ void a_offsets(const pg8::Unit& u, unsigned (&o0)[2], unsigned (&o1)[2]) const {
#pragma unroll
        for (int i = 0; i < 2; ++i) { int R, C; pg8::stage_rc(tid * 16 + i * 8192, R, C); o0[i] = (unsigned)((size_t)u.pm * tstep) + (unsigned)(R * (int)(tstep / 512) + C) * 2u; o1[i] = o0[i] + (unsigned)(tstep / 2); } }
    __device__ __forceinline__ size_t boff(const pg8::Unit& u) const { return (size_t)u.pn * tstep; }
    __device__ __forceinline__ void a_ready(const pg8::Unit&) const {}
    __device__ __forceinline__ void done(const pg8::Unit&) const {}
};
constexpr int PL_CNT = 0, PL_NT = 32, PL_TS = 64, PL_GN = 96, PL_GE = 104;
struct MoeOrder {
    int nN, lcn, lc, grp, rows_per_e, rowbytes; const LAS int* P; const int* lslot; bool gather; int tid;
    __device__ bool next(int i, pg8::Unit& u) const {
        int uidx = i * lcn + lc; const int n = P[PL_GN + grp];
        for (int k = 0; k < n; ++k) { const int e = P[PL_GE + grp * 16 + k], U = P[PL_NT + e] * nN;
            if (uidx < U) { const int tile = uidx / nN; u.e = __builtin_amdgcn_readfirstlane(e); u.pn = __builtin_amdgcn_readfirstlane(uidx - tile * nN); u.pm = __builtin_amdgcn_readfirstlane(P[PL_TS + e] + tile); u.l0 = __builtin_amdgcn_readfirstlane(tile * 256); return true; }
            uidx -= U; }
        return false;
    }
    __device__ __forceinline__ void a_offsets(const pg8::Unit& u, unsigned (&o0)[2], unsigned (&o1)[2]) const {
        const int cnt = P[PL_CNT + u.e];
#pragma unroll
        for (int i = 0; i < 2; ++i) { int R, C; pg8::stage_rc(tid * 16 + i * 8192, R, C);
            if (gather) { const int l0 = u.l0 + R, l1 = l0 + 128;
                const int t0 = (l0 < cnt) ? (lslot[u.e * T + l0] >> 2) : 0, t1 = (l1 < cnt) ? (lslot[u.e * T + l1] >> 2) : 0;
                o0[i] = (unsigned)t0 * (unsigned)rowbytes + (unsigned)C * 2u; o1[i] = (unsigned)t1 * (unsigned)rowbytes + (unsigned)C * 2u; }
            else { o0[i] = (unsigned)(u.pm * 256 + R) * (unsigned)rowbytes + (unsigned)C * 2u; o1[i] = o0[i] + 128u * (unsigned)rowbytes; } }
    }
    __device__ __forceinline__ size_t boff(const pg8::Unit& u) const { return ((size_t)u.e * rows_per_e + (size_t)u.pn * 256) * (size_t)rowbytes; }
    __device__ __forceinline__ void a_ready(const pg8::Unit&) const {}
    __device__ __forceinline__ void done(const pg8::Unit&) const {}
};

struct EpiProjI8 {
    typedef pg8::MmaI8 Mma; static constexpr bool PERM = true, AFTER_DRAIN = false;
    bf16* O; const float* hs; const float* ws;
    __device__ __forceinline__ void operator()(const pg8::i32x4 (&acc)[2][2][4][2], const pg8::Unit& u, int wr, int wc, int fr, int fq) const {
        const int row0 = u.pm * 256 + wr * 64 + fr, col0 = u.pn * 256 + wc * 32 + 8 * fq;
        float h[2][4]; f32x4 sc[2][2];
#pragma unroll
        for (int bj = 0; bj < 2; ++bj) { sc[bj][0] = *(const f32x4*)(ws + col0 + bj * 128); sc[bj][1] = *(const f32x4*)(ws + col0 + bj * 128 + 4); }
#pragma unroll
        for (int ai = 0; ai < 2; ++ai)
#pragma unroll
            for (int m = 0; m < 4; ++m) h[ai][m] = hs[row0 + ai * 128 + m * 16];
#pragma unroll
        for (int ai = 0; ai < 2; ++ai)
#pragma unroll
            for (int m = 0; m < 4; ++m) { const int row = row0 + ai * 128 + m * 16; bf16* rowp = O + (size_t)row * NPROJ + col0;
#pragma unroll
                for (int bj = 0; bj < 2; ++bj) {
                    const f32x4 c0 = __builtin_convertvector(acc[ai][bj][m][0], f32x4) * h[ai][m] * sc[bj][0], c1 = __builtin_convertvector(acc[ai][bj][m][1], f32x4) * h[ai][m] * sc[bj][1];
                    v4u w; w.x = pk2(c0[0], c0[1]); w.y = pk2(c0[2], c0[3]); w.z = pk2(c1[0], c1[1]); w.w = pk2(c1[2], c1[3]);
                    *(v4u*)(rowp + bj * 128) = w; } }
    }
};
struct EpiX1 {
    typedef pg8::MmaBf16 Mma; static constexpr bool PERM = false, AFTER_DRAIN = false;
    const float* x; float* out; const float* modf; float* rstat;
    __device__ __forceinline__ void operator()(const f32x4 (&acc)[2][2][4][2], const pg8::Unit& u, int wr, int wc, int fr, int fq) const {
        const int row0 = u.pm * 256 + wr * 64 + fr, col0 = u.pn * 256 + wc * 32 + 4 * fq, b = u.pm >> 4;
        f32x4 gv[2][2], av[2][2];
#pragma unroll
        for (int bj = 0; bj < 2; ++bj)
#pragma unroll
            for (int n = 0; n < 2; ++n) { gv[bj][n] = *(const f32x4*)(modf + b * 6144 + 2048 + col0 + bj * 128 + n * 16); av[bj][n] = *(const f32x4*)(modf + 32768 + b * 1024 + col0 + bj * 128 + n * 16); }
        f32x4 xv[2][2][2][2];
#define X1_LOAD(buf, sl, r) do { const size_t off_ = (size_t)(row0 + ((r) >> 2) * 128 + ((r) & 3) * 16) * D + col0; \
            _Pragma("unroll") for (int bj = 0; bj < 2; ++bj) _Pragma("unroll") for (int n = 0; n < 2; ++n) xv[buf][sl][bj][n] = *(const f32x4*)(x + off_ + bj * 128 + n * 16); } while (0)
#define X1_ROW(buf, sl, r) do { const int ai = (r) >> 2, m = (r) & 3, row = row0 + ai * 128 + m * 16; const size_t off = (size_t)row * D + col0; float ss = 0.f, ma = 0.f; \
            _Pragma("unroll") for (int bj = 0; bj < 2; ++bj) _Pragma("unroll") for (int n = 0; n < 2; ++n) { const f32x4 r_ = xv[buf][sl][bj][n] + gv[bj][n] * acc[ai][bj][m][n]; *(f32x4*)(out + off + bj * 128 + n * 16) = r_; \
                ss += (r_.x * r_.x + r_.y * r_.y) + (r_.z * r_.z + r_.w * r_.w); const f32x4 q = r_ * av[bj][n]; \
                ma = fmaxf(fmaxf(ma, fmaxf(fabsf(q.x), fabsf(q.y))), fmaxf(fabsf(q.z), fabsf(q.w))); } \
            ss += __shfl_xor(ss, 16); ss += __shfl_xor(ss, 32); ma = fmaxf(ma, __shfl_xor(ma, 16)); ma = fmaxf(ma, __shfl_xor(ma, 32)); \
            if (fq == 0) { float* rp = rstat + ((size_t)row * 16 + u.pn * 4 + wc) * 2; rp[0] = ss; rp[1] = ma; } } while (0)
        X1_LOAD(0, 0, 0); X1_LOAD(1, 0, 1);
        X1_ROW(0, 0, 0); X1_LOAD(0, 0, 2); X1_LOAD(0, 1, 3);
        X1_ROW(1, 0, 1); X1_LOAD(1, 0, 4); X1_LOAD(1, 1, 5);
        X1_ROW(0, 0, 2); X1_ROW(0, 1, 3); X1_LOAD(0, 0, 6); X1_LOAD(0, 1, 7);
        X1_ROW(1, 0, 4); X1_ROW(1, 1, 5);
        X1_ROW(0, 0, 6); X1_ROW(0, 1, 7);
#undef X1_ROW
#undef X1_LOAD
    }
};
struct EpiSwiglu {
    typedef pg8::MmaI8 Mma; static constexpr bool PERM = true, AFTER_DRAIN = false;
    unsigned char* act; const float* b_up; const float* wscale; const float* lhs; const LAS int* P;
    __device__ __forceinline__ void operator()(const pg8::i32x4 (&acc)[2][2][4][2], const pg8::Unit& u, int wr, int wc, int fr, int fq) const {
        const int row0 = u.pm * 256 + wr * 64 + fr, colw = u.pn * 128 + wc * 32 + 8 * fq, l00 = u.l0 + wr * 64 + fr, cnt = P[PL_CNT + u.e];
        const float* bg = b_up + (size_t)u.e * 2048 + colw; const float* bl = bg + 1024;
        const float* sg = wscale + (size_t)u.e * 2048 + u.pn * 256 + wc * 32 + 8 * fq; const float* sl = sg + 128;
        float hsv[2][4];
#pragma unroll
        for (int ai = 0; ai < 2; ++ai)
#pragma unroll
            for (int m = 0; m < 4; ++m) hsv[ai][m] = lhs[u.e * T + l00 + ai * 128 + m * 16];
        f32x4 bgv[2], blv[2], sgv[2], slv[2];
#pragma unroll
        for (int n = 0; n < 2; ++n) { bgv[n] = *(const f32x4*)(bg + 4 * n); blv[n] = *(const f32x4*)(bl + 4 * n); sgv[n] = *(const f32x4*)(sg + 4 * n); slv[n] = *(const f32x4*)(sl + 4 * n); }
#pragma unroll
        for (int ai = 0; ai < 2; ++ai)
#pragma unroll
            for (int m = 0; m < 4; ++m) { const int l = l00 + ai * 128 + m * 16; const float hs = (l < cnt) ? hsv[ai][m] : 0.f;
                float r[8];
                const f32x2_t hs2 = (f32x2_t){hs, hs};
#pragma unroll
                for (int n = 0; n < 2; ++n) {
#pragma unroll
                    for (int i = 0; i < 4; i += 2) {
                        const f32x2_t ag = (f32x2_t){(float)acc[ai][0][m][n][i], (float)acc[ai][0][m][n][i + 1]}, al = (f32x2_t){(float)acc[ai][1][m][n][i], (float)acc[ai][1][m][n][i + 1]};
                        const f32x2_t g0 = ag * hs2 * (f32x2_t){sgv[n][i], sgv[n][i + 1]} + (f32x2_t){bgv[n][i], bgv[n][i + 1]}, l0 = al * hs2 * (f32x2_t){slv[n][i], slv[n][i + 1]} + (f32x2_t){blv[n][i], blv[n][i + 1]};
                        const f32x2_t g = (f32x2_t){fminf(g0[0], 7.0f), fminf(g0[1], 7.0f)}, l1 = (f32x2_t){fminf(fmaxf(l0[0], -7.0f), 7.0f), fminf(fmaxf(l0[1], -7.0f), 7.0f)};
                        const f32x2_t ex = g * (f32x2_t){-1.702f * 1.44269504f, -1.702f * 1.44269504f};
                        const f32x2_t den = (f32x2_t){__builtin_amdgcn_exp2f(ex[0]), __builtin_amdgcn_exp2f(ex[1])} + (f32x2_t){1.f, 1.f};
                        const f32x2_t rc = (f32x2_t){__builtin_amdgcn_rcpf(den[0]), __builtin_amdgcn_rcpf(den[1])};
                        const f32x2_t o = g * rc * (l1 + (f32x2_t){1.f, 1.f});
                        r[4 * n + i] = o[0]; r[4 * n + i + 1] = o[1]; } }
                unsigned w0 = __builtin_amdgcn_cvt_pk_fp8_f32(r[0], r[1], 0u, false); w0 = __builtin_amdgcn_cvt_pk_fp8_f32(r[2], r[3], w0, true);
                unsigned w1 = __builtin_amdgcn_cvt_pk_fp8_f32(r[4], r[5], 0u, false); w1 = __builtin_amdgcn_cvt_pk_fp8_f32(r[6], r[7], w1, true);
                *(v2u*)(act + (size_t)(row0 + ai * 128 + m * 16) * DFF + colw) = (v2u){w0, w1}; }
    }
};
struct EpiDown {
    typedef pg8::MmaFp8 Mma; static constexpr bool PERM = true, AFTER_DRAIN = false;
    unsigned char* slot; const int* lslot; const float* lgate; const float* b_down; const LAS int* P;
    __device__ __forceinline__ void operator()(const f32x4 (&acc)[2][2][4][2], const pg8::Unit& u, int wr, int wc, int fr, int fq) const {
        const int l00 = u.l0 + wr * 64 + fr, col0 = u.pn * 256 + wc * 32 + 8 * fq, cnt = P[PL_CNT + u.e];
        const float* bb = b_down + (size_t)u.e * 1024 + col0;
        f32x4 bv[2][2];
#pragma unroll
        for (int bj = 0; bj < 2; ++bj)
#pragma unroll
            for (int n = 0; n < 2; ++n) bv[bj][n] = *(const f32x4*)(bb + bj * 128 + 4 * n);
        int sx[2][4]; float gx[2][4];
#pragma unroll
        for (int ai = 0; ai < 2; ++ai)
#pragma unroll
            for (int m = 0; m < 4; ++m) { const int l = l00 + ai * 128 + m * 16; sx[ai][m] = lslot[u.e * T + l]; gx[ai][m] = lgate[u.e * T + l]; }
#pragma unroll
        for (int ai = 0; ai < 2; ++ai)
#pragma unroll
            for (int m = 0; m < 4; ++m) { const int l = l00 + ai * 128 + m * 16;
                if (l < cnt) { const int sidx = sx[ai][m]; const float gt = gx[ai][m];
#pragma unroll
                    for (int bj = 0; bj < 2; ++bj) { const f32x4 v0 = (acc[ai][bj][m][0] * (1.f / 64.f) + bv[bj][0]) * (gt * 16.f), v1 = (acc[ai][bj][m][1] * (1.f / 64.f) + bv[bj][1]) * (gt * 16.f);
                        unsigned w0 = __builtin_amdgcn_cvt_pk_fp8_f32(v0[0], v0[1], 0u, false); w0 = __builtin_amdgcn_cvt_pk_fp8_f32(v0[2], v0[3], w0, true);
                        unsigned w1 = __builtin_amdgcn_cvt_pk_fp8_f32(v1[0], v1[1], 0u, false); w1 = __builtin_amdgcn_cvt_pk_fp8_f32(v1[2], v1[3], w1, true);
                        *(v2u*)(slot + (size_t)sidx * 1024 + col0 + bj * 128) = (v2u){w0, w1}; } } }
    }
};

__device__ __forceinline__ void p0_transpose_item(const float* W, int ldw, int K, bf16* WT, int src_col0, int dst_row0, int k0, LAS float* scr, int lane) {
#pragma unroll 8
    for (int i = 0; i < 32; ++i) { const int kk = 2 * i + (lane >> 5); scr[kk * 33 + (lane & 31)] = W[(size_t)(k0 + kk) * ldw + src_col0 + (lane & 31)]; }
    LDS_WAIT(); asm volatile("" ::: "memory");
    const int c = lane & 7;
#pragma unroll
    for (int j = 0; j < 4; ++j) { const int n = (lane >> 3) + 8 * j; const LAS float* s = scr + (8 * c) * 33 + n;
        v4u o; o.x = pk2(s[0 * 33], s[1 * 33]); o.y = pk2(s[2 * 33], s[3 * 33]); o.z = pk2(s[4 * 33], s[5 * 33]); o.w = pk2(s[6 * 33], s[7 * 33]);
        *(GAS v4u*)(WT + (size_t)(dst_row0 + n) * K + k0 + 8 * c) = o; }
    LDS_WAIT(); asm volatile("" ::: "memory");
}
__device__ __forceinline__ void p0_prologue(Frame& F) {
    LAS float* scr = (LAS float*)(F.lds + F.wave * 14336);
    if ((int)blockIdx.x < 48 && F.G > 96) return;
    const int first = (F.G > 96) ? 48 : 0, gw = ((int)blockIdx.x - first) * NWAVES + F.wave, NGW = (F.G - first) * NWAVES;
    for (int e = (int)blockIdx.x - first; e < 32; e += F.G - first) {
        bf16* img = F.wrimg();
        for (int k = F.tid; k < 1024; k += NWAVES * 64) { const float w = F.w_router[k * 32 + e]; const unsigned hi = pk2(w, 0.f) & 0xffffu; const float rem = w - __uint_as_float(hi << 16);
            img[e * WR_STRIDE + k] = (bf16)hi; img[(32 + e) * WR_STRIDE + k] = (bf16)(pk2(rem, 0.f) & 0xffffu); } }
    LAS float* SCL = (LAS float*)(F.lds + 8 * 16384 - 16384);
    __syncthreads();
    for (int i = F.tid; i < 4096; i += NWAVES * 64) { const int bb = i >> 10, k = i & 1023; SCL[k * 4 + bb] = siluf(F.c[i]); }
    __syncthreads();
    for (int it0 = gw; it0 < 96 * KSPLIT; it0 += 2 * NGW) {
        const int it1 = it0 + NGW; const bool two = it1 < 96 * KSPLIT;
        const int s0 = it0 % 96, q0 = it0 / 96, c0 = s0 * 64 + F.lane, s1 = two ? it1 % 96 : s0, q1 = two ? it1 / 96 : q0, c1 = s1 * 64 + F.lane;
        float w0[32], w1[32];
#pragma unroll
        for (int k = 0; k < 32; ++k) w0[k] = F.w_ada[(size_t)(q0 * 32 + k) * 6144 + c0];
        if (two) {
#pragma unroll
            for (int k = 0; k < 32; ++k) w1[k] = F.w_ada[(size_t)(q1 * 32 + k) * 6144 + c1]; }
        { f32x4 a = (f32x4){0.f, 0.f, 0.f, 0.f};
#pragma unroll
          for (int k = 0; k < 32; ++k) a = a + *(const LAS f32x4*)(SCL + (q0 * 32 + k) * 4) * w0[k];
          float* mp = F.modp() + (size_t)c0 * KSPLIT + q0; mp[0] = a.x; mp[(size_t)6144 * KSPLIT] = a.y; mp[(size_t)2 * 6144 * KSPLIT] = a.z; mp[(size_t)3 * 6144 * KSPLIT] = a.w; }
        if (two) { f32x4 a = (f32x4){0.f, 0.f, 0.f, 0.f};
#pragma unroll
          for (int k = 0; k < 32; ++k) a = a + *(const LAS f32x4*)(SCL + (q1 * 32 + k) * 4) * w1[k];
          float* mp = F.modp() + (size_t)c1 * KSPLIT + q1; mp[0] = a.x; mp[(size_t)6144 * KSPLIT] = a.y; mp[(size_t)2 * 6144 * KSPLIT] = a.z; mp[(size_t)3 * 6144 * KSPLIT] = a.w; }
    }
    __syncthreads();
    constexpr int I_IN = 0, I_OUT = 16 * 32, NITEMS = I_IN + I_OUT;
    for (int it = gw; it < NITEMS; it += NGW) {
        int r = it;
        { const int kb = r / 32, nb = r % 32; p0_transpose_item(F.w_out, D, D, F.Wout_t(), 32 * nb, 32 * nb, 64 * kb, scr, F.lane); }
    }
}
__device__ __forceinline__ void transpose64_item(const float* W, int ldw, int K, bf16* WT, int src_col0, int dst_row0, int k0, LAS float* scr, int lane) {
    const int r4 = lane >> 4, cg = lane & 15;
    f32x4 v[16];
#pragma unroll
    for (int i = 0; i < 16; ++i) v[i] = *(const GAS f32x4*)(W + (size_t)(k0 + 4 * i + r4) * ldw + src_col0 + 4 * cg);
#pragma unroll
    for (int i = 0; i < 16; ++i) { LAS float* p = scr + (4 * i + r4) * 65 + 4 * cg; p[0] = v[i].x; p[1] = v[i].y; p[2] = v[i].z; p[3] = v[i].w; }
    LDS_WAIT(); asm volatile("" ::: "memory");
    const int c = lane & 7;
#pragma unroll
    for (int j = 0; j < 8; ++j) { const int n = (lane >> 3) + 8 * j; const LAS float* sp = scr + (8 * c) * 65 + n;
        v4u o; o.x = pk2(sp[0 * 65], sp[1 * 65]); o.y = pk2(sp[2 * 65], sp[3 * 65]); o.z = pk2(sp[4 * 65], sp[5 * 65]); o.w = pk2(sp[6 * 65], sp[7 * 65]);
        *(GAS v4u*)(WT + (size_t)(dst_row0 + n) * K + k0 + 8 * c) = o; }
    LDS_WAIT(); asm volatile("" ::: "memory");
}
__device__ __forceinline__ void quant_strip(Frame& F, const float* W, const int ldw, signed char* out8, float* sout) {
    const int lane = F.lane, r4 = lane >> 4, cg = lane & 15;
    LAS float* scr = (LAS float*)(F.lds + F.wave * 16640); LAS float* cmax = (LAS float*)(F.lds + 8 * 16640); LAS float* scl = cmax + 512;
    __syncthreads();
    f32x4 v[2][16];
#pragma unroll
    for (int tt = 0; tt < 2; ++tt) { const int k0 = 64 * (F.wave + 8 * tt);
#pragma unroll
        for (int i = 0; i < 16; ++i) v[tt][i] = *(const GAS f32x4*)(W + (size_t)(k0 + 4 * i + r4) * ldw + 4 * cg); }
    float m0 = 0.f, m1 = 0.f, m2 = 0.f, m3 = 0.f;
#pragma unroll
    for (int tt = 0; tt < 2; ++tt)
#pragma unroll
        for (int i = 0; i < 16; ++i) { m0 = fmaxf(m0, fabsf(v[tt][i].x)); m1 = fmaxf(m1, fabsf(v[tt][i].y)); m2 = fmaxf(m2, fabsf(v[tt][i].z)); m3 = fmaxf(m3, fabsf(v[tt][i].w)); }
    m0 = fmaxf(m0, __shfl_xor(m0, 16)); m0 = fmaxf(m0, __shfl_xor(m0, 32)); m1 = fmaxf(m1, __shfl_xor(m1, 16)); m1 = fmaxf(m1, __shfl_xor(m1, 32));
    m2 = fmaxf(m2, __shfl_xor(m2, 16)); m2 = fmaxf(m2, __shfl_xor(m2, 32)); m3 = fmaxf(m3, __shfl_xor(m3, 16)); m3 = fmaxf(m3, __shfl_xor(m3, 32));
    if (r4 == 0) { LAS float* cm = cmax + F.wave * 64 + 4 * cg; cm[0] = m0; cm[1] = m1; cm[2] = m2; cm[3] = m3; }
    __syncthreads();
    if (F.tid < 64) { float m = 1e-30f;
#pragma unroll
        for (int w = 0; w < 8; ++w) m = fmaxf(m, cmax[w * 64 + F.tid]);
        scl[F.tid] = 127.f / m; sout[F.tid] = m * (1.f / 127.f); }
    __syncthreads();
#pragma unroll
    for (int tt = 0; tt < 2; ++tt) { const int k0 = 64 * (F.wave + 8 * tt);
#pragma unroll
        for (int i = 0; i < 16; ++i) { LAS float* p = scr + (4 * i + r4) * 65 + 4 * cg; p[0] = v[tt][i].x; p[1] = v[tt][i].y; p[2] = v[tt][i].z; p[3] = v[tt][i].w; }
        LDS_WAIT(); asm volatile("" ::: "memory");
        const int c = lane & 7;
#pragma unroll
        for (int jj = 0; jj < 8; ++jj) { const int n = (lane >> 3) + 8 * jj; const LAS float* sp = scr + (8 * c) * 65 + n; const float q = scl[n];
            const int q0 = (int)rintf(sp[0 * 65] * q), q1 = (int)rintf(sp[1 * 65] * q), q2 = (int)rintf(sp[2 * 65] * q), q3 = (int)rintf(sp[3 * 65] * q), q4 = (int)rintf(sp[4 * 65] * q), q5 = (int)rintf(sp[5 * 65] * q), q6 = (int)rintf(sp[6 * 65] * q), q7 = (int)rintf(sp[7 * 65] * q);
            const unsigned lo = (unsigned)(q0 & 255) | ((unsigned)(q1 & 255) << 8) | ((unsigned)(q2 & 255) << 16) | ((unsigned)(q3 & 255) << 24);
            const unsigned hi = (unsigned)(q4 & 255) | ((unsigned)(q5 & 255) << 8) | ((unsigned)(q6 & 255) << 16) | ((unsigned)(q7 & 255) << 24);
            *(GAS v2u*)(out8 + (size_t)n * 1024 + k0 + 8 * c) = (v2u){lo, hi}; }
        LDS_WAIT(); asm volatile("" ::: "memory"); }
}
__device__ __forceinline__ void quant_up_item(Frame& F, int it) {
    const int e = it >> 5, strip = it & 31, dr = 64 * strip, pn = dr >> 8, bj = (dr >> 7) & 1, j = dr & 127;
    quant_strip(F, F.w_up + (size_t)e * 1024 * 2048 + bj * 1024 + pn * 128 + j, 2048, F.Wup8() + ((size_t)e * 2048 + dr) * 1024, F.upscale() + (size_t)e * 2048 + dr);
}
__device__ __forceinline__ void quant_up_pipe(Frame& F, int first) {
    const int lane = F.lane, r4 = lane >> 4, cg = lane & 15, step = F.G - first; const unsigned voff = (unsigned)(r4 * 8192 + 16 * cg);
    LAS float* scr = (LAS float*)(F.lds + F.wave * 16640); LAS float* cmax = (LAS float*)(F.lds + 8 * 16640); LAS float* scl = cmax + 512;
    int it = (int)blockIdx.x - first;
    if (it >= 32 * 32) return;
    __syncthreads();
    f32x4 v[2][16];
    const float* W; { const int e = it >> 5, dr = 64 * (it & 31); W = F.w_up + (size_t)e * 1024 * 2048 + ((dr >> 7) & 1) * 1024 + (dr >> 8) * 128 + (dr & 127); }
#pragma unroll
    for (int tt = 0; tt < 2; ++tt) { const int k0 = 64 * (F.wave + 8 * tt);
#pragma unroll
        for (int i = 0; i < 16; ++i) v[tt][i] = *(const GAS f32x4*)((const GAS char*)(W + (size_t)(k0 + 4 * i) * 2048) + voff); }
    for (;;) {
        const int e = it >> 5, dr = 64 * (it & 31), nit = it + step; const bool more = nit < 32 * 32;
        signed char* out8 = F.Wup8() + ((size_t)e * 2048 + dr) * 1024; float* sout = F.upscale() + (size_t)e * 2048 + dr;
        { const int en = nit >> 5, drn = 64 * (nit & 31); W = F.w_up + (size_t)en * 1024 * 2048 + ((drn >> 7) & 1) * 1024 + (drn >> 8) * 128 + (drn & 127); }
        float m0 = 0.f, m1 = 0.f, m2 = 0.f, m3 = 0.f;
#pragma unroll
        for (int tt = 0; tt < 2; ++tt)
#pragma unroll
            for (int i = 0; i < 16; ++i) { m0 = fmaxf(m0, fabsf(v[tt][i].x)); m1 = fmaxf(m1, fabsf(v[tt][i].y)); m2 = fmaxf(m2, fabsf(v[tt][i].z)); m3 = fmaxf(m3, fabsf(v[tt][i].w)); }
        m0 = fmaxf(m0, __shfl_xor(m0, 16)); m0 = fmaxf(m0, __shfl_xor(m0, 32)); m1 = fmaxf(m1, __shfl_xor(m1, 16)); m1 = fmaxf(m1, __shfl_xor(m1, 32));
        m2 = fmaxf(m2, __shfl_xor(m2, 16)); m2 = fmaxf(m2, __shfl_xor(m2, 32)); m3 = fmaxf(m3, __shfl_xor(m3, 16)); m3 = fmaxf(m3, __shfl_xor(m3, 32));
        if (r4 == 0) { LAS float* cm = cmax + F.wave * 64 + 4 * cg; cm[0] = m0; cm[1] = m1; cm[2] = m2; cm[3] = m3; }
        __syncthreads();
        if (F.tid < 64) { float m = 1e-30f;
#pragma unroll
            for (int w = 0; w < 8; ++w) m = fmaxf(m, cmax[w * 64 + F.tid]);
            scl[F.tid] = 127.f / m; sout[F.tid] = m * (1.f / 127.f); }
        __syncthreads();
#pragma unroll
        for (int tt = 0; tt < 2; ++tt) { const int k0 = 64 * (F.wave + 8 * tt);
#pragma unroll
            for (int i = 0; i < 16; ++i) { LAS float* p = scr + (4 * i + r4) * 65 + 4 * cg; p[0] = v[tt][i].x; p[1] = v[tt][i].y; p[2] = v[tt][i].z; p[3] = v[tt][i].w; }
            LDS_WAIT(); asm volatile("" ::: "memory");
            if (more) {
#pragma unroll
                for (int i = 0; i < 16; ++i) v[tt][i] = *(const GAS f32x4*)((const GAS char*)(W + (size_t)(k0 + 4 * i) * 2048) + voff); }
            const int c = lane & 7;
#pragma unroll
            for (int jj = 0; jj < 8; ++jj) { const int n = (lane >> 3) + 8 * jj; const LAS float* sp = scr + (8 * c) * 65 + n; const float q = scl[n];
                const int q0 = (int)rintf(sp[0 * 65] * q), q1 = (int)rintf(sp[1 * 65] * q), q2 = (int)rintf(sp[2 * 65] * q), q3 = (int)rintf(sp[3 * 65] * q), q4 = (int)rintf(sp[4 * 65] * q), q5 = (int)rintf(sp[5 * 65] * q), q6 = (int)rintf(sp[6 * 65] * q), q7 = (int)rintf(sp[7 * 65] * q);
                const unsigned lo = (unsigned)(q0 & 255) | ((unsigned)(q1 & 255) << 8) | ((unsigned)(q2 & 255) << 16) | ((unsigned)(q3 & 255) << 24);
                const unsigned hi = (unsigned)(q4 & 255) | ((unsigned)(q5 & 255) << 8) | ((unsigned)(q6 & 255) << 16) | ((unsigned)(q7 & 255) << 24);
                *(GAS v2u*)(out8 + (size_t)n * 1024 + k0 + 8 * c) = (v2u){lo, hi}; }
            LDS_WAIT(); asm volatile("" ::: "memory"); }
        if (!more) break;
        it = nit;
    }
}
__device__ __forceinline__ void quant_in_item(Frame& F, int strip) {
    const int dr = 64 * strip, sc = dr < 2048 ? dr : (dr < 2816 ? dr + 8 : dr - 2816 + 2048);
    quant_strip(F, F.w_in + sc, IN_COLS, F.Win8() + (size_t)dr * 1024, F.inscale() + dr);
}
__device__ __forceinline__ void transpose64_fp8_item(const float* W, int ldw, unsigned char* WT, int src_col0, int dst_row0, int k0, LAS float* scr, int lane) {
    const int r4 = lane >> 4, cg = lane & 15;
    f32x4 v[16];
#pragma unroll
    for (int i = 0; i < 16; ++i) v[i] = *(const GAS f32x4*)(W + (size_t)(k0 + 4 * i + r4) * ldw + src_col0 + 4 * cg);
#pragma unroll
    for (int i = 0; i < 16; ++i) { LAS float* p = scr + (4 * i + r4) * 65 + 4 * cg; p[0] = v[i].x * 64.f; p[1] = v[i].y * 64.f; p[2] = v[i].z * 64.f; p[3] = v[i].w * 64.f; }
    LDS_WAIT(); asm volatile("" ::: "memory");
    const int c = lane & 7;
#pragma unroll
    for (int j = 0; j < 8; ++j) { const int n = (lane >> 3) + 8 * j; const LAS float* sp = scr + (8 * c) * 65 + n;
        unsigned w0 = __builtin_amdgcn_cvt_pk_fp8_f32(sp[0 * 65], sp[1 * 65], 0u, false); w0 = __builtin_amdgcn_cvt_pk_fp8_f32(sp[2 * 65], sp[3 * 65], w0, true);
        unsigned w1 = __builtin_amdgcn_cvt_pk_fp8_f32(sp[4 * 65], sp[5 * 65], 0u, false); w1 = __builtin_amdgcn_cvt_pk_fp8_f32(sp[6 * 65], sp[7 * 65], w1, true);
        *(GAS v2u*)(WT + (size_t)(dst_row0 + n) * 1024 + k0 + 8 * c) = (v2u){w0, w1}; }
    LDS_WAIT(); asm volatile("" ::: "memory");
}
__device__ __forceinline__ void expert_transposes(Frame& F, int first) {
    quant_up_pipe(F, first);
    __syncthreads();
    LAS float* scr = (LAS float*)(F.lds + F.wave * 16640);
    const int gw = ((int)blockIdx.x - first) * NWAVES + F.wave, NGW = (F.G - first) * NWAVES;
    { const int lane = F.lane, r4 = lane >> 4, cg = lane & 15, c = lane & 7; const unsigned voff = (unsigned)(r4 * 4096 + 16 * cg);
      int r = gw;
      if (r < 32 * 256) {
        f32x4 v[16];
        { const int e = r >> 8, rr = r & 255, kb = rr >> 4, nb = rr & 15; const float* W = F.w_down + (size_t)e * 1024 * 1024 + (size_t)(64 * kb) * 1024 + 64 * nb;
#pragma unroll
          for (int i = 0; i < 16; ++i) v[i] = *(const GAS f32x4*)((const GAS char*)(W + (size_t)(4 * i) * 1024) + voff); }
        for (;;) {
            const int e = r >> 8, rr = r & 255, kb = rr >> 4, nb = rr & 15, rn = r + NGW; const bool more = rn < 32 * 256;
            unsigned char* WT = (unsigned char*)F.Wdn_t() + (size_t)e * 1024 * 1024 + (size_t)(64 * nb) * 1024 + 64 * kb;
#pragma unroll
            for (int i = 0; i < 16; ++i) { LAS float* p = scr + (4 * i + r4) * 65 + 4 * cg; p[0] = v[i].x * 64.f; p[1] = v[i].y * 64.f; p[2] = v[i].z * 64.f; p[3] = v[i].w * 64.f; }
            LDS_WAIT(); asm volatile("" ::: "memory");
            if (more) { const int en = rn >> 8, rrn = rn & 255, kbn = rrn >> 4, nbn = rrn & 15; const float* W = F.w_down + (size_t)en * 1024 * 1024 + (size_t)(64 * kbn) * 1024 + 64 * nbn;
#pragma unroll
                for (int i = 0; i < 16; ++i) v[i] = *(const GAS f32x4*)((const GAS char*)(W + (size_t)(4 * i) * 1024) + voff); }
#pragma unroll
            for (int j = 0; j < 8; ++j) { const int n = (lane >> 3) + 8 * j; const LAS float* sp = scr + (8 * c) * 65 + n;
                unsigned w0 = __builtin_amdgcn_cvt_pk_fp8_f32(sp[0 * 65], sp[1 * 65], 0u, false); w0 = __builtin_amdgcn_cvt_pk_fp8_f32(sp[2 * 65], sp[3 * 65], w0, true);
                unsigned w1 = __builtin_amdgcn_cvt_pk_fp8_f32(sp[4 * 65], sp[5 * 65], 0u, false); w1 = __builtin_amdgcn_cvt_pk_fp8_f32(sp[6 * 65], sp[7 * 65], w1, true);
                *(GAS v2u*)(WT + (size_t)n * 1024 + 8 * c) = (v2u){w0, w1}; }
            LDS_WAIT(); asm volatile("" ::: "memory");
            if (!more) break;
            r = rn;
        } } }
}

__device__ __forceinline__ float mod_sum(Frame& F, int b, int col) {
    const f32x4* p = (const f32x4*)(F.modp() + ((size_t)b * 6144 + col) * KSPLIT); f32x4 a = p[0];
#pragma unroll
    for (int i = 1; i < KSPLIT / 4; ++i) a = a + p[i];
    return F.b_ada[col] + ((a.x + a.y) + (a.z + a.w));
}
__device__ __forceinline__ void mod_tables(Frame& F, LAS float* A, LAS float* Bv, const float* norm_w, int b, int sh_col) {
    for (int k = F.tid; k < 1024; k += NWAVES * 64) { A[k] = norm_w[k] * (1.f + mod_sum(F, b, sh_col + 1024 + k)); Bv[k] = mod_sum(F, b, sh_col + k); }
}
__device__ __forceinline__ void p1_hrows(Frame& F) {
    LAS float* A1 = (LAS float*)F.lds; LAS float* B1 = A1 + 1024;
    f32x4 xv[8][4];
    if ((int)blockIdx.x < 256) {
#pragma unroll
        for (int i = 0; i < 8; ++i) { const GAS f32x4* xr = (const GAS f32x4*)(F.x + (size_t)((int)blockIdx.x * 64 + F.wave + 8 * i) * D) + F.lane;
#pragma unroll
            for (int j = 0; j < 4; ++j) xv[i][j] = xr[64 * j]; } }
    for (int blk = blockIdx.x; blk < 256; blk += F.G) {
        if (F.tid < 96) { const int idx = blk * 96 + F.tid; F.modf()[idx] = mod_sum(F, idx / 6144, idx % 6144); }
        else if (F.tid < 128) { const int idx = blk * 32 + F.tid - 96, b2 = idx >> 11, k = idx & 1023;
            if (((idx >> 10) & 1) == 0) F.modf()[32768 + b2 * 1024 + k] = F.norm2_w[k] * (1.f + mod_sum(F, b2, 4096 + k)); else F.modf()[32768 + 4096 + b2 * 1024 + k] = mod_sum(F, b2, 3072 + k); } }
    for (int rg = blockIdx.x; rg < 256; rg += F.G) {
        const int b = rg >> 6;
        __syncthreads();
        mod_tables(F, A1, B1, F.norm1_w, b, 0);
        __syncthreads();
        if (rg != (int)blockIdx.x) {
#pragma unroll
            for (int i = 0; i < 8; ++i) { const GAS f32x4* xr = (const GAS f32x4*)(F.x + (size_t)(rg * 64 + F.wave + 8 * i) * D) + F.lane;
#pragma unroll
                for (int j = 0; j < 4; ++j) xv[i][j] = xr[64 * j]; } }
#pragma unroll
        for (int ri = 0; ri < 8; ++ri) { const int rr = F.wave + 8 * ri;
            const int t = rg * 64 + rr;
            f32x4 v[4];
#pragma unroll
            for (int j = 0; j < 4; ++j) v[j] = xv[ri][j];
            float ss = 0.f;
#pragma unroll
            for (int j = 0; j < 4; ++j) ss += (v[j].x * v[j].x + v[j].y * v[j].y) + (v[j].z * v[j].z + v[j].w * v[j].w);
            const float rstd = rsqrtf(wave_sum(ss) * (1.f / D) + EPS);
            f32x4 hv[4]; float am = 0.f;
#pragma unroll
            for (int j = 0; j < 4; ++j) { const int k = 4 * F.lane + 256 * j;
                const f32x4 a = *(const LAS f32x4*)(A1 + k), bb = *(const LAS f32x4*)(B1 + k);
                hv[j] = v[j] * rstd * a + bb; am = fmaxf(fmaxf(am, fmaxf(fabsf(hv[j].x), fabsf(hv[j].y))), fmaxf(fabsf(hv[j].z), fabsf(hv[j].w))); }
#pragma unroll
            for (int o = 1; o < 64; o <<= 1) am = fmaxf(am, __shfl_xor(am, o));
            am = fmaxf(am, 1e-30f); const float qs = 127.f / am; if (F.lane == 0) F.hscale1()[t] = am * (1.f / 127.f);
            GAS unsigned* o4 = (GAS unsigned*)(F.Hq() + (size_t)t * D) + F.lane;
#pragma unroll
            for (int j = 0; j < 4; ++j) { const int q0 = (int)rintf(hv[j].x * qs), q1 = (int)rintf(hv[j].y * qs), q2 = (int)rintf(hv[j].z * qs), q3 = (int)rintf(hv[j].w * qs);
                o4[64 * j] = (unsigned)(q0 & 255) | ((unsigned)(q1 & 255) << 8) | ((unsigned)(q2 & 255) << 16) | ((unsigned)(q3 & 255) << 24); }
        }
    }
}

__device__ __forceinline__ bf16x8 lda_frag(const LAS unsigned char* p) {
    const v2u lo = *(const LAS v2u*)p, hi = *(const LAS v2u*)(p + 32);
    const v4u w = (v4u){lo.x, lo.y, hi.x, hi.y}; return __builtin_bit_cast(bf16x8, w);
}
__device__ __forceinline__ bf16x8 pack_frag(const f32x4 a, const f32x4 b) { const v4u w = (v4u){pk2(a.x, a.y), pk2(a.z, a.w), pk2(b.x, b.y), pk2(b.z, b.w)}; return __builtin_bit_cast(bf16x8, w); }
constexpr int PQ_OFF = 0, PK_OFF = 17408, PKT_OFF = 34816, PVT_OFF = 53248, PAF_OFF = 71680, PTF_OFF = 88320, PTU_OFF = 104960, PTW_OFF = 114176, PMF_OFF = 123392, PSC_OFF = 129536;
__device__ __forceinline__ void dn_prep_item(Frame& F, int item, bool loadcw) {
    const int b = item >> 8, n = (item >> 2) & 63, h = item & 3, t0 = b * SEQ + n * CH, tid = F.tid, lane = F.lane, r16 = lane & 15, q4 = lane >> 4, wv = F.wave;
    LAS unsigned char* L = F.lds;
    LAS bf16* Qr = (LAS bf16*)(L + PQ_OFF); LAS bf16* Kr = (LAS bf16*)(L + PK_OFF); LAS bf16* Kt = (LAS bf16*)(L + PKT_OFF); LAS bf16* Vt = (LAS bf16*)(L + PVT_OFF);
    LAS float* Af = (LAS float*)(L + PAF_OFF); LAS float* Tf = (LAS float*)(L + PTF_OFF); LAS bf16* Tu = (LAS bf16*)(L + PTU_OFF); LAS bf16* Tw = (LAS bf16*)(L + PTW_OFF);
    LAS float* Mf = (LAS float*)(L + PMF_OFF); LAS float* gc = (LAS float*)(L + PSC_OFF); LAS float* bt = gc + 64; LAS float* eg = bt + 64; LAS float* e2 = eg + 64;
    unsigned char* img = F.dnimg() + (size_t)item * IMG_BYTES;
    __syncthreads();
    const int g16 = tid >> 4, l16 = tid & 15, cp = g16 >> 3, r8 = 8 * (g16 & 7), chan0 = cp * 512 + h * 128 + 8 * l16;
    v4u cin[11];
    if (g16 < 24) {
#pragma unroll
        for (int jj = 0; jj < 11; ++jj) { const int pos = n * CH + r8 - 3 + jj; cin[jj] = (v4u){0u, 0u, 0u, 0u}; if (pos >= 0) cin[jj] = *(const v4u*)(F.PROJ() + (size_t)(b * SEQ + pos) * NPROJ + chan0); }
    }
    LAS float* CWL = (LAS float*)(L + PSC_OFF + 1024);
    if (loadcw && tid < 384) { const int cpw = tid >> 7, rem = tid & 127, lw = rem >> 3, jw = (rem >> 1) & 3, hw = rem & 1;
        *(LAS f32x4*)(CWL + (cpw * 16 + lw) * 32 + jw * 8 + 4 * hw) = *(const f32x4*)(F.conv_w + jw * 1536 + cpw * 512 + h * 128 + 8 * lw + 4 * hw); }
    if (wv == 0) { const bf16* pab = F.PROJ() + (size_t)(t0 + lane) * NPROJ + PC_AB + h; const float za = bf2f(pab[0]) + F.dt_bias[h], zb = bf2f(pab[4]);
        float g = -__expf(F.a_log[h]) * (fmaxf(za, 0.f) + log1pf(__expf(-fabsf(za))));
#pragma unroll
        for (int o = 1; o < 64; o <<= 1) { const float tt = __shfl_up(g, o); if (lane >= o) g += tt; }
        const float gl = __shfl(g, 63);
        gc[lane] = g; bt[lane] = 1.f / (1.f + __expf(-zb)); eg[lane] = __expf(g); e2[lane] = __expf(gl - g);
        if (lane == 63) { const float dcy = __expf(gl); st_wt4(img + GI_U + 128, __float_as_uint(dcy)); st_wt4(img + GI_U + IMG_UHALF + 128, __float_as_uint(dcy)); } }
    for (int i = tid; i < 64 * 65; i += NWAVES * 64) Tf[i] = 0.f;
    __syncthreads();
    if (g16 < 24) {
#pragma unroll
      for (int rp = 0; rp < 4; ++rp) { const int r0 = r8 + 2 * rp;
        float xin[5][8];
#pragma unroll
        for (int jj = 0; jj < 5; ++jj) { const v4u w = cin[2 * rp + jj];
            xin[jj][0] = bflo(w.x); xin[jj][1] = bfhi(w.x); xin[jj][2] = bflo(w.y); xin[jj][3] = bfhi(w.y); xin[jj][4] = bflo(w.z); xin[jj][5] = bfhi(w.z); xin[jj][6] = bflo(w.w); xin[jj][7] = bfhi(w.w); }
        float y0[8], y1[8];
        { f32x2_t p0[4], p1[4];
#pragma unroll
          for (int i = 0; i < 4; ++i) { p0[i] = (f32x2_t){0.f, 0.f}; p1[i] = (f32x2_t){0.f, 0.f}; }
#pragma unroll
          for (int j = 0; j < 4; ++j) { const f32x4 ca = *(const LAS f32x4*)(CWL + (cp * 16 + l16) * 32 + j * 8), cb = *(const LAS f32x4*)(CWL + (cp * 16 + l16) * 32 + j * 8 + 4);
              const f32x2_t cw[4] = {(f32x2_t){ca.x, ca.y}, (f32x2_t){ca.z, ca.w}, (f32x2_t){cb.x, cb.y}, (f32x2_t){cb.z, cb.w}};
#pragma unroll
              for (int i = 0; i < 4; ++i) { p0[i] = p0[i] + cw[i] * (f32x2_t){xin[j][2 * i], xin[j][2 * i + 1]}; p1[i] = p1[i] + cw[i] * (f32x2_t){xin[j + 1][2 * i], xin[j + 1][2 * i + 1]}; } }
#pragma unroll
          for (int i = 0; i < 4; ++i) { y0[2 * i] = p0[i][0]; y0[2 * i + 1] = p0[i][1]; y1[2 * i] = p1[i][0]; y1[2 * i + 1] = p1[i][1]; } }
        float s0 = 0.f, s1 = 0.f;
#pragma unroll
        for (int i = 0; i < 8; ++i) { y0[i] = siluf(y0[i]); y1[i] = siluf(y1[i]); s0 += y0[i] * y0[i]; s1 += y1[i] * y1[i]; }
        if (cp < 2) {
            s0 += __shfl_xor(s0, 1); s0 += __shfl_xor(s0, 2); s0 += __shfl_xor(s0, 4); s0 += __shfl_xor(s0, 8);
            s1 += __shfl_xor(s1, 1); s1 += __shfl_xor(s1, 2); s1 += __shfl_xor(s1, 4); s1 += __shfl_xor(s1, 8);
            const float f = (cp == 0) ? 0.08838834764831845f : 1.f, n0 = rsqrtf(s0 + EPS) * f, n1 = rsqrtf(s1 + EPS) * f;
#pragma unroll
            for (int i = 0; i < 8; ++i) { y0[i] *= n0; y1[i] *= n1; }
        }
        const v4u w0 = (v4u){pk2(y0[0], y0[1]), pk2(y0[2], y0[3]), pk2(y0[4], y0[5]), pk2(y0[6], y0[7])}, w1 = (v4u){pk2(y1[0], y1[1]), pk2(y1[2], y1[3]), pk2(y1[4], y1[5]), pk2(y1[6], y1[7])};
        if (cp == 0) { *(LAS v4u*)(Qr + r0 * 136 + 8 * l16) = w0; *(LAS v4u*)(Qr + (r0 + 1) * 136 + 8 * l16) = w1;
            const float g0 = eg[r0] * IMG_SC, g1 = eg[r0 + 1] * IMG_SC;
            unsigned char* q0p = img + IMG_Q / 2 + r0 * 136 + 8 * l16; unsigned char* q1p = q0p + 136;
            st_wt8(q0p, fp8x4(y0[0] * g0, y0[1] * g0, y0[2] * g0, y0[3] * g0), fp8x4(y0[4] * g0, y0[5] * g0, y0[6] * g0, y0[7] * g0));
            st_wt8(q1p, fp8x4(y1[0] * g1, y1[1] * g1, y1[2] * g1, y1[3] * g1), fp8x4(y1[4] * g1, y1[5] * g1, y1[6] * g1, y1[7] * g1)); }
        else if (cp == 1) { *(LAS v4u*)(Kr + r0 * 136 + 8 * l16) = w0; *(LAS v4u*)(Kr + (r0 + 1) * 136 + 8 * l16) = w1;
#pragma unroll
            for (int i = 0; i < 8; ++i) *(LAS unsigned*)(Kt + (8 * l16 + i) * 72 + r0) = pk2(y0[i], y1[i]); }
        else {
#pragma unroll
            for (int i = 0; i < 8; ++i) *(LAS unsigned*)(Vt + (8 * l16 + i) * 72 + r0) = pk2(y0[i], y1[i]); }
        __builtin_amdgcn_sched_barrier(0);
      } }
    __syncthreads();
    { const int dk = tid >> 2, cc = (tid & 3) * 16;
      const v4u ka = *(const LAS v4u*)(Kt + dk * 72 + cc), kb = *(const LAS v4u*)(Kt + dk * 72 + cc + 8);
      const unsigned kw[8] = {ka.x, ka.y, ka.z, ka.w, kb.x, kb.y, kb.z, kb.w};
      float kf[16];
#pragma unroll
      for (int i = 0; i < 8; ++i) { kf[2 * i] = bflo(kw[i]) * e2[cc + 2 * i] * IMG_SC; kf[2 * i + 1] = bfhi(kw[i]) * e2[cc + 2 * i + 1] * IMG_SC; }
      unsigned char* kp = img + IMG_K / 2 + dk * (IMG_KS / 2) + cc;
#pragma unroll
      for (int i = 0; i < 4; ++i) st_wt4(kp + 4 * i, fp8x4(kf[4 * i], kf[4 * i + 1], kf[4 * i + 2], kf[4 * i + 3])); }
    { const int mt = wv >> 1;
      bf16x8 ak[4];
#pragma unroll
      for (int ks = 0; ks < 4; ++ks) ak[ks] = *(const LAS bf16x8*)(Kr + (16 * mt + r16) * 136 + 32 * ks + 8 * q4);
#pragma unroll
      for (int u = 0; u < 2; ++u) { const int nt = 2 * (wv & 1) + u;
        f32x4 akk = (f32x4){0.f, 0.f, 0.f, 0.f}, aqk = (f32x4){0.f, 0.f, 0.f, 0.f};
#pragma unroll
        for (int ks = 0; ks < 4; ++ks) { const bf16x8 bk = *(const LAS bf16x8*)(Kr + (16 * nt + r16) * 136 + 32 * ks + 8 * q4), bq = *(const LAS bf16x8*)(Qr + (16 * nt + r16) * 136 + 32 * ks + 8 * q4);
            akk = __builtin_amdgcn_mfma_f32_16x16x32_bf16(ak[ks], bk, akk, 0, 0, 0); aqk = __builtin_amdgcn_mfma_f32_16x16x32_bf16(ak[ks], bq, aqk, 0, 0, 0); }
        const int col = 16 * nt + r16; const float gcol = gc[col]; float o[4];
#pragma unroll
        for (int i = 0; i < 4; ++i) { const int row = 16 * mt + 4 * q4 + i; const float grow = gc[row];
            Af[row * 65 + col] = (col < row) ? bt[row] * akk[i] * __expf(grow - gcol) : 0.f;
            o[i] = (row <= col) ? aqk[i] * __expf(gcol - grow) : 0.f; }
        st_wt4(img + IMG_A / 2 + col * (IMG_KS / 2) + 16 * mt + 4 * q4, fp8x4(o[0] * IMG_SC, o[1] * IMG_SC, o[2] * IMG_SC, o[3] * IMG_SC)); } }
    __syncthreads();
    if (tid < 64) { const int blk = tid >> 4, c = tid & 15; float x[16];
#pragma unroll
        for (int i = 0; i < 16; ++i) { float r = (i == c) ? 1.f : 0.f;
#pragma unroll
            for (int j = 0; j < i; ++j) r -= Af[(16 * blk + i) * 65 + 16 * blk + j] * x[j];
            x[i] = r; }
#pragma unroll
        for (int i = 0; i < 16; ++i) Tf[(16 * blk + i) * 65 + 16 * blk + c] = x[i]; }
    __syncthreads();
    if (wv < 2) { const int lo = 32 * wv; f32x4 m = (f32x4){0.f, 0.f, 0.f, 0.f};
#pragma unroll
      for (int ks = 0; ks < 4; ++ks) m = __builtin_amdgcn_mfma_f32_16x16x4f32(Af[(lo + 16 + r16) * 65 + lo + 4 * ks + q4], Tf[(lo + 4 * ks + q4) * 65 + lo + r16], m, 0, 0, 0);
#pragma unroll
      for (int i = 0; i < 4; ++i) Mf[wv * 272 + (4 * q4 + i) * 17 + r16] = m[i];
      LDS_WAIT(); asm volatile("" ::: "memory");
      f32x4 x = (f32x4){0.f, 0.f, 0.f, 0.f};
#pragma unroll
      for (int ks = 0; ks < 4; ++ks) x = __builtin_amdgcn_mfma_f32_16x16x4f32(Tf[(lo + 16 + r16) * 65 + lo + 16 + 4 * ks + q4], Mf[wv * 272 + (4 * ks + q4) * 17 + r16], x, 0, 0, 0);
#pragma unroll
      for (int i = 0; i < 4; ++i) Tf[(lo + 16 + 4 * q4 + i) * 65 + lo + r16] = -x[i]; }
    __syncthreads();
    { const int ti = (wv >> 1) & 1, tj = wv & 1; f32x4 m = (f32x4){0.f, 0.f, 0.f, 0.f};
      if (wv < 4) {
#pragma unroll
        for (int ks = 0; ks < 8; ++ks) m = __builtin_amdgcn_mfma_f32_16x16x4f32(Af[(32 + 16 * ti + r16) * 65 + 4 * ks + q4], Tf[(4 * ks + q4) * 65 + 16 * tj + r16], m, 0, 0, 0);
#pragma unroll
        for (int i = 0; i < 4; ++i) Mf[544 + (16 * ti + 4 * q4 + i) * 33 + 16 * tj + r16] = m[i]; }
      __syncthreads();
      if (wv < 4) { f32x4 x = (f32x4){0.f, 0.f, 0.f, 0.f};
#pragma unroll
        for (int ks = 0; ks < 8; ++ks) x = __builtin_amdgcn_mfma_f32_16x16x4f32(Tf[(32 + 16 * ti + r16) * 65 + 32 + 4 * ks + q4], Mf[544 + (4 * ks + q4) * 33 + 16 * tj + r16], x, 0, 0, 0);
#pragma unroll
        for (int i = 0; i < 4; ++i) Tf[(32 + 16 * ti + 4 * q4 + i) * 65 + 16 * tj + r16] = -x[i]; } }
    __syncthreads();
    for (int idx = tid; idx < 4096; idx += NWAVES * 64) { const int i = idx >> 6, c = idx & 63; const float tv = Tf[i * 65 + c] * bt[c];
        Tu[i * 72 + c] = (bf16)f2bf(tv); Tw[i * 72 + c] = (bf16)f2bf(tv * eg[c]); }
    __syncthreads();
    { bf16x8 bv[2], akt[2];
#pragma unroll
      for (int ks = 0; ks < 2; ++ks) { bv[ks] = *(const LAS bf16x8*)(Vt + (16 * wv + r16) * 72 + 32 * ks + 8 * q4); akt[ks] = *(const LAS bf16x8*)(Kt + (16 * wv + r16) * 72 + 32 * ks + 8 * q4); }
#pragma unroll
      for (int t4 = 0; t4 < 4; ++t4) {
        f32x4 au = (f32x4){0.f, 0.f, 0.f, 0.f}, aw = (f32x4){0.f, 0.f, 0.f, 0.f};
#pragma unroll
        for (int ks = 0; ks < 2; ++ks) { const bf16x8 tu = *(const LAS bf16x8*)(Tu + (16 * t4 + r16) * 72 + 32 * ks + 8 * q4), tw = *(const LAS bf16x8*)(Tw + (16 * t4 + r16) * 72 + 32 * ks + 8 * q4);
            au = __builtin_amdgcn_mfma_f32_16x16x32_bf16(tu, bv[ks], au, 0, 0, 0);
            aw = __builtin_amdgcn_mfma_f32_16x16x32_bf16(akt[ks], tw, aw, 0, 0, 0); }
        st_wt8(img + GI_U + (16 * wv + r16) * 136 + (16 * t4 + 4 * q4) * 2, pk2(au[0], au[1]), pk2(au[2], au[3]));
        st_wt4(img + IMG_W / 2 + (16 * t4 + r16) * 136 + 16 * wv + 4 * q4, fp8x4(aw[0] * IMG_SC, aw[1] * IMG_SC, aw[2] * IMG_SC, aw[3] * IMG_SC)); } }
    asm volatile("s_waitcnt vmcnt(0)" ::: "memory");
    __syncthreads();
    if (tid == 0) __hip_atomic_store(F.ctl + CW_FLAG + item, 1u, RLX_AGENT);
}
constexpr int SWK_STRIDE = 72, SWV_STRIDE = 264;
__device__ __forceinline__ void swa_item(Frame& F, int item) {
    const int b = item >> 6, nb = (item >> 1) & 31, kvh = item & 1, tid = F.tid, lane = F.lane, r16 = lane & 15, q4 = lane >> 4;
    LAS bf16* Ks = (LAS bf16*)F.lds; LAS bf16* Vt = Ks + 256 * SWK_STRIDE;
    const int g = F.wave & 3, qh = F.wave >> 2, hq = kvh * 4 + g;
    __syncthreads();
    v4u qa[4], qc[4];
#pragma unroll
    for (int m = 0; m < 4; ++m) { const bf16* qp = F.PROJ() + (size_t)(b * SEQ + nb * WIN + 64 * qh + 16 * m + r16) * NPROJ + PC_SQ + hq * 64 + 8 * q4; qa[m] = *(const v4u*)qp; qc[m] = *(const v4u*)(qp + 32); }
    const f32x4 qw0 = *(const f32x4*)(F.q_norm_w + 8 * q4), qw1 = *(const f32x4*)(F.q_norm_w + 8 * q4 + 4), qw2 = *(const f32x4*)(F.q_norm_w + 32 + 8 * q4), qw3 = *(const f32x4*)(F.q_norm_w + 32 + 8 * q4 + 4);
    const float sinkv = F.sinks[hq];
    {
        const int slot = tid >> 1, half = tid & 1, pos = nb * WIN - WIN + slot;
        float kv[32], vv[32]; float ss = 0.f;
        if (pos >= 0) {
            const v4u* kp = (const v4u*)(F.PROJ() + (size_t)(b * SEQ + pos) * NPROJ + PC_SK + kvh * 64 + half * 32);
            const v4u* vp = (const v4u*)(F.PROJ() + (size_t)(b * SEQ + pos) * NPROJ + PC_SV + kvh * 64 + half * 32);
#pragma unroll
            for (int i = 0; i < 4; ++i) { const v4u a = kp[i], c = vp[i];
                kv[8 * i + 0] = bflo(a.x); kv[8 * i + 1] = bfhi(a.x); kv[8 * i + 2] = bflo(a.y); kv[8 * i + 3] = bfhi(a.y); kv[8 * i + 4] = bflo(a.z); kv[8 * i + 5] = bfhi(a.z); kv[8 * i + 6] = bflo(a.w); kv[8 * i + 7] = bfhi(a.w);
                vv[8 * i + 0] = bflo(c.x); vv[8 * i + 1] = bfhi(c.x); vv[8 * i + 2] = bflo(c.y); vv[8 * i + 3] = bfhi(c.y); vv[8 * i + 4] = bflo(c.z); vv[8 * i + 5] = bfhi(c.z); vv[8 * i + 6] = bflo(c.w); vv[8 * i + 7] = bfhi(c.w); }
        } else {
#pragma unroll
            for (int i = 0; i < 32; ++i) { kv[i] = 0.f; vv[i] = 0.f; }
        }
#pragma unroll
        for (int i = 0; i < 32; ++i) ss += kv[i] * kv[i];
        ss += __shfl_xor(ss, 1);
        const float rs = rsqrtf(ss * (1.f / 64.f) + EPS);
#pragma unroll
        for (int i = 0; i < 4; ++i) { const f32x4 w0 = *(const f32x4*)(F.k_norm_w + half * 32 + 8 * i), w1 = *(const f32x4*)(F.k_norm_w + half * 32 + 8 * i + 4);
            *(LAS v4u*)(Ks + slot * SWK_STRIDE + half * 32 + 8 * i) = (v4u){pk2(kv[8 * i] * rs * w0.x, kv[8 * i + 1] * rs * w0.y), pk2(kv[8 * i + 2] * rs * w0.z, kv[8 * i + 3] * rs * w0.w),
                                                                             pk2(kv[8 * i + 4] * rs * w1.x, kv[8 * i + 5] * rs * w1.y), pk2(kv[8 * i + 6] * rs * w1.z, kv[8 * i + 7] * rs * w1.w)}; }
#pragma unroll
        for (int i = 0; i < 32; ++i) Vt[(half * 32 + i) * SWV_STRIDE + slot] = (bf16)f2bf(vv[i]);
    }
    __syncthreads();
    const float LOG2E = 1.4426950408889634f;
    const float slope2 = exp2f(-(float)(hq + 1)) * LOG2E, sink2 = sinkv * LOG2E;
#pragma nounroll
    for (int m = 0; m < 4; ++m) {
        const int i0 = 64 * qh + 16 * m, iq = i0 + r16, t = nb * WIN + iq;
        bf16x8 qf[2];
        {
            const v4u a = qa[0], c = qc[0];
            qa[0] = qa[1]; qa[1] = qa[2]; qa[2] = qa[3]; qc[0] = qc[1]; qc[1] = qc[2]; qc[2] = qc[3];
            float x[16] = {bflo(a.x), bfhi(a.x), bflo(a.y), bfhi(a.y), bflo(a.z), bfhi(a.z), bflo(a.w), bfhi(a.w), bflo(c.x), bfhi(c.x), bflo(c.y), bfhi(c.y), bflo(c.z), bfhi(c.z), bflo(c.w), bfhi(c.w)};
            float ss = 0.f;
#pragma unroll
            for (int i = 0; i < 16; ++i) ss += x[i] * x[i];
            ss += __shfl_xor(ss, 16); ss += __shfl_xor(ss, 32);
            const float rs = rsqrtf(ss * (1.f / 64.f) + EPS) * 0.125f * LOG2E;
            const f32x4 w0 = qw0, w1 = qw1, w2 = qw2, w3 = qw3;
            const v4u f0 = (v4u){pk2(x[0] * rs * w0.x, x[1] * rs * w0.y), pk2(x[2] * rs * w0.z, x[3] * rs * w0.w), pk2(x[4] * rs * w1.x, x[5] * rs * w1.y), pk2(x[6] * rs * w1.z, x[7] * rs * w1.w)};
            const v4u f1 = (v4u){pk2(x[8] * rs * w2.x, x[9] * rs * w2.y), pk2(x[10] * rs * w2.z, x[11] * rs * w2.w), pk2(x[12] * rs * w3.x, x[13] * rs * w3.y), pk2(x[14] * rs * w3.z, x[15] * rs * w3.w)};
            qf[0] = __builtin_bit_cast(bf16x8, f0); qf[1] = __builtin_bit_cast(bf16x8, f1);
        }
        const int kt0 = 2 * (2 * qh + (m >> 1));
        f32x4 st[10]; float mx = sink2;
#pragma unroll
        for (int kk = 0; kk < 10; ++kk) {
            const int kt = kt0 + kk;
            f32x4 a4 = (f32x4){0.f, 0.f, 0.f, 0.f};
#pragma unroll
            for (int ks = 0; ks < 2; ++ks) { const bf16x8 kf = *(const LAS bf16x8*)(Ks + (16 * kt + r16) * SWK_STRIDE + 32 * ks + 8 * q4); a4 = __builtin_amdgcn_mfma_f32_16x16x32_bf16(kf, qf[ks], a4, 0, 0, 0); }
#pragma unroll
            for (int i = 0; i < 4; ++i) { const int j = 16 * kt + 4 * q4 + i, dlt = j - iq;
                const bool ok = (dlt >= 1) && (dlt <= 128) && (nb > 0 || j >= 128);
                const float v = ok ? a4[i] - slope2 * (float)(128 - dlt) : -3.0e38f;
                a4[i] = v; mx = fmaxf(mx, v); }
            st[kk] = a4;
        }
        mx = fmaxf(mx, __shfl_xor(mx, 16)); mx = fmaxf(mx, __shfl_xor(mx, 32));
        float sum = 0.f;
#pragma unroll
        for (int kk = 0; kk < 10; ++kk)
#pragma unroll
            for (int i = 0; i < 4; ++i) { const float p = __builtin_amdgcn_exp2f(st[kk][i] - mx); st[kk][i] = p; sum += p; }
        sum += __shfl_xor(sum, 16); sum += __shfl_xor(sum, 32);
        const float inv = 1.f / (sum + __builtin_amdgcn_exp2f(sink2 - mx));
        f32x4 o[4];
#pragma unroll
        for (int dt = 0; dt < 4; ++dt) o[dt] = (f32x4){0.f, 0.f, 0.f, 0.f};
#pragma unroll
        for (int s2 = 0; s2 < 5; ++s2) { const bf16x8 pf = pack_frag(st[2 * s2], st[2 * s2 + 1]);
#pragma unroll
            for (int dt = 0; dt < 4; ++dt) { const bf16x8 vf = lda_frag((const LAS unsigned char*)(Vt + (16 * dt + r16) * SWV_STRIDE + 16 * kt0 + 32 * s2 + 4 * q4)); o[dt] = __builtin_amdgcn_mfma_f32_16x16x32_bf16(vf, pf, o[dt], 0, 0, 0); } }
        bf16* op = F.MIXED() + (size_t)(b * SEQ + t) * D + 512 + hq * 64 + 4 * q4;
#pragma unroll
        for (int dt = 0; dt < 4; ++dt) *(v2u*)(op + 16 * dt) = (v2u){pk2(o[dt][0] * inv, o[dt][1] * inv), pk2(o[dt][2] * inv, o[dt][3] * inv)};
    }
}
constexpr int SCAN_NCW = 4;
__device__ __forceinline__ void scan_step(const int n, const LAS unsigned char* cur, f32x4 (&S)[8], float* op, const int ulo, const int c16, const int q4) {
    bf16x8 sf[4];
#pragma unroll
    for (int s2 = 0; s2 < 4; ++s2) sf[s2] = pack_frag(S[2 * s2], S[2 * s2 + 1]);
    f32x4 Pm[4], Om[4];
#pragma unroll
    for (int mt = 0; mt < 4; ++mt) { Pm[mt] = (f32x4){0.f, 0.f, 0.f, 0.f}; Om[mt] = (f32x4){0.f, 0.f, 0.f, 0.f}; }
#pragma unroll
    for (int mt = 0; mt < 4; ++mt)
#pragma unroll
        for (int s2 = 0; s2 < 4; ++s2) {
            const bf16x8 aw = lda_frag(cur + IMG_W + (16 * mt + c16) * 272 + (32 * s2 + 4 * q4) * 2);
            const bf16x8 aq = lda_frag(cur + IMG_Q + (16 * mt + c16) * 272 + (32 * s2 + 4 * q4) * 2);
            Pm[mt] = __builtin_amdgcn_mfma_f32_16x16x32_bf16(aw, sf[s2], Pm[mt], 0, 0, 0);
            Om[mt] = __builtin_amdgcn_mfma_f32_16x16x32_bf16(aq, sf[s2], Om[mt], 0, 0, 0);
        }
    const float dec = *(const LAS float*)(cur + IMG_U + 128);
    f32x4 Vm[4];
#pragma unroll
    for (int mt = 0; mt < 4; ++mt) { const v2u uc = *(const LAS v2u*)(cur + ulo + 32 * mt); const f32x4 u4 = (f32x4){bflo(uc.x), bfhi(uc.x), bflo(uc.y), bfhi(uc.y)}; Vm[mt] = u4 - Pm[mt] * (1.f / IMG_SC); }
    bf16x8 vf[2], vg[2];
    vf[0] = pack_frag(Vm[0], Vm[1]); vf[1] = pack_frag(Vm[2], Vm[3]);
    vg[0] = pack_frag(Vm[0] * (1.f / IMG_SC), Vm[1] * (1.f / IMG_SC)); vg[1] = pack_frag(Vm[2] * (1.f / IMG_SC), Vm[3] * (1.f / IMG_SC));
#pragma unroll
    for (int mt = 0; mt < 4; ++mt)
#pragma unroll
        for (int s2 = 0; s2 < 2; ++s2) {
            const bf16x8 aa = lda_frag(cur + IMG_A + (16 * mt + c16) * IMG_KS + (32 * s2 + 4 * q4) * 2);
            Om[mt] = __builtin_amdgcn_mfma_f32_16x16x32_bf16(aa, vf[s2], Om[mt], 0, 0, 0);
        }
#pragma unroll
    for (int m8 = 0; m8 < 8; ++m8) { S[m8] = S[m8] * dec;
#pragma unroll
        for (int s2 = 0; s2 < 2; ++s2) {
            const bf16x8 ak = lda_frag(cur + IMG_K + (16 * m8 + c16) * IMG_KS + (32 * s2 + 4 * q4) * 2);
            S[m8] = __builtin_amdgcn_mfma_f32_16x16x32_bf16(ak, vg[s2], S[m8], 0, 0, 0);
        } }
    float* o2 = op + (size_t)n * CH * 512;
#pragma unroll
    for (int mt = 0; mt < 4; ++mt)
#pragma unroll
        for (int i = 0; i < 4; ++i) o2[(size_t)(16 * mt + i) * 512] = Om[mt][i] * (1.f / IMG_SC);
    asm volatile("s_waitcnt lgkmcnt(0)" ::: "memory"); __builtin_amdgcn_s_barrier(); asm volatile("" ::: "memory");
}
constexpr int SC_NP = 11;
#define SC_LD(R, nn) do { const int n_ = ((nn) < NCH) ? (nn) : NCH - 1; const unsigned char* q_ = img + (size_t)n_ * istep; \
    { unsigned sp_ = 0; while (n_ >= ready) { const unsigned long long m_ = __ballot(__hip_atomic_load(flagp + lane * 4, RLX_AGENT) != 0u); ready = (m_ == ~0ull) ? 64 : __builtin_ctzll(~m_); \
        if (n_ >= ready) { __builtin_amdgcn_s_sleep(8); if (++sp_ > (1u << 20)) break; } } } \
    _Pragma("unroll") for (int p_ = 0; p_ < SC_NP; ++p_) { if (p_ < 8) asm volatile("global_load_dwordx4 %0, %1, %2" : "=v"(R[p_]) : "v"(vmain), "s"(q_ + p_ * 4096) : "memory"); \
        else asm volatile("global_load_dwordx4 %0, %1, %2" : "=v"(R[p_]) : "v"(vmain), "s"(q_ + GI_U + upart + (p_ - 8) * 4096) : "memory"); } } while (0)
#define SC_WAITR(R, CNT) asm volatile("s_waitcnt vmcnt(" #CNT ")" : "+v"(R[0]), "+v"(R[1]), "+v"(R[2]), "+v"(R[3]), "+v"(R[4]), "+v"(R[5]), "+v"(R[6]), "+v"(R[7]), "+v"(R[8]), "+v"(R[9]), "+v"(R[10]) :: "memory")
__device__ __forceinline__ void sc_cvt_store(LAS unsigned char* dst, const v4u q) {
    const unsigned qq[4] = {q.x, q.y, q.z, q.w}; unsigned o[8];
#pragma unroll
    for (int j = 0; j < 4; ++j) { const f32x2_t p0 = __builtin_amdgcn_cvt_pk_f32_fp8(qq[j], false), p1 = __builtin_amdgcn_cvt_pk_f32_fp8(qq[j], true); o[2 * j] = pk2(p0[0], p0[1]); o[2 * j + 1] = pk2(p1[0], p1[1]); }
    *(LAS v4u*)dst = (v4u){o[0], o[1], o[2], o[3]}; *(LAS v4u*)(dst + 16) = (v4u){o[4], o[5], o[6], o[7]};
}
#define SC_ST(R, buf) do { LAS unsigned char* b_ = (buf); _Pragma("unroll") for (int p_ = 0; p_ < 8; ++p_) if (p_ < 7 || hl * 16 < IMG_U / 2 - 7 * 4096) sc_cvt_store(b_ + 2 * (p_ * 4096 + hl * 16), R[p_]); \
    _Pragma("unroll") for (int p_ = 8; p_ < SC_NP; ++p_) if (p_ < 10 || hl * 16 < IMG_UHALF - 2 * 4096) *(LAS v4u*)(b_ + IMG_U + (p_ - 8) * 4096 + hl * 16) = R[p_]; \
    asm volatile("s_waitcnt lgkmcnt(0)" ::: "memory"); } while (0)
#define SC_BAR() do { __builtin_amdgcn_s_barrier(); asm volatile("" ::: "memory"); } while (0)
__device__ __forceinline__ void scan_item(Frame& F, int item) {
    static_assert(SCAN_NCW == 4 && 2 * IMG_LDS <= SCRATCH_BYTES && 8 * 4096 >= IMG_U / 2 && 7 * 4096 < IMG_U / 2 && GI_U + 2 * IMG_UHALF + 4096 <= IMG_BYTES, "scan geometry");
    constexpr int NSPLIT = 8 / SCAN_NCW;
    const int bh = item / NSPLIT, part = item % NSPLIT, b = bh >> 2, h = bh & 3, tid = F.tid, lane = F.lane, c16 = lane & 15, q4 = lane >> 4;
    const bool comp = F.wave < SCAN_NCW;
    LAS unsigned char* bufs = F.lds;
    const size_t istep = (size_t)4 * IMG_BYTES;
    const unsigned char* img = F.dnimg() + (size_t)((b * 64) * 4 + h) * IMG_BYTES;
    __syncthreads();
    if (comp) {
        const int dv0 = (part * SCAN_NCW + F.wave) * 16;
        const int ulo = IMG_U + (F.wave * 16 + c16) * 136 + 8 * q4;
        float* op = F.odn() + (size_t)(b * SEQ + 4 * q4) * 512 + h * 128 + dv0 + c16;
        f32x4 S[8];
#pragma unroll
        for (int i = 0; i < 8; ++i) S[i] = (f32x4){0.f, 0.f, 0.f, 0.f};
        SC_BAR();
        for (int n = 0; n < NCH; n += 2) { scan_step(n, bufs, S, op, ulo, c16, q4); scan_step(n + 1, bufs + IMG_LDS, S, op, ulo, c16, q4); }
    } else {
        const int hl = tid - 256;
        gu32* flagp = F.ctl + CW_FLAG + (b * 64) * 4 + h;
        int ready = 0;
        const unsigned vmain = (unsigned)hl * 16u; const int upart = part * IMG_UHALF;
        v4u R0[SC_NP], R1[SC_NP];
        SC_LD(R0, 0); SC_LD(R1, 1);
        SC_WAITR(R0, 11); SC_ST(R0, bufs); SC_LD(R0, 2); SC_BAR();
        for (int n = 0; n < NCH - 2; n += 2) {
            SC_WAITR(R1, 11); SC_ST(R1, bufs + IMG_LDS); SC_LD(R1, n + 3); SC_BAR();
            SC_WAITR(R0, 11); SC_ST(R0, bufs); SC_LD(R0, n + 4); SC_BAR();
        }
        SC_WAITR(R1, 11); SC_ST(R1, bufs + IMG_LDS); SC_LD(R1, NCH + 1); SC_BAR();
        SC_BAR();
        SC_WAITR(R0, 0); SC_WAITR(R1, 0);
    }
}
__device__ __forceinline__ void p34_mix(Frame& F, const XcdBarrier& bar) {
    constexpr int NSCAN = 16 * (8 / SCAN_NCW);
    if (F.G > NSCAN + 32) {
        if ((int)blockIdx.x < NSCAN) {
#ifndef NO_SCAN
            scan_item(F, (int)blockIdx.x);
#endif
        } else { const int np = F.G - NSCAN;
#ifndef NO_PREP
            int lasth = -1;
            for (int k = (int)blockIdx.x - NSCAN; k < 1024; k += np) { const int n = k >> 4, bh = k & 15; dn_prep_item(F, ((bh >> 2) * 64 + n) * 4 + (bh & 3), (bh & 3) != lasth); lasth = bh & 3; }
#endif
#ifndef NO_TR
            __syncthreads(); expert_transposes(F, NSCAN);
#endif
        }
#ifndef NO_SWA
        for (;;) { __syncthreads(); if (F.tid == 0) F.MISC[20] = __hip_atomic_fetch_add(F.ctl + CW_SWAQ, 1u, RLX_AGENT); __syncthreads(); const int it = (int)F.MISC[20]; if (it >= 256) break; swa_item(F, it); }
#endif
    }
}

__device__ __forceinline__ void p5_dnnorm(Frame& F) {
    const int gw = F.vcu * NWAVES + F.wave, NGW = F.G * NWAVES, lane = F.lane, d0 = (lane & 15) * 8;
    for (int t = gw; t < T; t += NGW) {
        const f32x4* op = (const f32x4*)(F.odn() + (size_t)t * 512 + lane * 8);
        const f32x4 a = op[0], c = op[1];
        float ss = (a.x * a.x + a.y * a.y) + (a.z * a.z + a.w * a.w) + (c.x * c.x + c.y * c.y) + (c.z * c.z + c.w * c.w);
        ss += __shfl_xor(ss, 1); ss += __shfl_xor(ss, 2); ss += __shfl_xor(ss, 4); ss += __shfl_xor(ss, 8);
        const float rs = rsqrtf(ss * (1.f / 128.f) + EPS);
        const v4u zz = *(const v4u*)(F.PROJ() + (size_t)t * NPROJ + PC_Z + lane * 8);
        const f32x4 w0 = *(const f32x4*)(F.dn_norm_w + d0), w1 = *(const f32x4*)(F.dn_norm_w + d0 + 4);
        float r[8] = {a.x * rs * w0.x, a.y * rs * w0.y, a.z * rs * w0.z, a.w * rs * w0.w, c.x * rs * w1.x, c.y * rs * w1.y, c.z * rs * w1.z, c.w * rs * w1.w};
        const float z[8] = {bflo(zz.x), bfhi(zz.x), bflo(zz.y), bfhi(zz.y), bflo(zz.z), bfhi(zz.z), bflo(zz.w), bfhi(zz.w)};
#pragma unroll
        for (int i = 0; i < 8; ++i) r[i] *= siluf(z[i]);
        v4u w; w.x = pk2(r[0], r[1]); w.y = pk2(r[2], r[3]); w.z = pk2(r[4], r[5]); w.w = pk2(r[6], r[7]);
        *(v4u*)(F.MIXED() + (size_t)t * D + lane * 8) = w;
    }
}

__device__ __forceinline__ void p7_router(Frame& F) {
    LAS bf16* Wh = (LAS bf16*)F.lds; LAS bf16* Wl = Wh + 32 * WR_STRIDE; LAS float* LG = (LAS float*)(F.lds + 2 * 32 * WR_STRIDE * 2);
    const int lane = F.lane, r16 = lane & 15, q4 = lane >> 4, wq = F.wave & 3, eh = F.wave >> 2;
    __syncthreads();
    { const v4u* src = (const v4u*)F.wrimg(); LAS v4u* dst = (LAS v4u*)Wh;
#pragma unroll 4
      for (int i = F.tid; i < 2 * 32 * WR_STRIDE / 8; i += NWAVES * 64) dst[i] = src[i]; }
    for (int rg = blockIdx.x; rg < 256; rg += F.G) {
        const int b = rg >> 6, t = rg * 64 + wq * 16 + r16;
        const float* m2a = F.modf() + 32768 + b * 1024; const float* m2b = F.modf() + 32768 + 4096 + b * 1024;
        __syncthreads();
        for (int i = F.tid; i < 64 * 33; i += NWAVES * 64) LG[i] = 0.f;
        float mB2;
        { float m = fmaxf(fabsf(m2b[F.tid]), fabsf(m2b[F.tid + 512]));
#pragma unroll
          for (int o = 1; o < 64; o <<= 1) m = fmaxf(m, __shfl_xor(m, o));
          LAS float* red = (LAS float*)(LG + 64 * 33 + 64);
          if (lane == 0) red[F.wave] = m;
          __syncthreads();
          mB2 = fmaxf(fmaxf(fmaxf(red[0], red[1]), fmaxf(red[2], red[3])), fmaxf(fmaxf(red[4], red[5]), fmaxf(red[6], red[7])));
          __syncthreads(); }
        const float* xr = F.out + (size_t)t * D + 8 * q4;
        float ss = 0.f, ma = 0.f;
        { const f32x4* rp = (const f32x4*)(F.rstat() + (size_t)t * 32);
#pragma unroll
          for (int i = 0; i < 8; ++i) { const f32x4 q = rp[i]; ss += q.x + q.z; ma = fmaxf(ma, fmaxf(q.y, q.w)); } }
        const float rstd = rsqrtf(ss * (1.f / D) + EPS);
        const float amax = fmaxf(rstd * ma + mB2, 1e-30f), qs = 127.f / amax;
        if (eh == 0 && q4 == 0) { F.hscale()[t] = amax * (1.f / 127.f); ((LAS float*)(LG + 64 * 33 + 96))[wq * 16 + r16] = amax * (1.f / 127.f); }
        f32x4 acc0 = (f32x4){0.f, 0.f, 0.f, 0.f}, acc1 = acc0;
        const LAS bf16* whp = Wh + r16 * WR_STRIDE + 8 * q4; const LAS bf16* wlp = Wl + r16 * WR_STRIDE + 8 * q4;
        signed char* qrow = F.H8() + (size_t)t * D + 8 * q4;
#pragma unroll 4
        for (int s3 = 0; s3 < 16; ++s3) { const int s2 = 16 * eh + s3;
            const f32x4 a = *(const f32x4*)(xr + 32 * s2), c = *(const f32x4*)(xr + 32 * s2 + 4);
            const f32x4 a0 = *(const f32x4*)(m2a + 32 * s2 + 8 * q4), a1 = *(const f32x4*)(m2a + 32 * s2 + 8 * q4 + 4), b0 = *(const f32x4*)(m2b + 32 * s2 + 8 * q4), b1 = *(const f32x4*)(m2b + 32 * s2 + 8 * q4 + 4);
            const f32x4 h0 = a * rstd * a0 + b0, h1 = c * rstd * a1 + b1;
            float hv[8] = {h0.x, h0.y, h0.z, h0.w, h1.x, h1.y, h1.z, h1.w}; unsigned hw[4], lw[4];
#pragma unroll
            for (int i = 0; i < 4; ++i) { hw[i] = pk2(hv[2 * i], hv[2 * i + 1]); lw[i] = pk2(hv[2 * i] - bflo(hw[i]), hv[2 * i + 1] - bfhi(hw[i])); }
            const v4u xhw = (v4u){hw[0], hw[1], hw[2], hw[3]};
            const v4u xlw = (v4u){lw[0], lw[1], lw[2], lw[3]};
            { int q[8];
#pragma unroll
              for (int i = 0; i < 8; ++i) q[i] = (int)rintf(hv[i] * qs);
              const unsigned lo = (unsigned)(q[0] & 255) | ((unsigned)(q[1] & 255) << 8) | ((unsigned)(q[2] & 255) << 16) | ((unsigned)(q[3] & 255) << 24);
              const unsigned hi = (unsigned)(q[4] & 255) | ((unsigned)(q[5] & 255) << 8) | ((unsigned)(q[6] & 255) << 16) | ((unsigned)(q[7] & 255) << 24);
              *(v2u*)(qrow + 32 * s2) = (v2u){lo, hi}; }
            const bf16x8 xh = __builtin_bit_cast(bf16x8, xhw), xl = __builtin_bit_cast(bf16x8, xlw);
            const bf16x8 wh0 = *(const LAS bf16x8*)(whp + 32 * s2), wl0 = *(const LAS bf16x8*)(wlp + 32 * s2), wh1 = *(const LAS bf16x8*)(whp + 16 * WR_STRIDE + 32 * s2), wl1 = *(const LAS bf16x8*)(wlp + 16 * WR_STRIDE + 32 * s2);
            acc0 = __builtin_amdgcn_mfma_f32_16x16x32_bf16(wh0, xh, acc0, 0, 0, 0); acc1 = __builtin_amdgcn_mfma_f32_16x16x32_bf16(wh1, xh, acc1, 0, 0, 0);
            acc0 = __builtin_amdgcn_mfma_f32_16x16x32_bf16(wh0, xl, acc0, 0, 0, 0); acc1 = __builtin_amdgcn_mfma_f32_16x16x32_bf16(wh1, xl, acc1, 0, 0, 0);
            acc0 = __builtin_amdgcn_mfma_f32_16x16x32_bf16(wl0, xh, acc0, 0, 0, 0); acc1 = __builtin_amdgcn_mfma_f32_16x16x32_bf16(wl1, xh, acc1, 0, 0, 0);
        }
#pragma unroll
        for (int i = 0; i < 4; ++i) { atomicAdd((float*)(LG + (wq * 16 + r16) * 33 + 4 * q4 + i), acc0[i] + (eh == 0 ? F.b_router[4 * q4 + i] : 0.f)); atomicAdd((float*)(LG + (wq * 16 + r16) * 33 + 16 + 4 * q4 + i), acc1[i] + (eh == 0 ? F.b_router[16 + 4 * q4 + i] : 0.f)); }
        __syncthreads();
        LAS unsigned* lc = (LAS unsigned*)(LG + 64 * 33); LAS unsigned* lbase = lc + 32;
        if (F.tid < 32) lc[F.tid] = 0u;
        __syncthreads();
        float tv[4]; int ti[4]; unsigned rk[4];
        if (F.wave == 0) {
#pragma unroll
            for (int r = 0; r < 4; ++r) { float bv = -3.0e38f; int bi = 0;
                for (int e = 0; e < 32; ++e) { const float v = LG[lane * 33 + e]; const bool taken = (r > 0 && ti[0] == e) || (r > 1 && ti[1] == e) || (r > 2 && ti[2] == e); if (!taken && v > bv) { bv = v; bi = e; } }
                tv[r] = bv; ti[r] = bi; rk[r] = atomicAdd((unsigned*)(lc + bi), 1u); }
        }
        __syncthreads();
        if (F.tid < 32) lbase[F.tid] = atomicAdd((unsigned*)(F.ctl + CW_CNT + 64 * F.tid), lc[F.tid]);
        __syncthreads();
        if (F.wave == 0) {
            const int tt = rg * 64 + lane;
            const float e1 = __expf(tv[1] - tv[0]), e2 = __expf(tv[2] - tv[0]), e3 = __expf(tv[3] - tv[0]), inv = 1.f / (1.f + e1 + e2 + e3);
            const float gts[4] = {inv, e1 * inv, e2 * inv, e3 * inv}; const float hsr = ((const LAS float*)(LG + 64 * 33 + 96))[lane];
#pragma unroll
            for (int r = 0; r < 4; ++r) { const unsigned pos = lbase[ti[r]] + rk[r]; F.lslot()[ti[r] * T + pos] = tt * 4 + r; F.lgate()[ti[r] * T + pos] = gts[r]; F.lhs()[ti[r] * T + pos] = hsr; }
        }
    }
}

__device__ __forceinline__ void moe_plan(Frame& F) {
    LAS int* P = (LAS int*)(F.lds + CTRL_OFF + 256); LAS int* ord = P + PL_GE + 128;
    __syncthreads();
    if (F.tid < NE) { const int c = (int)__hip_atomic_load(F.ctl + CW_CNT + 64 * F.tid, RLX_AGENT); P[PL_CNT + F.tid] = c; P[PL_NT + F.tid] = (c + 255) >> 8; }
    if (F.tid < 8) P[PL_GN + F.tid] = 0;
    __syncthreads();
    if (F.tid < NE) { const int e = F.tid, k = P[PL_NT + e]; int rank = 0, ts = 0;
        for (int o = 0; o < NE; ++o) { const int ko = P[PL_NT + o]; rank += (ko > k || (ko == k && o < e)) ? 1 : 0; ts += (o < e) ? ko : 0; }
        ord[rank] = e; P[PL_TS + e] = ts; }
    __syncthreads();
    if (F.tid == 0) {
        int load[8], gn[8];
#pragma unroll
        for (int g = 0; g < 8; ++g) { load[g] = 0; gn[g] = 0; }
        for (int it = 0; it < NE; ++it) { const int be = ord[it], bk = P[PL_NT + be];
            int bg = 0, bl = load[0];
#pragma unroll
            for (int g = 1; g < 8; ++g) if (load[g] < bl) { bl = load[g]; bg = g; }
            int n = 0;
#pragma unroll
            for (int g = 0; g < 8; ++g) if (g == bg) { n = gn[g]; load[g] += bk; gn[g] += 1; }
            P[PL_GE + bg * 16 + n] = be; }
#pragma unroll
        for (int g = 0; g < 8; ++g) P[PL_GN + g] = gn[g];
    }
    __syncthreads();
}

__device__ __forceinline__ void p2_proj(Frame& F) {
    pg8::Gemm g{(const bf16*)F.Hq(), (const bf16*)F.Win8(), T, NPROJ, D / 2}; DenseOrder S; S.init(T, NPROJ, D / 2, F.G, (int)blockIdx.x, F.tid);
    EpiProjI8 E{F.PROJ(), F.hscale1(), F.inscale()};
    pg8::gemm_phase<EpiProjI8, DenseOrder, true, true>(F.lds, g, S, E, F.wave, F.lane);
}
__device__ __forceinline__ void p6_outproj(Frame& F) {
    pg8::Gemm g{F.MIXED(), F.Wout_t(), T, D, D}; DenseOrder S; S.init(T, D, D, F.G, (int)blockIdx.x, F.tid);
    EpiX1 E{F.x, F.out, F.modf(), F.rstat()};
    pg8::gemm_phase<EpiX1, DenseOrder, true, true>(F.lds, g, S, E, F.wave, F.lane);
}
__device__ __forceinline__ void p9_up(Frame& F) {
    moe_plan(F);
    pg8::Gemm g{(const bf16*)F.H8(), (const bf16*)F.Wup8(), 0, 0, D / 2};
    MoeOrder S{8, F.G / 8, (int)blockIdx.x / 8, (int)blockIdx.x % 8, 2048, 1024, (const LAS int*)(F.lds + CTRL_OFF + 256), F.lslot(), true, F.tid};
    EpiSwiglu E{(unsigned char*)F.ACT(), F.b_up, F.upscale(), F.lhs(), (const LAS int*)(F.lds + CTRL_OFF + 256)};
    pg8::gemm_phase<EpiSwiglu, MoeOrder, true, true>(F.lds, g, S, E, F.wave, F.lane);
}
__device__ __forceinline__ void p10_down(Frame& F, bool have_plan) {
    if (!have_plan) moe_plan(F);
    pg8::Gemm g{F.ACT(), F.Wdn_t(), 0, 0, DFF / 2};
    MoeOrder S{4, F.G / 8, (int)blockIdx.x / 8, (int)blockIdx.x % 8, 1024, 1024, (const LAS int*)(F.lds + CTRL_OFF + 256), F.lslot(), false, F.tid};
    EpiDown E{(unsigned char*)F.SLOT(), F.lslot(), F.lgate(), F.b_down, (const LAS int*)(F.lds + CTRL_OFF + 256)};
    pg8::gemm_phase<EpiDown, MoeOrder, true, true>(F.lds, g, S, E, F.wave, F.lane);
}
__device__ __forceinline__ void p11_combine(Frame& F) {
    const int gw = F.vcu * NWAVES + F.wave, NGW = F.G * NWAVES, lane = F.lane;
    for (int t0 = gw * 2; t0 < T; t0 += NGW * 2) {
        v2u w[2][2][4]; f32x4 x[2][2][2];
#pragma unroll
        for (int tt = 0; tt < 2; ++tt)
#pragma unroll
            for (int j = 0; j < 2; ++j) { const int col = j * 512 + lane * 8;
#pragma unroll
                for (int k = 0; k < 4; ++k) w[tt][j][k] = *(const v2u*)((const unsigned char*)F.SLOT() + (size_t)((t0 + tt) * 4 + k) * D + col);
                x[tt][j][0] = *(const f32x4*)(F.out + (size_t)(t0 + tt) * D + col); x[tt][j][1] = *(const f32x4*)(F.out + (size_t)(t0 + tt) * D + col + 4); }
        const float* g2 = F.modf() + (t0 >> 12) * 6144 + 5120;
#pragma unroll
        for (int j = 0; j < 2; ++j) { const int col = j * 512 + lane * 8;
            const f32x4 g0 = *(const f32x4*)(g2 + col), g1 = *(const f32x4*)(g2 + col + 4);
#pragma unroll
            for (int tt = 0; tt < 2; ++tt) { float sm[8];
#pragma unroll
                for (int i = 0; i < 8; ++i) sm[i] = 0.f;
#pragma unroll
                for (int k = 0; k < 4; ++k) { const v2u q = w[tt][j][k];
                    const f32x2_t p0 = __builtin_amdgcn_cvt_pk_f32_fp8(q.x, false), p1 = __builtin_amdgcn_cvt_pk_f32_fp8(q.x, true), p2 = __builtin_amdgcn_cvt_pk_f32_fp8(q.y, false), p3 = __builtin_amdgcn_cvt_pk_f32_fp8(q.y, true);
                    sm[0] += p0[0]; sm[1] += p0[1]; sm[2] += p1[0]; sm[3] += p1[1]; sm[4] += p2[0]; sm[5] += p2[1]; sm[6] += p3[0]; sm[7] += p3[1]; }
#pragma unroll
                for (int i = 0; i < 8; ++i) sm[i] *= (1.f / 16.f);
                f32x4 x0 = x[tt][j][0], x1 = x[tt][j][1];
                x0.x += g0.x * sm[0]; x0.y += g0.y * sm[1]; x0.z += g0.z * sm[2]; x0.w += g0.w * sm[3]; x1.x += g1.x * sm[4]; x1.y += g1.y * sm[5]; x1.z += g1.z * sm[6]; x1.w += g1.w * sm[7];
                if (PROBE_A >= 0) { const float dtus = (float)(__hip_atomic_load(F.ctl + CW_TS + PROBE_A + 1, RLX_AGENT) - __hip_atomic_load(F.ctl + CW_TS + PROBE_A, RLX_AGENT)) * 0.01f; const float sc = 1.f + sqrtf(dtus * PROBE_SCALE); x0 = x0 * sc; x1 = x1 * sc; }
                if (PROBE_B >= 0 && t0 + tt == 0 && lane == 0 && j == 0) { const float dtus = (float)(__hip_atomic_load(F.ctl + CW_TS + PROBE_B + 1, RLX_AGENT) - __hip_atomic_load(F.ctl + CW_TS + PROBE_B, RLX_AGENT)) * 0.01f; x0.x += 1.f + dtus * 0.01f; }
                f32x4* op = (f32x4*)(F.out + (size_t)(t0 + tt) * D + col); op[0] = x0; op[1] = x1; } }
    }
}

__global__ void __launch_bounds__(NWAVES * 64, 2) fwd_kernel(Args args) {
    extern __shared__ __attribute__((aligned(16))) unsigned char lds[];
    Frame F;
    F.lds = (LAS unsigned char*)lds;
    F.MISC = (volatile LAS unsigned*)(F.lds + CTRL_OFF);
    F.wave = __builtin_amdgcn_readfirstlane((int)threadIdx.x >> 6); F.refresh();
    F.G = gridDim.x; { const int bx = blockIdx.x; F.vcu = (F.G % 8 == 0) ? (bx % 8) * (F.G / 8) + bx / 8 : bx; }
    for (int u = F.tid; u < 32; u += NWAVES * 64) ((LAS unsigned*)(F.lds + CTRL_OFF))[u] = 0u;
    __syncthreads();
    XcdBarrier bar; bar.bar = (unsigned*)(F.ctl + CW_BAR); bar.x = 0; bar.st = nullptr;
    if (N_LAUNCHES == 1) bar = xcd_barrier_post((unsigned*)(F.ctl + CW_BAR), F.MISC + 8, (unsigned)F.wave);
    const int lo = args.ph_lo, hi = args.ph_hi;
#ifndef PHASE_MASK
#define PHASE_MASK 0xFFFu
#endif
#define IN(k) (((PHASE_MASK >> (k)) & 1u) && lo <= (k) && (k) < hi)
#define SEAM(k) do { if (IN(k) && IN((k) + 1)) xcd_barrier(bar); if ((PROBE_A >= 0 || PROBE_B >= 0) && blockIdx.x == 0 && F.tid == 0) __hip_atomic_store(F.ctl + CW_TS + (k) + 1, (unsigned)rt(), RLX_AGENT); } while (0)

#ifndef DUP_MASK
#define DUP_MASK 0u
#endif
#define DUP(k) ((DUP_MASK >> (k)) & 1u)
    if ((PROBE_A >= 0 || PROBE_B >= 0) && blockIdx.x == 0 && F.tid == 0) __hip_atomic_store(F.ctl + CW_TS, (unsigned)rt(), RLX_AGENT);
    if (IN(0)) { F.refresh(); for (int st = blockIdx.x; st < 48; st += F.G) quant_in_item(F, st); __syncthreads(); p0_prologue(F); if (DUP(0)) { xcd_barrier(bar); p0_prologue(F); } SEAM(0); }
    if (IN(1)) { F.refresh(); p1_hrows(F); if (DUP(1)) { xcd_barrier(bar); p1_hrows(F); } SEAM(1); }
    if (IN(2)) { F.refresh(); p2_proj(F); if (DUP(2)) { xcd_barrier(bar); p2_proj(F); } SEAM(2); }
    if (IN(3)) { F.refresh(); p34_mix(F, bar); if (IN(3) && IN(5)) xcd_barrier(bar); if ((PROBE_A >= 0 || PROBE_B >= 0) && blockIdx.x == 0 && F.tid == 0) { __hip_atomic_store(F.ctl + CW_TS + 4, (unsigned)rt(), RLX_AGENT); __hip_atomic_store(F.ctl + CW_TS + 5, (unsigned)rt(), RLX_AGENT); } }
    if (IN(5)) { F.refresh(); p5_dnnorm(F); if (DUP(5)) { xcd_barrier(bar); p5_dnnorm(F); } SEAM(5); }
    if (IN(6)) { F.refresh(); p6_outproj(F); if (DUP(6)) { xcd_barrier(bar); p6_outproj(F); } SEAM(6); }
    if (IN(7)) { F.refresh(); p7_router(F); if (IN(7) && IN(9)) xcd_barrier(bar); if ((PROBE_A >= 0 || PROBE_B >= 0) && blockIdx.x == 0 && F.tid == 0) { __hip_atomic_store(F.ctl + CW_TS + 8, (unsigned)rt(), RLX_AGENT); __hip_atomic_store(F.ctl + CW_TS + 9, (unsigned)rt(), RLX_AGENT); } }
    if (IN(9)) { F.refresh(); p9_up(F); if (DUP(9)) { xcd_barrier(bar); p9_up(F); } SEAM(9); }
    if (IN(10)) { F.refresh(); p10_down(F, IN(9)); SEAM(10); }
    if (IN(11)) { F.refresh(); p11_combine(F); }
#undef IN
#undef SEAM
}

extern "C" void kernel_launch(void* const* d_in, const int* in_sizes, int n_in, void* d_out, int out_size, void* d_ws, size_t ws_size, hipStream_t stream) {
    static int grid = 0;
    if (grid == 0) {
        if (n_in != 21 || out_size != T * D || ws_size < WS_END) { fprintf(stderr, "kernel_launch: unexpected shapes (n_in %d out %d ws %zu)\n", n_in, out_size, ws_size); grid = -1; return; }
        int dev = 0, cus = 0;
        if (hipGetDevice(&dev) != hipSuccess || hipDeviceGetAttribute(&cus, hipDeviceAttributeMultiprocessorCount, dev) != hipSuccess) { grid = -1; return; }
        if (hipFuncSetAttribute((const void*)fwd_kernel, hipFuncAttributeMaxDynamicSharedMemorySize, LDS_BYTES) != hipSuccess) { fprintf(stderr, "kernel_launch: hipFuncSetAttribute failed\n"); grid = -1; return; }
        int per_cu = 0;
        if (hipOccupancyMaxActiveBlocksPerMultiprocessor(&per_cu, (const void*)fwd_kernel, NWAVES * 64, LDS_BYTES) != hipSuccess || per_cu < 1) fprintf(stderr, "kernel_launch: occupancy query reports %d\n", per_cu);
        (void)hipGetLastError();
        grid = cus;
    }
    if (grid < 0) return;
    if (hipMemsetAsync((char*)d_ws + WS_CTL, 0, CTL_ZERO_BYTES, stream) != hipSuccess) { fprintf(stderr, "kernel_launch: memset failed\n"); return; }
    Args a{};
    for (int i = 0; i < 21; ++i) a.in[i] = (const float*)d_in[i];
    a.out = (float*)d_out; a.ws = (unsigned char*)d_ws;
    for (int li = 0; li < N_LAUNCHES; ++li) {
        a.ph_lo = (N_LAUNCHES == 1) ? 0 : li; a.ph_hi = (N_LAUNCHES == 1) ? NPH : li + 1; a.li = li;
        hipLaunchKernelGGL(fwd_kernel, dim3(grid), dim3(NWAVES * 64), LDS_BYTES, stream, a);
        const hipError_t le = hipPeekAtLastError();
        if (le != hipSuccess) { fprintf(stderr, "kernel_launch: launch %d failed: %s\n", li, hipGetErrorName(le)); break; }
    }
}
```

```cpp
#include <hip/hip_runtime.h>
#include <cstdio>
#include <cstdint>

namespace pg8 {
#define PG8_LAS __attribute__((address_space(3)))
typedef unsigned short bf16_t;
typedef short bf16x8 __attribute__((ext_vector_type(8)));
typedef float f32x4 __attribute__((ext_vector_type(4)));
typedef unsigned u32x4 __attribute__((ext_vector_type(4)));
constexpr int BM = 256, BK = 64, HALF = 128, HTB = HALF * BK * 2  , STAGE_BYTES = 8 * HTB, NXCD = 8, WGM = 8;

__host__ __device__ __forceinline__ int lds_byte(int r, int c) { const int st = (r >> 4) * 2 + (c >> 5), rr = r & 15, cc = c & 31, ob = rr * 64 + cc * 2; return st * 1024 + (ob ^ (((ob >> 9) & 1) << 5)); }
__host__ __device__ __forceinline__ void stage_rc(int b, int& R, int& C) { const int st = b / 1024, sb = b % 1024, swz = sb ^ (((sb >> 9) & 1) << 5); R = (st >> 1) * 16 + swz / 64; C = (st & 1) * 32 + (swz % 64) / 2; }
__host__ __device__ __forceinline__ int perm32(int rho) { const int n = rho >> 4, i = rho & 15; return 8 * (i >> 2) + 4 * n + (i & 3); }

struct Unit { int pm, pn, e, l0; };
typedef int i32x4 __attribute__((ext_vector_type(4)));
typedef int i32x8 __attribute__((ext_vector_type(8)));
__device__ __forceinline__ bf16x8 frag_lo(i32x8 v) { return __builtin_bit_cast(bf16x8, __builtin_shufflevector(v, v, 0, 1, 2, 3)); }
__device__ __forceinline__ bf16x8 frag_hi(i32x8 v) { return __builtin_bit_cast(bf16x8, __builtin_shufflevector(v, v, 4, 5, 6, 7)); }
struct MmaBf16 { typedef f32x4 acc_t; static __device__ __forceinline__ acc_t mma(i32x8 a, i32x8 b, acc_t c) {
    c = __builtin_amdgcn_mfma_f32_16x16x32_bf16(frag_lo(a), frag_lo(b), c, 0, 0, 0); return __builtin_amdgcn_mfma_f32_16x16x32_bf16(frag_hi(a), frag_hi(b), c, 0, 0, 0); } };
struct MmaI8 { typedef i32x4 acc_t; static __device__ __forceinline__ acc_t mma(i32x8 a, i32x8 b, acc_t c) {
    c = __builtin_amdgcn_mfma_i32_16x16x64_i8(__builtin_shufflevector(a, a, 0, 1, 2, 3), __builtin_shufflevector(b, b, 0, 1, 2, 3), c, 0, 0, 0);
    return __builtin_amdgcn_mfma_i32_16x16x64_i8(__builtin_shufflevector(a, a, 4, 5, 6, 7), __builtin_shufflevector(b, b, 4, 5, 6, 7), c, 0, 0, 0); } };
typedef long i64x4v __attribute__((ext_vector_type(4)));
struct MmaFp8 { typedef f32x4 acc_t; static __device__ __forceinline__ acc_t mma(i32x8 a, i32x8 b, acc_t c) {
    asm volatile("v_mfma_f32_16x16x128_f8f6f4 %0, %1, %2, %0" : "+v"(c) : "v"(a), "v"(b)); return c; } };
struct Gemm { const bf16_t* A; const bf16_t* Bt; int M, N, K; };

__device__ __forceinline__ unsigned cvt_pk_bf16(float lo, float hi) { unsigned r; asm volatile("v_cvt_pk_bf16_f32 %0, %1, %2" : "=v"(r) : "v"(lo), "v"(hi)); return r; }
typedef float f32x2 __attribute__((ext_vector_type(2)));
__device__ __forceinline__ f32x2 gelu_pk(f32x2 v) {
    const f32x2 av = __builtin_elementwise_abs(v), d = av * 0.2316418882f + 1.0f;
    f32x2 t; t.x = __builtin_amdgcn_rcpf(d.x); t.y = __builtin_amdgcn_rcpf(d.y);
    f32x2 q = t * 0.5307027145f + (-0.7265760135f); q = q * t + 0.7107068705f; q = q * t + (-0.142248368f); q = q * t + 0.127414796f; q = q * t;
    const f32x2 s = (v * v) * (-0.72134752044f);
    f32x2 e; e.x = __builtin_amdgcn_exp2f(s.x); e.y = __builtin_amdgcn_exp2f(s.y);
    const f32x2 m = v * (q * e), r = v - m;
    f32x2 o; o.x = v.x < 0.f ? m.x : r.x; o.y = v.y < 0.f ? m.y : r.y; return o;
}

template <int ACT  > struct EpiBf16 {
    typedef MmaBf16 Mma; static constexpr bool PERM = true, AFTER_DRAIN = false; static_assert(ACT == 0 || ACT == 1, "EpiBf16: ACT is 0 (none) or 1 (gelu_pk)");
    bf16_t* O; int ldc; const float* bias; int split_cols; size_t split_stride; float scale0;
    __device__ __forceinline__ void operator()(const f32x4 (&acc)[2][2][4][2], const Unit& u, int wr, int wc, int fr, int fq) const {
        const int row0 = u.pm * BM + wr * 64 + fr; int colt = u.pn * BM; bf16_t* base = O;
        float sc = 1.f; if (split_cols) { const int t = colt / split_cols; base += (size_t)t * split_stride; colt -= t * split_cols; if (t == 0) sc = scale0; }
        const int col0 = colt + wc * 32 + 8 * fq, bcol0 = u.pn * BM + wc * 32 + 8 * fq;
        f32x4 bv[2][2];
#pragma unroll
        for (int bj = 0; bj < 2; ++bj)
#pragma unroll
            for (int n = 0; n < 2; ++n) bv[bj][n] = bias ? *(const f32x4*)(bias + bcol0 + bj * HALF + 4 * n) : (f32x4){0.f, 0.f, 0.f, 0.f};
#pragma unroll
        for (int ai = 0; ai < 2; ++ai)
#pragma unroll
            for (int m = 0; m < 4; ++m) { bf16_t* rowp = base + (size_t)(row0 + ai * HALF + m * 16) * ldc + col0;
#pragma unroll
                for (int bj = 0; bj < 2; ++bj) { f32x4 v0 = acc[ai][bj][m][0] + bv[bj][0], v1 = acc[ai][bj][m][1] + bv[bj][1];
                    if (ACT == 1) { f32x2 a = gelu_pk((f32x2){v0[0], v0[1]}), b = gelu_pk((f32x2){v0[2], v0[3]}), c = gelu_pk((f32x2){v1[0], v1[1]}), d = gelu_pk((f32x2){v1[2], v1[3]});
                        v0 = (f32x4){a.x, a.y, b.x, b.y}; v1 = (f32x4){c.x, c.y, d.x, d.y}; }
                    v0 = v0 * sc; v1 = v1 * sc; u32x4 w; w.x = cvt_pk_bf16(v0[0], v0[1]); w.y = cvt_pk_bf16(v0[2], v0[3]); w.z = cvt_pk_bf16(v1[0], v1[1]); w.w = cvt_pk_bf16(v1[2], v1[3]);
                    *(u32x4*)(rowp + bj * HALF) = w; } }
    }
};

template <class Epi, class Sched, bool ALIGN_EPI = false, bool SP2 = false>
__device__ __forceinline__ void gemm_phase(PG8_LAS unsigned char* lds, const Gemm g, const Sched& S, const Epi& E, const int wid, const int lane) {
    const int tid = wid * 64 + lane, wr = wid >> 2, wc = wid & 3, fr = lane & 15, fq = lane >> 4;
    const int K = g.K, nt = K / BK;
    unsigned voffB[2];
#pragma unroll
    for (int i = 0; i < 2; ++i) { int R, C; stage_rc(tid * 16 + i * 8192, R, C); const int Rb = Epi::PERM ? ((R & ~31) + perm32(R & 31)) : R;
        voffB[i] = (unsigned)(Rb * K + C) * 2u; }
    const size_t kstep = (size_t)(BK * 2);
    const size_t hstep = (size_t)HALF * K * 2;
    const unsigned ldsw = (unsigned)wid * 1024u;
    const int aoff = lds_byte(wr * 64 + fr, fq * 8), boff = lds_byte(wc * 32 + fr, fq * 8);
#define PG8_SA(b, h) (((b) * 2 + (h)) * HTB)
#define PG8_SB(b, h) ((4 + (b) * 2 + (h)) * HTB)
#define PG8_STAGE(bufoff, gbase, voff) do { _Pragma("unroll") for (int _i = 0; _i < 2; ++_i) \
        __builtin_amdgcn_global_load_lds((const unsigned*)((const char*)(gbase) + (voff)[_i]), (PG8_LAS unsigned*)(lds + (bufoff) + ldsw + _i * 8192), 16, 0, 0); } while (0)
#define PG8_LDA(dst, b, h) do { _Pragma("unroll") for (int m = 0; m < 4; ++m) { const i32x4 lo_ = *(const PG8_LAS i32x4*)(lds + PG8_SA(b, h) + aoff + m * 2048), hi_ = *(const PG8_LAS i32x4*)(lds + PG8_SA(b, h) + aoff + m * 2048 + 1024); dst[m] = __builtin_shufflevector(lo_, hi_, 0, 1, 2, 3, 4, 5, 6, 7); } } while (0)
#define PG8_LDB(dst, b, h) do { _Pragma("unroll") for (int n = 0; n < 2; ++n) { const i32x4 lo_ = *(const PG8_LAS i32x4*)(lds + PG8_SB(b, h) + boff + n * 2048), hi_ = *(const PG8_LAS i32x4*)(lds + PG8_SB(b, h) + boff + n * 2048 + 1024); dst[n] = __builtin_shufflevector(lo_, hi_, 0, 1, 2, 3, 4, 5, 6, 7); } } while (0)
#define PG8_MMA(ai, bj, At, Bt) do { __builtin_amdgcn_s_setprio(1); _Pragma("unroll") for (int m = 0; m < 4; ++m) _Pragma("unroll") for (int n = 0; n < 2; ++n) \
        acc[ai][bj][m][n] = Epi::Mma::mma(Bt[n], At[m], acc[ai][bj][m][n]); __builtin_amdgcn_s_setprio(0); } while (0)
#define PG8_WAIT_V(n) asm volatile("s_waitcnt vmcnt(" #n ")" ::: "memory")
#define PG8_WAIT_L(n) asm volatile("s_waitcnt lgkmcnt(" #n ")" ::: "memory")
#define PG8_BAR __builtin_amdgcn_s_barrier()
#define PG8_SCHED __builtin_amdgcn_sched_barrier(0)
    Unit cur, nxt; int ui = 0;
    if (!S.next(0, cur)) return;
    typedef typename Epi::Mma::acc_t acc_t;
    acc_t acc[2][2][4][2];
#pragma unroll
    for (int a = 0; a < 2; ++a)
#pragma unroll
        for (int b = 0; b < 2; ++b)
#pragma unroll
            for (int m = 0; m < 4; ++m)
#pragma unroll
                for (int n = 0; n < 2; ++n) acc[a][b][m][n] = acc_t{};
    i32x8 At[4], B0[2], B1[2];
    const char* const A0 = (const char*)g.A; const char* cB = (const char*)g.Bt + S.boff(cur);
    unsigned oA0[2], oA1[2], nA0[2], nA1[2];
    S.a_offsets(cur, oA0, oA1);
    S.a_ready(cur);
    if constexpr (SP2) {
        PG8_STAGE(PG8_SB(0, 0), cB, voffB); PG8_STAGE(PG8_SB(0, 1), cB + hstep, voffB); PG8_STAGE(PG8_SA(0, 0), A0, oA0); PG8_STAGE(PG8_SA(0, 1), A0, oA1);
        if (wr == 1) PG8_BAR;
        PG8_WAIT_V(2); PG8_BAR;
        PG8_STAGE(PG8_SB(1, 0), cB + kstep, voffB); PG8_STAGE(PG8_SA(1, 0), A0 + kstep, oA0); PG8_STAGE(PG8_SB(1, 1), cB + hstep + kstep, voffB);
        PG8_WAIT_V(6); PG8_BAR;
    }
    for (;;) {
        const bool has_next = S.next(ui + 1, nxt);
        const char* nB = has_next ? (const char*)g.Bt + S.boff(nxt) : cB;
        if (has_next) S.a_offsets(nxt, nA0, nA1); else { nA0[0] = oA0[0]; nA0[1] = oA0[1]; nA1[0] = oA1[0]; nA1[1] = oA1[1]; }
#pragma nounroll
        for (int t = 0; t < nt; t += 2) {
            const bool last = (t == nt - 2);
            const char* a1 = A0 + (size_t)(t + 1) * kstep;
            const char* a2 = last ? A0 : A0 + (size_t)(t + 2) * kstep; const char* b2 = last ? nB : cB + (size_t)(t + 2) * kstep;
            unsigned s0[2], s1[2]; s0[0] = last ? nA0[0] : oA0[0]; s0[1] = last ? nA0[1] : oA0[1]; s1[0] = last ? nA1[0] : oA1[0]; s1[1] = last ? nA1[1] : oA1[1];
            const char* a3 = a2 + kstep; const char* b3 = b2 + kstep;
            if (last && has_next) S.a_ready(nxt);
            if constexpr (SP2) {
            PG8_LDB(B0, 0, 0); PG8_LDB(B1, 0, 1); PG8_SCHED; PG8_LDA(At, 0, 0); PG8_STAGE(PG8_SA(1, 1), a1, oA1);
            PG8_WAIT_V(8); PG8_WAIT_L(0); PG8_BAR; PG8_MMA(0, 0, At, B0); PG8_MMA(0, 1, At, B1); PG8_BAR; PG8_SCHED;
            PG8_LDA(At, 0, 1); PG8_STAGE(PG8_SB(0, 0), b2, voffB); PG8_STAGE(PG8_SB(0, 1), b2 + hstep, voffB); PG8_STAGE(PG8_SA(0, 0), a2, s0);
            PG8_WAIT_V(8); PG8_WAIT_L(0); PG8_BAR; PG8_MMA(1, 0, At, B0); PG8_MMA(1, 1, At, B1); PG8_BAR; PG8_SCHED;
            PG8_LDB(B0, 1, 0); PG8_LDB(B1, 1, 1); PG8_SCHED; PG8_LDA(At, 1, 0); PG8_STAGE(PG8_SA(0, 1), a2, s1);
            PG8_WAIT_V(8); PG8_WAIT_L(0); PG8_BAR; PG8_MMA(0, 0, At, B0); PG8_MMA(0, 1, At, B1); PG8_BAR; PG8_SCHED;
            PG8_LDA(At, 1, 1); PG8_STAGE(PG8_SB(1, 0), b3, voffB); PG8_STAGE(PG8_SB(1, 1), b3 + hstep, voffB); PG8_STAGE(PG8_SA(1, 0), a3, s0);
            PG8_WAIT_V(8); PG8_WAIT_L(0); PG8_BAR; PG8_MMA(1, 0, At, B0); PG8_MMA(1, 1, At, B1); PG8_BAR; PG8_SCHED;
            }
        }
        if constexpr (ALIGN_EPI) { if (wr == 0) PG8_BAR; }
        asm volatile("s_nop 7\n\ts_nop 7\n\ts_nop 7" ::: "memory");
        if constexpr (!Epi::AFTER_DRAIN) { E(acc, cur, wr, wc, fr, fq); S.done(cur); }
        if (!has_next) break;
#pragma unroll
        for (int a = 0; a < 2; ++a)
#pragma unroll
            for (int b = 0; b < 2; ++b)
#pragma unroll
                for (int m = 0; m < 4; ++m)
#pragma unroll
                    for (int n = 0; n < 2; ++n) acc[a][b][m][n] = acc_t{};
        cur = nxt; cB = nB; ++ui; oA0[0] = nA0[0]; oA0[1] = nA0[1]; oA1[0] = nA1[0]; oA1[1] = nA1[1];
        if constexpr (ALIGN_EPI) { if (wr == 1) PG8_BAR; }
    }
    PG8_WAIT_V(0);
    if constexpr (!ALIGN_EPI) { if (wr == 0) PG8_BAR; }
    PG8_BAR;
    if constexpr (Epi::AFTER_DRAIN) { E.fused(acc, cur, wr, wc, fr, fq, lds, wid, lane); S.done(cur); }
#undef PG8_SA
#undef PG8_SB
#undef PG8_STAGE
#undef PG8_LDA
#undef PG8_LDB
#undef PG8_MMA
#undef PG8_WAIT_V
#undef PG8_WAIT_L
#undef PG8_BAR
#undef PG8_SCHED
}
}

#define GAS __attribute__((address_space(1)))
#define LAS __attribute__((address_space(3)))
typedef unsigned short bf16;
typedef unsigned v4u __attribute__((ext_vector_type(4)));
typedef float f32x4 __attribute__((ext_vector_type(4)));
typedef short bf16x8 __attribute__((ext_vector_type(8)));
typedef GAS unsigned gu32;
typedef GAS unsigned long long gu64;
#define RLX_AGENT __ATOMIC_RELAXED, __HIP_MEMORY_SCOPE_AGENT
#define LDS_WAIT() asm volatile("s_waitcnt lgkmcnt(0)" ::: "memory")
#define VM_WAIT() asm volatile("s_waitcnt vmcnt(0)" ::: "memory")
__device__ __forceinline__ unsigned long long rt() { return __builtin_amdgcn_s_memrealtime(); }
__device__ __forceinline__ unsigned f2bf(float f) { unsigned u = __builtin_bit_cast(unsigned, f); return (u + 0x7fffu + ((u >> 16) & 1u)) >> 16; }
typedef float f32x2_t __attribute__((ext_vector_type(2))); typedef __bf16 bf16x2_t __attribute__((ext_vector_type(2)));
__device__ __forceinline__ unsigned pk2(float lo, float hi) { const f32x2_t v = {lo, hi}; const bf16x2_t b = __builtin_convertvector(v, bf16x2_t); return __builtin_bit_cast(unsigned, b); }

#define XB_TMO      128
#define XB_XCNT(j)  (256  + 64 * (j))
#define XB_XSUB(j)  (1280 + 64 * (j))
#define XB_XGEN(j)  (2304 + 64 * (j))
#define XB_TOP      3328
#define XB_TOPGEN   3392
#define XCD_BAR_WORDS 3456
#define XB_SPIN_CAP (1u << 18)

__device__ __forceinline__ unsigned xb_ld(unsigned* p)              { return __hip_atomic_load(p, __ATOMIC_RELAXED, __HIP_MEMORY_SCOPE_AGENT); }
__device__ __forceinline__ unsigned xb_add(unsigned* p, unsigned v) { return __hip_atomic_fetch_add(p, v, __ATOMIC_RELAXED, __HIP_MEMORY_SCOPE_AGENT); }
__device__ __forceinline__ unsigned xb_xcc_id() { return (unsigned)__builtin_amdgcn_s_getreg((3 << 11) | 20) & 0xFu; }
#define XB_SPIN(cond, bar) do { unsigned _sp = 0; while (cond) { __builtin_amdgcn_s_sleep(1); \
    if ((++_sp & 255u) == 0u) { if (xb_ld(&(bar)[XB_TMO])) break; if (_sp > XB_SPIN_CAP) { atomicAdd(&(bar)[XB_TMO], 1u); break; } } } } while (0)

struct XcdBarrier {
    unsigned wv;
    unsigned* bar; unsigned x;
    volatile LAS unsigned* st;
};

__device__ __forceinline__ int lane_now() { int l; asm volatile("v_mbcnt_lo_u32_b32 %0, -1, 0\n\tv_mbcnt_hi_u32_b32 %0, -1, %0" : "=v"(l)); return l; }
__device__ __forceinline__ XcdBarrier xcd_barrier_post(unsigned* bar, volatile LAS unsigned* st, unsigned wv) {
    XcdBarrier b; b.wv = wv; b.bar = bar; b.x = xb_xcc_id(); b.st = st;
    if (wv == 0u && lane_now() == 0) (void)xb_add(&bar[XB_XCNT(b.x)], 1u);
    return b;
}
__device__ __forceinline__ void xcd_barrier_complete(unsigned* bar, unsigned x, unsigned& nloc, unsigned& nx) {
    const unsigned G = gridDim.x * gridDim.y * gridDim.z;
    unsigned sum, cnt, mine, sp = 0u;
    for (;;) {
        sum = 0u; cnt = 0u; mine = 0u;
#pragma unroll
        for (unsigned j = 0; j < 16; ++j) { const unsigned c = xb_ld(&bar[XB_XCNT(j)]); sum += c; cnt += (c > 0u) ? 1u : 0u; mine = (j == x) ? c : mine; }
        if (sum == G) break;
        __builtin_amdgcn_s_sleep(1);
        if ((++sp & 255u) == 0u) { if (xb_ld(&bar[XB_TMO])) break; if (sp > XB_SPIN_CAP) { atomicAdd(&bar[XB_TMO], 1u); break; } }
    }
    nloc = mine > 0u ? mine : 1u; nx = cnt > 0u ? cnt : 1u;
}

__device__ __forceinline__ void xcd_barrier(const XcdBarrier& b) {
    asm volatile("s_waitcnt vmcnt(0)" ::: "memory");
    __syncthreads();
    if (b.wv == 0u && lane_now() == 0) {
        unsigned* bar = b.bar;
        __builtin_amdgcn_s_waitcnt(0);
        unsigned nloc = b.st[0], nx = b.st[1];
        if (nloc == 0u) { xcd_barrier_complete(bar, b.x, nloc, nx); b.st[0] = nloc; b.st[1] = nx; }
        const unsigned old = xb_add(&bar[XB_XSUB(b.x)], 1u);
        const unsigned gen = old / nloc;
        if (old + 1u == (gen + 1u) * nloc) {
            __builtin_amdgcn_fence(__ATOMIC_RELEASE, "agent");
            asm volatile("s_waitcnt vmcnt(0)" ::: "memory");
            const unsigned og = xb_add(&bar[XB_TOP], 1u);
            const unsigned tg = og / nx;
            if (og + 1u == (tg + 1u) * nx) xb_add(&bar[XB_TOPGEN], 1u);
            else XB_SPIN(xb_ld(&bar[XB_TOPGEN]) == tg, bar);
            __builtin_amdgcn_fence(__ATOMIC_ACQUIRE, "agent");
            xb_add(&bar[XB_XGEN(b.x)], 1u);
            asm volatile("s_waitcnt vmcnt(0)" ::: "memory");
        } else {
            XB_SPIN(xb_ld(&bar[XB_XGEN(b.x)]) == gen, bar);
            __builtin_amdgcn_fence(__ATOMIC_ACQUIRE, "agent");
            asm volatile("s_waitcnt vmcnt(0)" ::: "memory");
        }
    }
    __syncthreads();
}


constexpr int NWAVES = 8;
constexpr int NPH = 12;
#ifndef MK_N_LAUNCHES
#define MK_N_LAUNCHES 1
#endif
constexpr int N_LAUNCHES = MK_N_LAUNCHES;

constexpr int BATCH = 4, SEQ = 4096, D = 1024, T = BATCH * SEQ;
constexpr int DN_H = 4, DK = 128, CH = 64, NCH = SEQ / CH;
constexpr int SW_H = 8, SW_KV = 2, HD = 64, WIN = 128, NB = SEQ / WIN;
constexpr int IN_COLS = 2824, NPROJ = 3072, PC_AB = 2816;
constexpr int PC_Z = 1536, PC_SQ = 2048, PC_SK = 2560, PC_SV = 2688;
constexpr int NE = 32, TOPK = 4, DFF = 1024;
constexpr int MAXTILES = 288, NPADMAX = MAXTILES * 256;
constexpr float EPS = 1e-6f;
constexpr int DNP_STRIDE = 36928;

constexpr size_t MiB = 1u << 20;
constexpr size_t WS_CTL = 0, CTL_ZERO_BYTES = 128 * 1024;
constexpr size_t WS_MODP = 18 * MiB;
#ifndef FUSE56
#define FUSE56 1
#endif
#ifndef W_SHARE
#define W_SHARE 768
#endif
constexpr int KSPLIT = 16; static_assert(KSPLIT == 16, "the adaLN GEMV items hold 1024 / KSPLIT = 64 weight rows in registers");
constexpr size_t WS_MODF = 2 * MiB;
constexpr size_t WS_GB = 3 * MiB;
constexpr size_t WS_WIN = 4 * MiB;
constexpr size_t WS_WOUT = 10 * MiB;
constexpr size_t WS_LSLOT = 12 * MiB;
constexpr size_t WS_LGATE = 14 * MiB;
constexpr size_t WS_LHS = 22 * MiB;
constexpr size_t WS_RSLOT = 16 * MiB;
constexpr size_t WS_RGATE = 17 * MiB;
constexpr size_t WS_H = 32 * MiB;
constexpr size_t WS_PROJ = 64 * MiB;
constexpr size_t WS_MIXED = 300 * MiB;
constexpr size_t WS_RSTAT = 297 * MiB;
constexpr size_t WS_ODN = 184 * MiB;
constexpr size_t WS_DNIMG = 216 * MiB;
constexpr size_t WS_DNUT = 280 * MiB;
constexpr size_t WS_DEC = 296 * MiB;
constexpr int IMG_W = 0, IMG_Q = 17408, IMG_K = 34816, IMG_A = 52224, IMG_U = 60928, IMG_UHALF = 8704, IMG_KS = 136;
constexpr int GI_U = 32768, IMG_BYTES = 65536; constexpr float IMG_SC = 16.f;
constexpr int IMG_LDS = IMG_U + IMG_UHALF;
constexpr size_t WS_WUP = 384 * MiB;
constexpr size_t WS_WDN = 512 * MiB;
constexpr size_t WS_XS = 576 * MiB;
constexpr size_t WS_ACT = 720 * MiB;
constexpr size_t WS_SLOT = 864 * MiB;
constexpr size_t WS_END = 992 * MiB;
static_assert(WS_XS + (size_t)NPADMAX * 1024 * 2 <= WS_ACT && WS_ACT + (size_t)NPADMAX * 1024 * 2 <= WS_SLOT, "xs/act");
constexpr int CW_CNT = 8192;
constexpr int CW_BAR = 4096;
constexpr int CW_SWAQ = 12288;
constexpr int CW_MQ = 26624;
constexpr int CW_FLAG = 16384;
constexpr int CW_TS = 128;
static_assert((size_t)(CW_MQ + 64 * 64) * 4 <= CTL_ZERO_BYTES && (size_t)(CW_FLAG + 1024) * 4 <= CTL_ZERO_BYTES && (size_t)(CW_CNT + 64 * 32) * 4 <= CTL_ZERO_BYTES && (size_t)(CW_SWAQ + 64) * 4 <= CTL_ZERO_BYTES, "every control word lies inside the per-call memset");
#ifndef PROBE_A
#define PROBE_A -1
#endif
#ifndef PROBE_B
#define PROBE_B -1
#endif
#ifndef PROBE_SCALE
#define PROBE_SCALE 1.0e-6f
#endif

constexpr int WR_STRIDE = 1032;
constexpr int LDS_BYTES = 147456;
constexpr int CTRL_OFF = LDS_BYTES - 4096;
constexpr int SCRATCH_BYTES = CTRL_OFF;

struct Args { const float* in[21]; float* out; unsigned char* ws; int ph_lo, ph_hi, li, pad; };
struct Frame {
    LAS unsigned char* lds;
    volatile LAS unsigned* MISC;
    gu32* ctl;
    int tid, lane, wave, vcu, G;
    __device__ __forceinline__ void refresh() {
        lane = lane_now(); tid = wave * 64 + lane;
        const __attribute__((address_space(4))) Args* ap = (const __attribute__((address_space(4))) Args*)__builtin_amdgcn_kernarg_segment_ptr();
        asm volatile("" : "+s"(ap));
        x = ap->in[0]; c = ap->in[1]; w_ada = ap->in[2]; b_ada = ap->in[3]; norm1_w = ap->in[4]; w_in = ap->in[5]; conv_w = ap->in[6]; a_log = ap->in[7]; dt_bias = ap->in[8];
        dn_norm_w = ap->in[9]; q_norm_w = ap->in[10]; k_norm_w = ap->in[11]; sinks = ap->in[12]; w_out = ap->in[13]; norm2_w = ap->in[14]; w_router = ap->in[15]; b_router = ap->in[16];
        w_up = ap->in[17]; b_up = ap->in[18]; w_down = ap->in[19]; b_down = ap->in[20]; out = ap->out; ws = ap->ws; ctl = (gu32*)(ap->ws + WS_CTL);
    }
    const float *x, *c, *w_ada, *b_ada, *norm1_w, *w_in, *conv_w, *a_log, *dt_bias, *dn_norm_w, *q_norm_w, *k_norm_w, *sinks, *w_out, *norm2_w, *w_router, *b_router, *w_up, *b_up, *w_down, *b_down;
    float* out; unsigned char* ws;
    __device__ __forceinline__ float* modp() const { return (float*)(ws + WS_MODP); }
    __device__ __forceinline__ float* modf() const { return (float*)(ws + WS_MODF); }
    __device__ __forceinline__ bf16* wrimg() const { return (bf16*)(ws + WS_GB + 600 * 1024); }
    __device__ __forceinline__ bf16* odn() const { return (bf16*)(ws + WS_ODN); }
    __device__ __forceinline__ float* lgate() const { return (float*)(ws + WS_LGATE); }
    __device__ __forceinline__ float* lhs() const { return (float*)(ws + WS_LHS); }
    __device__ __forceinline__ bf16* X1B() const { return (bf16*)(ws + WS_H); }
    __device__ __forceinline__ int* lslot() const { return (int*)(ws + WS_LSLOT); }
    __device__ __forceinline__ unsigned char* dnimg() const { return (unsigned char*)(ws + WS_DNIMG); }
    __device__ __forceinline__ float* rstat() const { return (float*)(ws + WS_RSTAT); }
    __device__ __forceinline__ signed char* Hq() const { return (signed char*)(ws + WS_H); }
    __device__ __forceinline__ signed char* Win8() const { return (signed char*)(ws + WS_WIN); }
    __device__ __forceinline__ float* hscale1() const { return (float*)(ws + WS_GB); }
    __device__ __forceinline__ float* inscale() const { return (float*)(ws + WS_GB + 512 * 1024); }
    __device__ __forceinline__ signed char* H8() const { return (signed char*)(ws + WS_XS); }
    __device__ __forceinline__ signed char* Wup8() const { return (signed char*)(ws + WS_WUP); }
    __device__ __forceinline__ float* upscale() const { return (float*)(ws + WS_RSLOT); }
    __device__ __forceinline__ float* hscale() const { return (float*)(ws + WS_RGATE); }
    __device__ __forceinline__ bf16* Wout_t() const { return (bf16*)(ws + WS_WOUT); }
    __device__ __forceinline__ signed char* Wout8() const { return (signed char*)(ws + WS_WOUT); }
    __device__ __forceinline__ float* outscale() const { return (float*)(ws + WS_GB + 800 * 1024); }
    __device__ __forceinline__ signed char* MIXQ() const { return (signed char*)(ws + WS_SLOT); }
    __device__ __forceinline__ float* mscale() const { return (float*)(ws + WS_SLOT + 32 * MiB); }
    __device__ __forceinline__ bf16* Wdn_t() const { return (bf16*)(ws + WS_WDN); }
    __device__ __forceinline__ bf16* PROJ() const { return (bf16*)(ws + WS_PROJ); }
    __device__ __forceinline__ bf16* MIXED() const { return (bf16*)(ws + WS_MIXED); }
    __device__ __forceinline__ bf16* ACT() const { return (bf16*)(ws + WS_ACT); }
    __device__ __forceinline__ bf16* SLOT() const { return (bf16*)(ws + WS_SLOT); }
};

typedef unsigned v2u __attribute__((ext_vector_type(2)));
__device__ __forceinline__ void st_wt8(void* p, unsigned lo, unsigned hi) { __hip_atomic_store((unsigned long long*)p, ((unsigned long long)hi << 32) | lo, __ATOMIC_RELAXED, __HIP_MEMORY_SCOPE_AGENT); }
__device__ __forceinline__ unsigned fp8x4(float a, float b, float c, float d) { unsigned w = __builtin_amdgcn_cvt_pk_fp8_f32(a, b, 0u, false); return __builtin_amdgcn_cvt_pk_fp8_f32(c, d, w, true); }
__device__ __forceinline__ void st_wt4(void* p, unsigned v) { __hip_atomic_store((unsigned*)p, v, __ATOMIC_RELAXED, __HIP_MEMORY_SCOPE_AGENT); }
__device__ __forceinline__ float bf2f(bf16 v) { return __uint_as_float((unsigned)v << 16); }
__device__ __forceinline__ float bflo(unsigned w) { return __uint_as_float(w << 16); }
__device__ __forceinline__ float bfhi(unsigned w) { return __uint_as_float(w & 0xffff0000u); }
__device__ __forceinline__ float wave_sum(float v) {
#pragma unroll
    for (int o = 1; o < 64; o <<= 1) v += __shfl_xor(v, o);
    return v;
}
__device__ __forceinline__ float siluf(float v) { return v * __builtin_amdgcn_rcpf(1.f + __builtin_amdgcn_exp2f(v * -1.44269504f)); }

struct DenseOrder {
    int nM, nN, nwg, G, c, tid; size_t tstep;
    __device__ void init(int M, int N, int K, int G_, int c_, int tid_) { nM = M / 256; nN = N / 256; nwg = nM * nN; G = G_; c = c_; tid = tid_; tstep = (size_t)256 * K * 2; }
    __device__ bool next(int i, pg8::Unit& u) const {
        const long L = (long)i * G + c; if (L >= nwg) return false;
        int wgid = (int)L; { const int q = nwg / 8, r = nwg % 8, xcd = wgid % 8, off = wgid / 8; wgid = (xcd < r ? xcd * (q + 1) : r * (q + 1) + (xcd - r) * q) + off; }
        const int nig = 8 * nN, gid = wgid / nig, fm = gid * 8, gsz = (nM - fm) < 8 ? (nM - fm) : 8;
        u.pm = fm + ((wgid % nig) % gsz); u.pn = (wgid % nig) / gsz; u.e = 0; return true;
    }
    __device__ __forceinline__ void a_offsets(const pg8::Unit& u, unsigned (&o0)[2], unsigned (&o1)[2]) const {
#pragma unroll
        for (int i = 0; i < 2; ++i) { int R, C; pg8::stage_rc(tid * 16 + i * 8192, R, C); o0[i] = (unsigned)((size_t)u.pm * tstep) + (unsigned)(R * (int)(tstep / 512) + C) * 2u; o1[i] = o0[i] + (unsigned)(tstep / 2); } }
    __device__ __forceinline__ size_t boff(const pg8::Unit& u) const { return (size_t)u.pn * tstep; }
    __device__ __forceinline__ void a_ready(const pg8::Unit&) const {}
    __device__ __forceinline__ void done(const pg8::Unit&) const {}
};
constexpr int PL_CNT = 0, PL_NT = 32, PL_TS = 64, PL_GN = 96, PL_GE = 104;
struct MoeOrder {
    int nN, lcn, lc, grp, rows_per_e, rowbytes; const LAS int* P; const int* lslot; bool gather; int tid;
    const LAS int* UL;
    __device__ __forceinline__ void fill(LAS int* ul) const {
        if (tid < 64) { int uidx = tid * lcn + lc; const int n = P[PL_GN + grp]; int w0 = -1, w1 = 0, w2 = 0;
            for (int k = 0; k < n; ++k) { const int e = P[PL_GE + grp * 16 + k], U = P[PL_NT + e] * nN;
                if (uidx < U) { const int tile = uidx / nN; w0 = e | ((uidx - tile * nN) << 8); w1 = P[PL_TS + e] + tile; w2 = tile * 256; break; }
                uidx -= U; }
            ul[3 * tid] = w0; ul[3 * tid + 1] = w1; ul[3 * tid + 2] = w2; }
        __syncthreads();
    }
    __device__ bool next(int i, pg8::Unit& u) const {
        if (i >= 64) return false;
        const int w0 = UL[3 * i]; if (w0 < 0) return false;
        u.e = __builtin_amdgcn_readfirstlane(w0 & 255); u.pn = __builtin_amdgcn_readfirstlane((w0 >> 8) & 255); u.pm = __builtin_amdgcn_readfirstlane(UL[3 * i + 1]); u.l0 = __builtin_amdgcn_readfirstlane(UL[3 * i + 2]); return true;
    }
    __device__ __forceinline__ void a_offsets(const pg8::Unit& u, unsigned (&o0)[2], unsigned (&o1)[2]) const {
        const int cnt = P[PL_CNT + u.e];
#pragma unroll
        for (int i = 0; i < 2; ++i) { int R, C; pg8::stage_rc(tid * 16 + i * 8192, R, C);
            if (gather) { const int l0 = u.l0 + R, l1 = l0 + 128;
                const int t0 = (l0 < cnt) ? (lslot[u.e * T + l0] >> 2) : 0, t1 = (l1 < cnt) ? (lslot[u.e * T + l1] >> 2) : 0;
                o0[i] = (unsigned)t0 * (unsigned)rowbytes + (unsigned)C * 2u; o1[i] = (unsigned)t1 * (unsigned)rowbytes + (unsigned)C * 2u; }
            else { o0[i] = (unsigned)(u.pm * 256 + R) * (unsigned)rowbytes + (unsigned)C * 2u; o1[i] = o0[i] + 128u * (unsigned)rowbytes; } }
    }
    __device__ __forceinline__ size_t boff(const pg8::Unit& u) const { return ((size_t)u.e * rows_per_e + (size_t)u.pn * 256) * (size_t)rowbytes; }
    __device__ __forceinline__ void a_ready(const pg8::Unit&) const {}
    __device__ __forceinline__ void done(const pg8::Unit&) const {}
};

struct EpiProjI8 {
    typedef pg8::MmaI8 Mma; static constexpr bool PERM = true, AFTER_DRAIN = false;
    bf16* O; const float* hs; const float* ws;
    __device__ __forceinline__ void operator()(const pg8::i32x4 (&acc)[2][2][4][2], const pg8::Unit& u, int wr, int wc, int fr, int fq) const {
        const int row0 = u.pm * 256 + wr * 64 + fr, col0 = u.pn * 256 + wc * 32 + 8 * fq;
        float h[2][4]; f32x4 sc[2][2];
#pragma unroll
        for (int bj = 0; bj < 2; ++bj) { sc[bj][0] = *(const f32x4*)(ws + col0 + bj * 128); sc[bj][1] = *(const f32x4*)(ws + col0 + bj * 128 + 4); }
#pragma unroll
        for (int ai = 0; ai < 2; ++ai)
#pragma unroll
            for (int m = 0; m < 4; ++m) h[ai][m] = hs[row0 + ai * 128 + m * 16];
#pragma unroll
        for (int ai = 0; ai < 2; ++ai)
#pragma unroll
            for (int m = 0; m < 4; ++m) { const int row = row0 + ai * 128 + m * 16; bf16* rowp = O + (size_t)row * NPROJ + col0;
#pragma unroll
                for (int bj = 0; bj < 2; ++bj) {
                    const f32x4 c0 = __builtin_convertvector(acc[ai][bj][m][0], f32x4) * h[ai][m] * sc[bj][0], c1 = __builtin_convertvector(acc[ai][bj][m][1], f32x4) * h[ai][m] * sc[bj][1];
                    v4u w; w.x = pk2(c0[0], c0[1]); w.y = pk2(c0[2], c0[3]); w.z = pk2(c1[0], c1[1]); w.w = pk2(c1[2], c1[3]);
                    *(v4u*)(rowp + bj * 128) = w; } }
    }
};
struct EpiX1 {
    typedef pg8::MmaI8 Mma; static constexpr bool PERM = true, AFTER_DRAIN = false;
    const float* x; bf16* out; const float* modf; float* rstat; const float* hs; const float* ws;
    __device__ __forceinline__ void operator()(const pg8::i32x4 (&acc)[2][2][4][2], const pg8::Unit& u, int wr, int wc, int fr, int fq) const {
        const int row0 = u.pm * 256 + wr * 64 + fr, col0 = u.pn * 256 + wc * 32 + 8 * fq, b = u.pm >> 4;
        f32x4 gv[2][2], av[2][2]; float h[2][4];
#pragma unroll
        for (int ai = 0; ai < 2; ++ai)
#pragma unroll
            for (int m = 0; m < 4; ++m) h[ai][m] = hs[row0 + ai * 128 + m * 16];
#pragma unroll
        for (int bj = 0; bj < 2; ++bj)
#pragma unroll
            for (int n = 0; n < 2; ++n) { gv[bj][n] = *(const f32x4*)(modf + b * 6144 + 2048 + col0 + bj * 128 + n * 4) * *(const f32x4*)(ws + col0 + bj * 128 + n * 4); av[bj][n] = *(const f32x4*)(modf + 32768 + b * 1024 + col0 + bj * 128 + n * 4); }
        f32x4 xv[2][2][2][2];
#define X1_LOAD(buf, sl, r) do { const size_t off_ = (size_t)(row0 + ((r) >> 2) * 128 + ((r) & 3) * 16) * D + col0; \
            _Pragma("unroll") for (int bj = 0; bj < 2; ++bj) _Pragma("unroll") for (int n = 0; n < 2; ++n) xv[buf][sl][bj][n] = *(const f32x4*)(x + off_ + bj * 128 + n * 4); } while (0)
#define X1_ROW(buf, sl, r) do { const int ai = (r) >> 2, m = (r) & 3, row = row0 + ai * 128 + m * 16; const size_t off = (size_t)row * D + col0; float ss = 0.f, ma = 0.f; \
            _Pragma("unroll") for (int bj = 0; bj < 2; ++bj) { v4u w_; \
              _Pragma("unroll") for (int n = 0; n < 2; ++n) { const f32x4 r0_ = xv[buf][sl][bj][n] + gv[bj][n] * (__builtin_convertvector(acc[ai][bj][m][n], f32x4) * h[ai][m]); const unsigned lo_ = pk2(r0_.x, r0_.y), hi_ = pk2(r0_.z, r0_.w); \
                if (n == 0) { w_.x = lo_; w_.y = hi_; } else { w_.z = lo_; w_.w = hi_; } \
                const f32x4 r_ = (f32x4){bflo(lo_), bfhi(lo_), bflo(hi_), bfhi(hi_)}; \
                ss += (r_.x * r_.x + r_.y * r_.y) + (r_.z * r_.z + r_.w * r_.w); const f32x4 q = r_ * av[bj][n]; \
                ma = fmaxf(fmaxf(ma, fmaxf(fabsf(q.x), fabsf(q.y))), fmaxf(fabsf(q.z), fabsf(q.w))); } \
              *(v4u*)(out + off + bj * 128) = w_; } \
            ss += __shfl_xor(ss, 16); ss += __shfl_xor(ss, 32); ma = fmaxf(ma, __shfl_xor(ma, 16)); ma = fmaxf(ma, __shfl_xor(ma, 32)); \
            if (fq == 0) { float* rp = rstat + ((size_t)row * 16 + u.pn * 4 + wc) * 2; rp[0] = ss; rp[1] = ma; } } while (0)
        X1_LOAD(0, 0, 0); X1_LOAD(1, 0, 1);
        X1_ROW(0, 0, 0); X1_LOAD(0, 0, 2); X1_LOAD(0, 1, 3);
        X1_ROW(1, 0, 1); X1_LOAD(1, 0, 4); X1_LOAD(1, 1, 5);
        X1_ROW(0, 0, 2); X1_ROW(0, 1, 3); X1_LOAD(0, 0, 6); X1_LOAD(0, 1, 7);
        X1_ROW(1, 0, 4); X1_ROW(1, 1, 5);
        X1_ROW(0, 0, 6); X1_ROW(0, 1, 7);
#undef X1_ROW
#undef X1_LOAD
    }
};
struct EpiSwiglu {
    typedef pg8::MmaI8 Mma; static constexpr bool PERM = true, AFTER_DRAIN = false;
    unsigned char* act; const float* b_up; const float* wscale; const float* lhs; const LAS int* P;
    __device__ __forceinline__ void operator()(const pg8::i32x4 (&acc)[2][2][4][2], const pg8::Unit& u, int wr, int wc, int fr, int fq) const {
        const int row0 = u.pm * 256 + wr * 64 + fr, colw = u.pn * 128 + wc * 32 + 8 * fq, l00 = u.l0 + wr * 64 + fr, cnt = P[PL_CNT + u.e];
        const float* bg = b_up + (size_t)u.e * 2048 + colw; const float* bl = bg + 1024;
        const float* sg = wscale + (size_t)u.e * 2048 + u.pn * 256 + wc * 32 + 8 * fq; const float* sl = sg + 128;
        float hsv[2][4];
#pragma unroll
        for (int ai = 0; ai < 2; ++ai)
#pragma unroll
            for (int m = 0; m < 4; ++m) hsv[ai][m] = lhs[u.e * T + l00 + ai * 128 + m * 16];
        f32x4 bgv[2], blv[2], sgv[2], slv[2];
#pragma unroll
        for (int n = 0; n < 2; ++n) { bgv[n] = *(const f32x4*)(bg + 4 * n); blv[n] = *(const f32x4*)(bl + 4 * n); sgv[n] = *(const f32x4*)(sg + 4 * n); slv[n] = *(const f32x4*)(sl + 4 * n); }
#pragma unroll
        for (int ai = 0; ai < 2; ++ai)
#pragma unroll
            for (int m = 0; m < 4; ++m) { const int l = l00 + ai * 128 + m * 16; const float hs = (l < cnt) ? hsv[ai][m] : 0.f;
                float r[8];
                const f32x2_t hs2 = (f32x2_t){hs, hs};
#pragma unroll
                for (int n = 0; n < 2; ++n) {
#pragma unroll
                    for (int i = 0; i < 4; i += 2) {
                        const f32x2_t ag = (f32x2_t){(float)acc[ai][0][m][n][i], (float)acc[ai][0][m][n][i + 1]}, al = (f32x2_t){(float)acc[ai][1][m][n][i], (float)acc[ai][1][m][n][i + 1]};
                        const f32x2_t g0 = ag * hs2 * (f32x2_t){sgv[n][i], sgv[n][i + 1]} + (f32x2_t){bgv[n][i], bgv[n][i + 1]}, l0 = al * hs2 * (f32x2_t){slv[n][i], slv[n][i + 1]} + (f32x2_t){blv[n][i], blv[n][i + 1]};
                        const f32x2_t g = (f32x2_t){fminf(g0[0], 7.0f), fminf(g0[1], 7.0f)}, l1 = (f32x2_t){fminf(fmaxf(l0[0], -7.0f), 7.0f), fminf(fmaxf(l0[1], -7.0f), 7.0f)};
                        const f32x2_t ex = g * (f32x2_t){-1.702f * 1.44269504f, -1.702f * 1.44269504f};
                        const f32x2_t den = (f32x2_t){__builtin_amdgcn_exp2f(ex[0]), __builtin_amdgcn_exp2f(ex[1])} + (f32x2_t){1.f, 1.f};
                        const f32x2_t rc = (f32x2_t){__builtin_amdgcn_rcpf(den[0]), __builtin_amdgcn_rcpf(den[1])};
                        const f32x2_t o = g * rc * (l1 + (f32x2_t){1.f, 1.f});
                        r[4 * n + i] = o[0]; r[4 * n + i + 1] = o[1]; } }
                unsigned w0 = __builtin_amdgcn_cvt_pk_fp8_f32(r[0], r[1], 0u, false); w0 = __builtin_amdgcn_cvt_pk_fp8_f32(r[2], r[3], w0, true);
                unsigned w1 = __builtin_amdgcn_cvt_pk_fp8_f32(r[4], r[5], 0u, false); w1 = __builtin_amdgcn_cvt_pk_fp8_f32(r[6], r[7], w1, true);
                *(v2u*)(act + (size_t)(row0 + ai * 128 + m * 16) * DFF + colw) = (v2u){w0, w1}; }
    }
};
struct EpiDown {
    typedef pg8::MmaFp8 Mma; static constexpr bool PERM = true, AFTER_DRAIN = false;
    unsigned char* slot; const int* lslot; const float* lgate; const float* b_down; const LAS int* P;
    __device__ __forceinline__ void operator()(const f32x4 (&acc)[2][2][4][2], const pg8::Unit& u, int wr, int wc, int fr, int fq) const {
        const int l00 = u.l0 + wr * 64 + fr, col0 = u.pn * 256 + wc * 32 + 8 * fq, cnt = P[PL_CNT + u.e];
        const float* bb = b_down + (size_t)u.e * 1024 + col0;
        f32x4 bv[2][2];
#pragma unroll
        for (int bj = 0; bj < 2; ++bj)
#pragma unroll
            for (int n = 0; n < 2; ++n) bv[bj][n] = *(const f32x4*)(bb + bj * 128 + 4 * n);
        int sx[2][4]; float gx[2][4];
#pragma unroll
        for (int ai = 0; ai < 2; ++ai)
#pragma unroll
            for (int m = 0; m < 4; ++m) { const int l = l00 + ai * 128 + m * 16; sx[ai][m] = lslot[u.e * T + l]; gx[ai][m] = lgate[u.e * T + l]; }
#pragma unroll
        for (int ai = 0; ai < 2; ++ai)
#pragma unroll
            for (int m = 0; m < 4; ++m) { const int l = l00 + ai * 128 + m * 16;
                if (l < cnt) { const int sidx = sx[ai][m]; const float gt = gx[ai][m];
#pragma unroll
                    for (int bj = 0; bj < 2; ++bj) { const f32x4 v0 = (acc[ai][bj][m][0] * (1.f / 64.f) + bv[bj][0]) * (gt * 16.f), v1 = (acc[ai][bj][m][1] * (1.f / 64.f) + bv[bj][1]) * (gt * 16.f);
                        unsigned w0 = __builtin_amdgcn_cvt_pk_fp8_f32(v0[0], v0[1], 0u, false); w0 = __builtin_amdgcn_cvt_pk_fp8_f32(v0[2], v0[3], w0, true);
                        unsigned w1 = __builtin_amdgcn_cvt_pk_fp8_f32(v1[0], v1[1], 0u, false); w1 = __builtin_amdgcn_cvt_pk_fp8_f32(v1[2], v1[3], w1, true);
                        *(v2u*)(slot + (size_t)sidx * 1024 + col0 + bj * 128) = (v2u){w0, w1}; } } }
    }
};

__device__ __forceinline__ void p0_transpose_item(const float* W, int ldw, int K, bf16* WT, int src_col0, int dst_row0, int k0, LAS float* scr, int lane) {
#pragma unroll 8
    for (int i = 0; i < 32; ++i) { const int kk = 2 * i + (lane >> 5); scr[kk * 33 + (lane & 31)] = W[(size_t)(k0 + kk) * ldw + src_col0 + (lane & 31)]; }
    LDS_WAIT(); asm volatile("" ::: "memory");
    const int c = lane & 7;
#pragma unroll
    for (int j = 0; j < 4; ++j) { const int n = (lane >> 3) + 8 * j; const LAS float* s = scr + (8 * c) * 33 + n;
        v4u o; o.x = pk2(s[0 * 33], s[1 * 33]); o.y = pk2(s[2 * 33], s[3 * 33]); o.z = pk2(s[4 * 33], s[5 * 33]); o.w = pk2(s[6 * 33], s[7 * 33]);
        *(GAS v4u*)(WT + (size_t)(dst_row0 + n) * K + k0 + 8 * c) = o; }
    LDS_WAIT(); asm volatile("" ::: "memory");
}
__device__ __forceinline__ void p0_prologue(Frame& F) {
    LAS float* scr = (LAS float*)(F.lds + F.wave * 14336);
    const int first = 0, gw = ((int)blockIdx.x - first) * NWAVES + F.wave, NGW = (F.G - first) * NWAVES;
    for (int e = (int)blockIdx.x - first; e < 32; e += F.G - first) {
        bf16* img = F.wrimg();
        for (int k = F.tid; k < 1024; k += NWAVES * 64) { const float w = F.w_router[k * 32 + e]; const unsigned hi = pk2(w, 0.f) & 0xffffu; const float rem = w - __uint_as_float(hi << 16);
            img[e * WR_STRIDE + k] = (bf16)hi; img[(32 + e) * WR_STRIDE + k] = (bf16)(pk2(rem, 0.f) & 0xffffu); } }
    LAS float* SCL = (LAS float*)(F.lds + 8 * 16384 - 16384);
    __syncthreads();
    for (int i = F.tid; i < 4096; i += NWAVES * 64) { const int bb = i >> 10, k = i & 1023; SCL[k * 4 + bb] = siluf(F.c[i]); }
    __syncthreads();
    for (int it = gw; it < 96 * KSPLIT; it += NGW) {
        const int s0 = it % 96, q0 = it / 96, c0 = s0 * 64 + F.lane;
        float w0[64];
#pragma unroll
        for (int k = 0; k < 64; ++k) w0[k] = *(const GAS float*)((const GAS char*)(F.w_ada + (size_t)(q0 * 64 + k) * 6144 + s0 * 64) + (unsigned)(4 * F.lane));
        f32x4 a = (f32x4){0.f, 0.f, 0.f, 0.f};
#pragma unroll
        for (int k = 0; k < 64; ++k) a = a + *(const LAS f32x4*)(SCL + (q0 * 64 + k) * 4) * w0[k];
        float* mp = F.modp() + (size_t)c0 * KSPLIT + q0; mp[0] = a.x; mp[(size_t)6144 * KSPLIT] = a.y; mp[(size_t)2 * 6144 * KSPLIT] = a.z; mp[(size_t)3 * 6144 * KSPLIT] = a.w;
    }
    __syncthreads();
    (void)scr;
}
__device__ __forceinline__ void transpose64_item(const float* W, int ldw, int K, bf16* WT, int src_col0, int dst_row0, int k0, LAS float* scr, int lane) {
    const int r4 = lane >> 4, cg = lane & 15;
    f32x4 v[16];
#pragma unroll
    for (int i = 0; i < 16; ++i) v[i] = *(const GAS f32x4*)(W + (size_t)(k0 + 4 * i + r4) * ldw + src_col0 + 4 * cg);
#pragma unroll
    for (int i = 0; i < 16; ++i) { LAS float* p = scr + (4 * i + r4) * 65 + 4 * cg; p[0] = v[i].x; p[1] = v[i].y; p[2] = v[i].z; p[3] = v[i].w; }
    LDS_WAIT(); asm volatile("" ::: "memory");
    const int c = lane & 7;
#pragma unroll
    for (int j = 0; j < 8; ++j) { const int n = (lane >> 3) + 8 * j; const LAS float* sp = scr + (8 * c) * 65 + n;
        v4u o; o.x = pk2(sp[0 * 65], sp[1 * 65]); o.y = pk2(sp[2 * 65], sp[3 * 65]); o.z = pk2(sp[4 * 65], sp[5 * 65]); o.w = pk2(sp[6 * 65], sp[7 * 65]);
        *(GAS v4u*)(WT + (size_t)(dst_row0 + n) * K + k0 + 8 * c) = o; }
    LDS_WAIT(); asm volatile("" ::: "memory");
}
template <int NC>
__device__ __forceinline__ void quant_strip(Frame& F, const float* W, const int ldw, signed char* out8, float* sout) {
    constexpr int LPR = NC / 4, RPI = 64 / LPR, NI = 64 / RPI;
    const int lane = F.lane, r4 = lane / LPR, cg = lane % LPR;
    LAS float* scr = (LAS float*)(F.lds + F.wave * 16640); LAS float* cmax = (LAS float*)(F.lds + 8 * 16640); LAS float* scl = cmax + 512;
    __syncthreads();
    f32x4 v[2][NI];
#pragma unroll
    for (int tt = 0; tt < 2; ++tt) { const int k0 = 64 * (F.wave + 8 * tt);
#pragma unroll
        for (int i = 0; i < NI; ++i) v[tt][i] = *(const GAS f32x4*)(W + (size_t)(k0 + RPI * i + r4) * ldw + 4 * cg); }
    float m0 = 0.f, m1 = 0.f, m2 = 0.f, m3 = 0.f;
#pragma unroll
    for (int tt = 0; tt < 2; ++tt)
#pragma unroll
        for (int i = 0; i < NI; ++i) { m0 = fmaxf(m0, fabsf(v[tt][i].x)); m1 = fmaxf(m1, fabsf(v[tt][i].y)); m2 = fmaxf(m2, fabsf(v[tt][i].z)); m3 = fmaxf(m3, fabsf(v[tt][i].w)); }
#pragma unroll
    for (int o = LPR; o < 64; o <<= 1) { m0 = fmaxf(m0, __shfl_xor(m0, o)); m1 = fmaxf(m1, __shfl_xor(m1, o)); m2 = fmaxf(m2, __shfl_xor(m2, o)); m3 = fmaxf(m3, __shfl_xor(m3, o)); }
    if (r4 == 0) { LAS float* cm = cmax + F.wave * 64 + 4 * cg; cm[0] = m0; cm[1] = m1; cm[2] = m2; cm[3] = m3; }
    __syncthreads();
    if (F.tid < NC) { float m = 1e-30f;
#pragma unroll
        for (int w = 0; w < 8; ++w) m = fmaxf(m, cmax[w * 64 + F.tid]);
        scl[F.tid] = 127.f / m; sout[F.tid] = m * (1.f / 127.f); }
    __syncthreads();
#pragma unroll
    for (int tt = 0; tt < 2; ++tt) { const int k0 = 64 * (F.wave + 8 * tt);
#pragma unroll
        for (int i = 0; i < NI; ++i) { LAS float* p = scr + (RPI * i + r4) * 65 + 4 * cg; p[0] = v[tt][i].x; p[1] = v[tt][i].y; p[2] = v[tt][i].z; p[3] = v[tt][i].w; }
        LDS_WAIT(); asm volatile("" ::: "memory");
        const int c = lane & 7;
#pragma unroll
        for (int jj = 0; jj < NC / 8; ++jj) { const int n = (lane >> 3) + 8 * jj; const LAS float* sp = scr + (8 * c) * 65 + n; const float q = scl[n];
            const int q0 = (int)rintf(sp[0 * 65] * q), q1 = (int)rintf(sp[1 * 65] * q), q2 = (int)rintf(sp[2 * 65] * q), q3 = (int)rintf(sp[3 * 65] * q), q4 = (int)rintf(sp[4 * 65] * q), q5 = (int)rintf(sp[5 * 65] * q), q6 = (int)rintf(sp[6 * 65] * q), q7 = (int)rintf(sp[7 * 65] * q);
            const unsigned lo = (unsigned)(q0 & 255) | ((unsigned)(q1 & 255) << 8) | ((unsigned)(q2 & 255) << 16) | ((unsigned)(q3 & 255) << 24);
            const unsigned hi = (unsigned)(q4 & 255) | ((unsigned)(q5 & 255) << 8) | ((unsigned)(q6 & 255) << 16) | ((unsigned)(q7 & 255) << 24);
            *(GAS v2u*)(out8 + (size_t)n * 1024 + k0 + 8 * c) = (v2u){lo, hi}; }
        LDS_WAIT(); asm volatile("" ::: "memory"); }
}
__device__ __forceinline__ void quant_up_item(Frame& F, int it) {
    const int e = it >> 5, strip = it & 31, dr = 64 * strip, pn = dr >> 8, bj = (dr >> 7) & 1, j = dr & 127;
    quant_strip<64>(F, F.w_up + (size_t)e * 1024 * 2048 + bj * 1024 + pn * 128 + j, 2048, F.Wup8() + ((size_t)e * 2048 + dr) * 1024, F.upscale() + (size_t)e * 2048 + dr);
}
__device__ __forceinline__ void quant_up_pipe(Frame& F, int it0, int step, int hi) {
    const int lane = F.lane, r4 = lane >> 4, cg = lane & 15; const unsigned voff = (unsigned)(r4 * 8192 + 16 * cg);
    LAS float* scr = (LAS float*)(F.lds + F.wave * 16640); LAS float* cmax = (LAS float*)(F.lds + 8 * 16640); LAS float* scl = cmax + 512;
    int it = it0;
    if (it >= hi) return;
    __syncthreads();
    f32x4 v[2][16];
    const float* W; { const int e = it >> 5, dr = 64 * (it & 31); W = F.w_up + (size_t)e * 1024 * 2048 + ((dr >> 7) & 1) * 1024 + (dr >> 8) * 128 + (dr & 127); }
#pragma unroll
    for (int tt = 0; tt < 2; ++tt) { const int k0 = 64 * (F.wave + 8 * tt);
#pragma unroll
        for (int i = 0; i < 16; ++i) v[tt][i] = *(const GAS f32x4*)((const GAS char*)(W + (size_t)(k0 + 4 * i) * 2048) + voff); }
    for (;;) {
        const int e = it >> 5, dr = 64 * (it & 31), nit = it + step; const bool more = nit < hi;
        signed char* out8 = F.Wup8() + ((size_t)e * 2048 + dr) * 1024; float* sout = F.upscale() + (size_t)e * 2048 + dr;
        { const int en = nit >> 5, drn = 64 * (nit & 31); W = F.w_up + (size_t)en * 1024 * 2048 + ((drn >> 7) & 1) * 1024 + (drn >> 8) * 128 + (drn & 127); }
        float m0 = 0.f, m1 = 0.f, m2 = 0.f, m3 = 0.f;
#pragma unroll
        for (int tt = 0; tt < 2; ++tt)
#pragma unroll
            for (int i = 0; i < 16; ++i) { m0 = fmaxf(m0, fabsf(v[tt][i].x)); m1 = fmaxf(m1, fabsf(v[tt][i].y)); m2 = fmaxf(m2, fabsf(v[tt][i].z)); m3 = fmaxf(m3, fabsf(v[tt][i].w)); }
        m0 = fmaxf(m0, __shfl_xor(m0, 16)); m0 = fmaxf(m0, __shfl_xor(m0, 32)); m1 = fmaxf(m1, __shfl_xor(m1, 16)); m1 = fmaxf(m1, __shfl_xor(m1, 32));
        m2 = fmaxf(m2, __shfl_xor(m2, 16)); m2 = fmaxf(m2, __shfl_xor(m2, 32)); m3 = fmaxf(m3, __shfl_xor(m3, 16)); m3 = fmaxf(m3, __shfl_xor(m3, 32));
        if (r4 == 0) { LAS float* cm = cmax + F.wave * 64 + 4 * cg; cm[0] = m0; cm[1] = m1; cm[2] = m2; cm[3] = m3; }
        __syncthreads();
        if (F.tid < 64) { float m = 1e-30f;
#pragma unroll
            for (int w = 0; w < 8; ++w) m = fmaxf(m, cmax[w * 64 + F.tid]);
            scl[F.tid] = 127.f / m; sout[F.tid] = m * (1.f / 127.f); }
        __syncthreads();
#pragma unroll
        for (int tt = 0; tt < 2; ++tt) { const int k0 = 64 * (F.wave + 8 * tt);
#pragma unroll
            for (int i = 0; i < 16; ++i) { LAS float* p = scr + (4 * i + r4) * 65 + 4 * cg; p[0] = v[tt][i].x; p[1] = v[tt][i].y; p[2] = v[tt][i].z; p[3] = v[tt][i].w; }
            LDS_WAIT(); asm volatile("" ::: "memory");
            if (more) {
#pragma unroll
                for (int i = 0; i < 16; ++i) v[tt][i] = *(const GAS f32x4*)((const GAS char*)(W + (size_t)(k0 + 4 * i) * 2048) + voff); }
            const int c = lane & 7;
#pragma unroll
            for (int jj = 0; jj < 8; ++jj) { const int n = (lane >> 3) + 8 * jj; const LAS float* sp = scr + (8 * c) * 65 + n; const float q = scl[n];
                const int q0 = (int)rintf(sp[0 * 65] * q), q1 = (int)rintf(sp[1 * 65] * q), q2 = (int)rintf(sp[2 * 65] * q), q3 = (int)rintf(sp[3 * 65] * q), q4 = (int)rintf(sp[4 * 65] * q), q5 = (int)rintf(sp[5 * 65] * q), q6 = (int)rintf(sp[6 * 65] * q), q7 = (int)rintf(sp[7 * 65] * q);
                const unsigned lo = (unsigned)(q0 & 255) | ((unsigned)(q1 & 255) << 8) | ((unsigned)(q2 & 255) << 16) | ((unsigned)(q3 & 255) << 24);
                const unsigned hi = (unsigned)(q4 & 255) | ((unsigned)(q5 & 255) << 8) | ((unsigned)(q6 & 255) << 16) | ((unsigned)(q7 & 255) << 24);
                *(GAS v2u*)(out8 + (size_t)n * 1024 + k0 + 8 * c) = (v2u){lo, hi}; }
            LDS_WAIT(); asm volatile("" ::: "memory"); }
        if (!more) break;
        it = nit;
    }
}
__device__ __forceinline__ void quant_in_item(Frame& F, int strip) {
    const int dr = 64 * strip, sc = dr < 2048 ? dr : (dr < 2816 ? dr + 8 : dr - 2816 + 2048);
    quant_strip<64>(F, F.w_in + sc, IN_COLS, F.Win8() + (size_t)dr * 1024, F.inscale() + dr);
}
__device__ __forceinline__ void transpose64_fp8_item(const float* W, int ldw, unsigned char* WT, int src_col0, int dst_row0, int k0, LAS float* scr, int lane) {
    const int r4 = lane >> 4, cg = lane & 15;
    f32x4 v[16];
#pragma unroll
    for (int i = 0; i < 16; ++i) v[i] = *(const GAS f32x4*)(W + (size_t)(k0 + 4 * i + r4) * ldw + src_col0 + 4 * cg);
#pragma unroll
    for (int i = 0; i < 16; ++i) { LAS float* p = scr + (4 * i + r4) * 65 + 4 * cg; p[0] = v[i].x * 64.f; p[1] = v[i].y * 64.f; p[2] = v[i].z * 64.f; p[3] = v[i].w * 64.f; }
    LDS_WAIT(); asm volatile("" ::: "memory");
    const int c = lane & 7;
#pragma unroll
    for (int j = 0; j < 8; ++j) { const int n = (lane >> 3) + 8 * j; const LAS float* sp = scr + (8 * c) * 65 + n;
        unsigned w0 = __builtin_amdgcn_cvt_pk_fp8_f32(sp[0 * 65], sp[1 * 65], 0u, false); w0 = __builtin_amdgcn_cvt_pk_fp8_f32(sp[2 * 65], sp[3 * 65], w0, true);
        unsigned w1 = __builtin_amdgcn_cvt_pk_fp8_f32(sp[4 * 65], sp[5 * 65], 0u, false); w1 = __builtin_amdgcn_cvt_pk_fp8_f32(sp[6 * 65], sp[7 * 65], w1, true);
        *(GAS v2u*)(WT + (size_t)(dst_row0 + n) * 1024 + k0 + 8 * c) = (v2u){w0, w1}; }
    LDS_WAIT(); asm volatile("" ::: "memory");
}
__device__ __forceinline__ void expert_transposes(Frame& F, int rank, int nblk, int uplo, int uphi, int dnlo, int dnhi) {
    quant_up_pipe(F, uplo + rank, nblk, uphi);
    __syncthreads();
    LAS float* scr = (LAS float*)(F.lds + F.wave * 16640);
    const int gw = dnlo + rank * NWAVES + F.wave, NGW = nblk * NWAVES;
    { const int lane = F.lane, r4 = lane >> 4, cg = lane & 15, c = lane & 7; const unsigned voff = (unsigned)(r4 * 4096 + 16 * cg);
      int r = gw;
      if (r < dnhi) {
        f32x4 v[16];
        { const int e = r >> 8, rr = r & 255, kb = rr >> 4, nb = rr & 15; const float* W = F.w_down + (size_t)e * 1024 * 1024 + (size_t)(64 * kb) * 1024 + 64 * nb;
#pragma unroll
          for (int i = 0; i < 16; ++i) v[i] = *(const GAS f32x4*)((const GAS char*)(W + (size_t)(4 * i) * 1024) + voff); }
        for (;;) {
            const int e = r >> 8, rr = r & 255, kb = rr >> 4, nb = rr & 15, rn = r + NGW; const bool more = rn < dnhi;
            unsigned char* WT = (unsigned char*)F.Wdn_t() + (size_t)e * 1024 * 1024 + (size_t)(64 * nb) * 1024 + 64 * kb;
#pragma unroll
            for (int i = 0; i < 16; ++i) { LAS float* p = scr + (4 * i + r4) * 65 + 4 * cg; p[0] = v[i].x * 64.f; p[1] = v[i].y * 64.f; p[2] = v[i].z * 64.f; p[3] = v[i].w * 64.f; }
            LDS_WAIT(); asm volatile("" ::: "memory");
            if (more) { const int en = rn >> 8, rrn = rn & 255, kbn = rrn >> 4, nbn = rrn & 15; const float* W = F.w_down + (size_t)en * 1024 * 1024 + (size_t)(64 * kbn) * 1024 + 64 * nbn;
#pragma unroll
                for (int i = 0; i < 16; ++i) v[i] = *(const GAS f32x4*)((const GAS char*)(W + (size_t)(4 * i) * 1024) + voff); }
#pragma unroll
            for (int j = 0; j < 8; ++j) { const int n = (lane >> 3) + 8 * j; const LAS float* sp = scr + (8 * c) * 65 + n;
                unsigned w0 = __builtin_amdgcn_cvt_pk_fp8_f32(sp[0 * 65], sp[1 * 65], 0u, false); w0 = __builtin_amdgcn_cvt_pk_fp8_f32(sp[2 * 65], sp[3 * 65], w0, true);
                unsigned w1 = __builtin_amdgcn_cvt_pk_fp8_f32(sp[4 * 65], sp[5 * 65], 0u, false); w1 = __builtin_amdgcn_cvt_pk_fp8_f32(sp[6 * 65], sp[7 * 65], w1, true);
                *(GAS v2u*)(WT + (size_t)n * 1024 + 8 * c) = (v2u){w0, w1}; }
            LDS_WAIT(); asm volatile("" ::: "memory");
            if (!more) break;
            r = rn;
        } } }
}

__device__ __forceinline__ float mod_sum(Frame& F, int b, int col) {
    const f32x4* p = (const f32x4*)(F.modp() + ((size_t)b * 6144 + col) * KSPLIT); f32x4 a = p[0];
#pragma unroll
    for (int i = 1; i < KSPLIT / 4; ++i) a = a + p[i];
    return F.b_ada[col] + ((a.x + a.y) + (a.z + a.w));
}
__device__ __forceinline__ void mod_tables(Frame& F, LAS float* A, LAS float* Bv, const float* norm_w, int b, int sh_col) {
    for (int k = F.tid; k < 1024; k += NWAVES * 64) { A[k] = norm_w[k] * (1.f + mod_sum(F, b, sh_col + 1024 + k)); Bv[k] = mod_sum(F, b, sh_col + k); }
}
__device__ __forceinline__ void p1_hrows(Frame& F) {
    LAS float* A1 = (LAS float*)F.lds; LAS float* B1 = A1 + 1024;
    f32x4 tm[2][2][KSPLIT / 4]; f32x4 xv[8][4];
    if ((int)blockIdx.x < 256) { const int b0 = (int)blockIdx.x >> 6;
#pragma unroll
        for (int kk = 0; kk < 2; ++kk) { const int k = F.tid + kk * NWAVES * 64;
#pragma unroll
            for (int ab = 0; ab < 2; ++ab) { const f32x4* pp = (const f32x4*)(F.modp() + ((size_t)b0 * 6144 + (ab == 0 ? 1024 + k : k)) * KSPLIT);
#pragma unroll
                for (int i = 0; i < KSPLIT / 4; ++i) tm[kk][ab][i] = pp[i]; } }
#pragma unroll
        for (int i = 0; i < 8; ++i) { const GAS f32x4* xr = (const GAS f32x4*)(F.x + (size_t)((int)blockIdx.x * 64 + F.wave + 8 * i) * D) + F.lane;
#pragma unroll
            for (int j = 0; j < 4; ++j) xv[i][j] = xr[64 * j]; } }
    for (int blk = blockIdx.x; blk < 256; blk += F.G) {
        if (F.tid < 96) { const int idx = blk * 96 + F.tid; F.modf()[idx] = mod_sum(F, idx / 6144, idx % 6144); }
        else if (F.tid < 128) { const int idx = blk * 32 + F.tid - 96, b2 = idx >> 11, k = idx & 1023;
            if (((idx >> 10) & 1) == 0) F.modf()[32768 + b2 * 1024 + k] = F.norm2_w[k] * (1.f + mod_sum(F, b2, 4096 + k)); else F.modf()[32768 + 4096 + b2 * 1024 + k] = mod_sum(F, b2, 3072 + k); } }
    for (int rg = blockIdx.x; rg < 256; rg += F.G) {
        const int b = rg >> 6;
        __syncthreads();
        if (rg == (int)blockIdx.x) {
#pragma unroll
            for (int kk = 0; kk < 2; ++kk) { const int k = F.tid + kk * NWAVES * 64; float sm[2];
#pragma unroll
                for (int ab = 0; ab < 2; ++ab) { f32x4 a = tm[kk][ab][0];
#pragma unroll
                    for (int i = 1; i < KSPLIT / 4; ++i) a = a + tm[kk][ab][i];
                    sm[ab] = F.b_ada[ab == 0 ? 1024 + k : k] + ((a.x + a.y) + (a.z + a.w)); }
                A1[k] = F.norm1_w[k] * (1.f + sm[0]); B1[k] = sm[1]; }
        } else mod_tables(F, A1, B1, F.norm1_w, b, 0);
        __syncthreads();
        if (rg != (int)blockIdx.x) {
#pragma unroll
            for (int i = 0; i < 8; ++i) { const GAS f32x4* xr = (const GAS f32x4*)(F.x + (size_t)(rg * 64 + F.wave + 8 * i) * D) + F.lane;
#pragma unroll
                for (int j = 0; j < 4; ++j) xv[i][j] = xr[64 * j]; } }
#pragma unroll
        for (int ri = 0; ri < 8; ++ri) { const int rr = F.wave + 8 * ri;
            const int t = rg * 64 + rr;
            f32x4 v[4];
#pragma unroll
            for (int j = 0; j < 4; ++j) v[j] = xv[ri][j];
            float ss = 0.f;
#pragma unroll
            for (int j = 0; j < 4; ++j) ss += (v[j].x * v[j].x + v[j].y * v[j].y) + (v[j].z * v[j].z + v[j].w * v[j].w);
            const float rstd = rsqrtf(wave_sum(ss) * (1.f / D) + EPS);
            f32x4 hv[4]; float am = 0.f;
#pragma unroll
            for (int j = 0; j < 4; ++j) { const int k = 4 * F.lane + 256 * j;
                const f32x4 a = *(const LAS f32x4*)(A1 + k), bb = *(const LAS f32x4*)(B1 + k);
                hv[j] = v[j] * rstd * a + bb; am = fmaxf(fmaxf(am, fmaxf(fabsf(hv[j].x), fabsf(hv[j].y))), fmaxf(fabsf(hv[j].z), fabsf(hv[j].w))); }
#pragma unroll
            for (int o = 1; o < 64; o <<= 1) am = fmaxf(am, __shfl_xor(am, o));
            am = fmaxf(am, 1e-30f); const float qs = 127.f / am; if (F.lane == 0) F.hscale1()[t] = am * (1.f / 127.f);
            GAS unsigned* o4 = (GAS unsigned*)(F.Hq() + (size_t)t * D) + F.lane;
#pragma unroll
            for (int j = 0; j < 4; ++j) { const int q0 = (int)rintf(hv[j].x * qs), q1 = (int)rintf(hv[j].y * qs), q2 = (int)rintf(hv[j].z * qs), q3 = (int)rintf(hv[j].w * qs);
                o4[64 * j] = (unsigned)(q0 & 255) | ((unsigned)(q1 & 255) << 8) | ((unsigned)(q2 & 255) << 16) | ((unsigned)(q3 & 255) << 24); }
        }
    }
}

__device__ __forceinline__ bf16x8 lda_frag(const LAS unsigned char* p) {
    const v2u lo = *(const LAS v2u*)p, hi = *(const LAS v2u*)(p + 32);
    const v4u w = (v4u){lo.x, lo.y, hi.x, hi.y}; return __builtin_bit_cast(bf16x8, w);
}
__device__ __forceinline__ bf16x8 pack_frag(const f32x4 a, const f32x4 b) { const v4u w = (v4u){pk2(a.x, a.y), pk2(a.z, a.w), pk2(b.x, b.y), pk2(b.z, b.w)}; return __builtin_bit_cast(bf16x8, w); }
constexpr int PQ_OFF = 0, PK_OFF = 17408, PKT_OFF = 34816, PVT_OFF = 53248, PAF_OFF = 71680, PTF_OFF = 88320, PTU_OFF = 104960, PTW_OFF = 114176, PMF_OFF = 123392, PSC_OFF = 129536;
__device__ __forceinline__ void dn_prep_item(Frame& F, int item, bool loadcw) {
    const int b = item >> 8, n = (item >> 2) & 63, h = item & 3, t0 = b * SEQ + n * CH, tid = F.tid, lane = F.lane, r16 = lane & 15, q4 = lane >> 4, wv = F.wave;
    LAS unsigned char* L = F.lds;
    LAS bf16* Qr = (LAS bf16*)(L + PQ_OFF); LAS bf16* Kr = (LAS bf16*)(L + PK_OFF); LAS bf16* Kt = (LAS bf16*)(L + PKT_OFF); LAS bf16* Vt = (LAS bf16*)(L + PVT_OFF);
    LAS float* Af = (LAS float*)(L + PAF_OFF); LAS float* Tf = (LAS float*)(L + PTF_OFF); LAS bf16* Tu = (LAS bf16*)(L + PTU_OFF); LAS bf16* Tw = (LAS bf16*)(L + PTW_OFF);
    LAS float* Mf = (LAS float*)(L + PMF_OFF); LAS float* gc = (LAS float*)(L + PSC_OFF); LAS float* bt = gc + 64; LAS float* eg = bt + 64; LAS float* e2 = eg + 64;
    unsigned char* img = F.dnimg() + (size_t)item * IMG_BYTES;
    __syncthreads();
    const int g16 = tid >> 4, l16 = tid & 15, cp = g16 >> 3, r8 = 8 * (g16 & 7), chan0 = cp * 512 + h * 128 + 8 * l16;
    v4u cin[11];
    if (g16 < 24) {
#pragma unroll
        for (int jj = 0; jj < 11; ++jj) { const int pos = n * CH + r8 - 3 + jj; cin[jj] = (v4u){0u, 0u, 0u, 0u}; if (pos >= 0) cin[jj] = *(const v4u*)(F.PROJ() + (size_t)(b * SEQ + pos) * NPROJ + chan0); }
    }
    LAS float* CWL = (LAS float*)(L + PSC_OFF + 1024);
    if (loadcw && tid < 384) { const int cpw = tid >> 7, rem = tid & 127, lw = rem >> 3, jw = (rem >> 1) & 3, hw = rem & 1;
        *(LAS f32x4*)(CWL + (cpw * 16 + lw) * 32 + jw * 8 + 4 * hw) = *(const f32x4*)(F.conv_w + jw * 1536 + cpw * 512 + h * 128 + 8 * lw + 4 * hw); }
    if (wv == 0) { const bf16* pab = F.PROJ() + (size_t)(t0 + lane) * NPROJ + PC_AB + h; const float za = bf2f(pab[0]) + F.dt_bias[h], zb = bf2f(pab[4]);
        float g = -__expf(F.a_log[h]) * (fmaxf(za, 0.f) + log1pf(__expf(-fabsf(za))));
#pragma unroll
        for (int o = 1; o < 64; o <<= 1) { const float tt = __shfl_up(g, o); if (lane >= o) g += tt; }
        const float gl = __shfl(g, 63);
        gc[lane] = g; bt[lane] = 1.f / (1.f + __expf(-zb)); eg[lane] = __expf(g); e2[lane] = __expf(gl - g);
        if (lane == 63) { const float dcy = __expf(gl); st_wt4(img + GI_U + 128, __float_as_uint(dcy)); st_wt4(img + GI_U + IMG_UHALF + 128, __float_as_uint(dcy)); } }
    for (int i = tid; i < 64 * 65; i += NWAVES * 64) Tf[i] = 0.f;
    __syncthreads();
    if (g16 < 24) {
#pragma unroll
      for (int rp = 0; rp < 4; ++rp) { const int r0 = r8 + 2 * rp;
        float xin[5][8];
#pragma unroll
        for (int jj = 0; jj < 5; ++jj) { const v4u w = cin[2 * rp + jj];
            xin[jj][0] = bflo(w.x); xin[jj][1] = bfhi(w.x); xin[jj][2] = bflo(w.y); xin[jj][3] = bfhi(w.y); xin[jj][4] = bflo(w.z); xin[jj][5] = bfhi(w.z); xin[jj][6] = bflo(w.w); xin[jj][7] = bfhi(w.w); }
        float y0[8], y1[8];
        { f32x2_t p0[4], p1[4];
#pragma unroll
          for (int i = 0; i < 4; ++i) { p0[i] = (f32x2_t){0.f, 0.f}; p1[i] = (f32x2_t){0.f, 0.f}; }
#pragma unroll
          for (int j = 0; j < 4; ++j) { const f32x4 ca = *(const LAS f32x4*)(CWL + (cp * 16 + l16) * 32 + j * 8), cb = *(const LAS f32x4*)(CWL + (cp * 16 + l16) * 32 + j * 8 + 4);
              const f32x2_t cw[4] = {(f32x2_t){ca.x, ca.y}, (f32x2_t){ca.z, ca.w}, (f32x2_t){cb.x, cb.y}, (f32x2_t){cb.z, cb.w}};
#pragma unroll
              for (int i = 0; i < 4; ++i) { p0[i] = p0[i] + cw[i] * (f32x2_t){xin[j][2 * i], xin[j][2 * i + 1]}; p1[i] = p1[i] + cw[i] * (f32x2_t){xin[j + 1][2 * i], xin[j + 1][2 * i + 1]}; } }
#pragma unroll
          for (int i = 0; i < 4; ++i) { y0[2 * i] = p0[i][0]; y0[2 * i + 1] = p0[i][1]; y1[2 * i] = p1[i][0]; y1[2 * i + 1] = p1[i][1]; } }
        float s0 = 0.f, s1 = 0.f;
#pragma unroll
        for (int i = 0; i < 8; ++i) { y0[i] = siluf(y0[i]); y1[i] = siluf(y1[i]); s0 += y0[i] * y0[i]; s1 += y1[i] * y1[i]; }
        if (cp < 2) {
            s0 += __shfl_xor(s0, 1); s0 += __shfl_xor(s0, 2); s0 += __shfl_xor(s0, 4); s0 += __shfl_xor(s0, 8);
            s1 += __shfl_xor(s1, 1); s1 += __shfl_xor(s1, 2); s1 += __shfl_xor(s1, 4); s1 += __shfl_xor(s1, 8);
            const float f = (cp == 0) ? 0.08838834764831845f : 1.f, n0 = rsqrtf(s0 + EPS) * f, n1 = rsqrtf(s1 + EPS) * f;
#pragma unroll
            for (int i = 0; i < 8; ++i) { y0[i] *= n0; y1[i] *= n1; }
        }
        const v4u w0 = (v4u){pk2(y0[0], y0[1]), pk2(y0[2], y0[3]), pk2(y0[4], y0[5]), pk2(y0[6], y0[7])}, w1 = (v4u){pk2(y1[0], y1[1]), pk2(y1[2], y1[3]), pk2(y1[4], y1[5]), pk2(y1[6], y1[7])};
        if (cp == 0) { *(LAS v4u*)(Qr + r0 * 136 + 8 * l16) = w0; *(LAS v4u*)(Qr + (r0 + 1) * 136 + 8 * l16) = w1;
            const float g0 = eg[r0] * IMG_SC, g1 = eg[r0 + 1] * IMG_SC;
            unsigned char* q0p = img + IMG_Q / 2 + r0 * 136 + 8 * l16; unsigned char* q1p = q0p + 136;
            st_wt8(q0p, fp8x4(y0[0] * g0, y0[1] * g0, y0[2] * g0, y0[3] * g0), fp8x4(y0[4] * g0, y0[5] * g0, y0[6] * g0, y0[7] * g0));
            st_wt8(q1p, fp8x4(y1[0] * g1, y1[1] * g1, y1[2] * g1, y1[3] * g1), fp8x4(y1[4] * g1, y1[5] * g1, y1[6] * g1, y1[7] * g1)); }
        else if (cp == 1) { *(LAS v4u*)(Kr + r0 * 136 + 8 * l16) = w0; *(LAS v4u*)(Kr + (r0 + 1) * 136 + 8 * l16) = w1;
#pragma unroll
            for (int i = 0; i < 8; ++i) *(LAS unsigned*)(Kt + (8 * l16 + i) * 72 + r0) = pk2(y0[i], y1[i]); }
        else {
#pragma unroll
            for (int i = 0; i < 8; ++i) *(LAS unsigned*)(Vt + (8 * l16 + i) * 72 + r0) = pk2(y0[i], y1[i]); }
        __builtin_amdgcn_sched_barrier(0);
      } }
    __syncthreads();
    { const int dk = tid >> 2, cc = (tid & 3) * 16;
      const v4u ka = *(const LAS v4u*)(Kt + dk * 72 + cc), kb = *(const LAS v4u*)(Kt + dk * 72 + cc + 8);
      const unsigned kw[8] = {ka.x, ka.y, ka.z, ka.w, kb.x, kb.y, kb.z, kb.w};
      float kf[16];
#pragma unroll
      for (int i = 0; i < 8; ++i) { kf[2 * i] = bflo(kw[i]) * e2[cc + 2 * i] * IMG_SC; kf[2 * i + 1] = bfhi(kw[i]) * e2[cc + 2 * i + 1] * IMG_SC; }
      unsigned char* kp = img + IMG_K / 2 + dk * (IMG_KS / 2) + cc;
#pragma unroll
      for (int i = 0; i < 4; ++i) st_wt4(kp + 4 * i, fp8x4(kf[4 * i], kf[4 * i + 1], kf[4 * i + 2], kf[4 * i + 3])); }
    { const int mt = wv >> 1;
      bf16x8 ak[4];
#pragma unroll
      for (int ks = 0; ks < 4; ++ks) ak[ks] = *(const LAS bf16x8*)(Kr + (16 * mt + r16) * 136 + 32 * ks + 8 * q4);
#pragma unroll
      for (int u = 0; u < 2; ++u) { const int nt = 2 * (wv & 1) + u;
        f32x4 akk = (f32x4){0.f, 0.f, 0.f, 0.f}, aqk = (f32x4){0.f, 0.f, 0.f, 0.f};
#pragma unroll
        for (int ks = 0; ks < 4; ++ks) { const bf16x8 bk = *(const LAS bf16x8*)(Kr + (16 * nt + r16) * 136 + 32 * ks + 8 * q4), bq = *(const LAS bf16x8*)(Qr + (16 * nt + r16) * 136 + 32 * ks + 8 * q4);
            akk = __builtin_amdgcn_mfma_f32_16x16x32_bf16(ak[ks], bk, akk, 0, 0, 0); aqk = __builtin_amdgcn_mfma_f32_16x16x32_bf16(ak[ks], bq, aqk, 0, 0, 0); }
        const int col = 16 * nt + r16; const float gcol = gc[col]; float o[4];
#pragma unroll
        for (int i = 0; i < 4; ++i) { const int row = 16 * mt + 4 * q4 + i; const float grow = gc[row];
            Af[row * 65 + col] = (col < row) ? bt[row] * akk[i] * __expf(grow - gcol) : 0.f;
            o[i] = (row <= col) ? aqk[i] * __expf(gcol - grow) : 0.f; }
        st_wt4(img + IMG_A / 2 + col * (IMG_KS / 2) + 16 * mt + 4 * q4, fp8x4(o[0] * IMG_SC, o[1] * IMG_SC, o[2] * IMG_SC, o[3] * IMG_SC)); } }
    __syncthreads();
    if (tid < 64) { const int blk = tid >> 4, c = tid & 15; float x[16];
#pragma unroll
        for (int i = 0; i < 16; ++i) { float r = (i == c) ? 1.f : 0.f;
#pragma unroll
            for (int j = 0; j < i; ++j) r -= Af[(16 * blk + i) * 65 + 16 * blk + j] * x[j];
            x[i] = r; }
#pragma unroll
        for (int i = 0; i < 16; ++i) Tf[(16 * blk + i) * 65 + 16 * blk + c] = x[i]; }
    __syncthreads();
    if (wv < 2) { const int lo = 32 * wv; f32x4 m = (f32x4){0.f, 0.f, 0.f, 0.f};
#pragma unroll
      for (int ks = 0; ks < 4; ++ks) m = __builtin_amdgcn_mfma_f32_16x16x4f32(Af[(lo + 16 + r16) * 65 + lo + 4 * ks + q4], Tf[(lo + 4 * ks + q4) * 65 + lo + r16], m, 0, 0, 0);
#pragma unroll
      for (int i = 0; i < 4; ++i) Mf[wv * 272 + (4 * q4 + i) * 17 + r16] = m[i];
      LDS_WAIT(); asm volatile("" ::: "memory");
      f32x4 x = (f32x4){0.f, 0.f, 0.f, 0.f};
#pragma unroll
      for (int ks = 0; ks < 4; ++ks) x = __builtin_amdgcn_mfma_f32_16x16x4f32(Tf[(lo + 16 + r16) * 65 + lo + 16 + 4 * ks + q4], Mf[wv * 272 + (4 * ks + q4) * 17 + r16], x, 0, 0, 0);
#pragma unroll
      for (int i = 0; i < 4; ++i) Tf[(lo + 16 + 4 * q4 + i) * 65 + lo + r16] = -x[i]; }
    __syncthreads();
    { const int ti = (wv >> 1) & 1, tj = wv & 1; f32x4 m = (f32x4){0.f, 0.f, 0.f, 0.f};
      if (wv < 4) {
#pragma unroll
        for (int ks = 0; ks < 8; ++ks) m = __builtin_amdgcn_mfma_f32_16x16x4f32(Af[(32 + 16 * ti + r16) * 65 + 4 * ks + q4], Tf[(4 * ks + q4) * 65 + 16 * tj + r16], m, 0, 0, 0);
#pragma unroll
        for (int i = 0; i < 4; ++i) Mf[544 + (16 * ti + 4 * q4 + i) * 33 + 16 * tj + r16] = m[i]; }
      __syncthreads();
      if (wv < 4) { f32x4 x = (f32x4){0.f, 0.f, 0.f, 0.f};
#pragma unroll
        for (int ks = 0; ks < 8; ++ks) x = __builtin_amdgcn_mfma_f32_16x16x4f32(Tf[(32 + 16 * ti + r16) * 65 + 32 + 4 * ks + q4], Mf[544 + (4 * ks + q4) * 33 + 16 * tj + r16], x, 0, 0, 0);
#pragma unroll
        for (int i = 0; i < 4; ++i) Tf[(32 + 16 * ti + 4 * q4 + i) * 65 + 16 * tj + r16] = -x[i]; } }
    __syncthreads();
    for (int idx = tid; idx < 4096; idx += NWAVES * 64) { const int i = idx >> 6, c = idx & 63; const float tv = Tf[i * 65 + c] * bt[c];
        Tu[i * 72 + c] = (bf16)f2bf(tv); Tw[i * 72 + c] = (bf16)f2bf(tv * eg[c]); }
    __syncthreads();
    { bf16x8 bv[2], akt[2];
#pragma unroll
      for (int ks = 0; ks < 2; ++ks) { bv[ks] = *(const LAS bf16x8*)(Vt + (16 * wv + r16) * 72 + 32 * ks + 8 * q4); akt[ks] = *(const LAS bf16x8*)(Kt + (16 * wv + r16) * 72 + 32 * ks + 8 * q4); }
#pragma unroll
      for (int t4 = 0; t4 < 4; ++t4) {
        f32x4 au = (f32x4){0.f, 0.f, 0.f, 0.f}, aw = (f32x4){0.f, 0.f, 0.f, 0.f};
#pragma unroll
        for (int ks = 0; ks < 2; ++ks) { const bf16x8 tu = *(const LAS bf16x8*)(Tu + (16 * t4 + r16) * 72 + 32 * ks + 8 * q4), tw = *(const LAS bf16x8*)(Tw + (16 * t4 + r16) * 72 + 32 * ks + 8 * q4);
            au = __builtin_amdgcn_mfma_f32_16x16x32_bf16(tu, bv[ks], au, 0, 0, 0);
            aw = __builtin_amdgcn_mfma_f32_16x16x32_bf16(akt[ks], tw, aw, 0, 0, 0); }
        st_wt8(img + GI_U + (16 * wv + r16) * 136 + (16 * t4 + 4 * q4) * 2, pk2(au[0], au[1]), pk2(au[2], au[3]));
        st_wt4(img + IMG_W / 2 + (16 * t4 + r16) * 136 + 16 * wv + 4 * q4, fp8x4(aw[0] * IMG_SC, aw[1] * IMG_SC, aw[2] * IMG_SC, aw[3] * IMG_SC)); } }
    asm volatile("s_waitcnt vmcnt(0)" ::: "memory");
    __syncthreads();
    if (tid == 0) __hip_atomic_store(F.ctl + CW_FLAG + item, 1u, RLX_AGENT);
}
constexpr int SWK_STRIDE = 72, SWV_STRIDE = 264;
__device__ __forceinline__ void swa_item(Frame& F, int item) {
    const int b = item >> 6, nb = (item >> 1) & 31, kvh = item & 1, tid = F.tid, lane = F.lane, r16 = lane & 15, q4 = lane >> 4;
    LAS bf16* Ks = (LAS bf16*)F.lds; LAS bf16* Vt = Ks + 256 * SWK_STRIDE;
    const int g = F.wave & 3, qh = F.wave >> 2, hq = kvh * 4 + g;
    __syncthreads();
    v4u qa[4], qc[4];
#pragma unroll
    for (int m = 0; m < 4; ++m) { const bf16* qp = F.PROJ() + (size_t)(b * SEQ + nb * WIN + 64 * qh + 16 * m + r16) * NPROJ + PC_SQ + hq * 64 + 8 * q4; qa[m] = *(const v4u*)qp; qc[m] = *(const v4u*)(qp + 32); }
    const f32x4 qw0 = *(const f32x4*)(F.q_norm_w + 8 * q4), qw1 = *(const f32x4*)(F.q_norm_w + 8 * q4 + 4), qw2 = *(const f32x4*)(F.q_norm_w + 32 + 8 * q4), qw3 = *(const f32x4*)(F.q_norm_w + 32 + 8 * q4 + 4);
    const float sinkv = F.sinks[hq];
    {
        const int slot = tid >> 1, half = tid & 1, pos = nb * WIN - WIN + slot;
        float kv[32], vv[32]; float ss = 0.f;
        if (pos >= 0) {
            const v4u* kp = (const v4u*)(F.PROJ() + (size_t)(b * SEQ + pos) * NPROJ + PC_SK + kvh * 64 + half * 32);
            const v4u* vp = (const v4u*)(F.PROJ() + (size_t)(b * SEQ + pos) * NPROJ + PC_SV + kvh * 64 + half * 32);
#pragma unroll
            for (int i = 0; i < 4; ++i) { const v4u a = kp[i], c = vp[i];
                kv[8 * i + 0] = bflo(a.x); kv[8 * i + 1] = bfhi(a.x); kv[8 * i + 2] = bflo(a.y); kv[8 * i + 3] = bfhi(a.y); kv[8 * i + 4] = bflo(a.z); kv[8 * i + 5] = bfhi(a.z); kv[8 * i + 6] = bflo(a.w); kv[8 * i + 7] = bfhi(a.w);
                vv[8 * i + 0] = bflo(c.x); vv[8 * i + 1] = bfhi(c.x); vv[8 * i + 2] = bflo(c.y); vv[8 * i + 3] = bfhi(c.y); vv[8 * i + 4] = bflo(c.z); vv[8 * i + 5] = bfhi(c.z); vv[8 * i + 6] = bflo(c.w); vv[8 * i + 7] = bfhi(c.w); }
        } else {
#pragma unroll
            for (int i = 0; i < 32; ++i) { kv[i] = 0.f; vv[i] = 0.f; }
        }
#pragma unroll
        for (int i = 0; i < 32; ++i) ss += kv[i] * kv[i];
        ss += __shfl_xor(ss, 1);
        const float rs = rsqrtf(ss * (1.f / 64.f) + EPS);
#pragma unroll
        for (int i = 0; i < 4; ++i) { const f32x4 w0 = *(const f32x4*)(F.k_norm_w + half * 32 + 8 * i), w1 = *(const f32x4*)(F.k_norm_w + half * 32 + 8 * i + 4);
            *(LAS v4u*)(Ks + slot * SWK_STRIDE + half * 32 + 8 * i) = (v4u){pk2(kv[8 * i] * rs * w0.x, kv[8 * i + 1] * rs * w0.y), pk2(kv[8 * i + 2] * rs * w0.z, kv[8 * i + 3] * rs * w0.w),
                                                                             pk2(kv[8 * i + 4] * rs * w1.x, kv[8 * i + 5] * rs * w1.y), pk2(kv[8 * i + 6] * rs * w1.z, kv[8 * i + 7] * rs * w1.w)}; }
#pragma unroll
        for (int i = 0; i < 32; ++i) Vt[(half * 32 + i) * SWV_STRIDE + slot] = (bf16)f2bf(vv[i]);
    }
    __syncthreads();
    const float LOG2E = 1.4426950408889634f;
    const float slope2 = exp2f(-(float)(hq + 1)) * LOG2E, sink2 = sinkv * LOG2E;
#pragma nounroll
    for (int m = 0; m < 4; ++m) {
        const int i0 = 64 * qh + 16 * m, iq = i0 + r16, t = nb * WIN + iq;
        bf16x8 qf[2];
        {
            const v4u a = qa[0], c = qc[0];
            qa[0] = qa[1]; qa[1] = qa[2]; qa[2] = qa[3]; qc[0] = qc[1]; qc[1] = qc[2]; qc[2] = qc[3];
            float x[16] = {bflo(a.x), bfhi(a.x), bflo(a.y), bfhi(a.y), bflo(a.z), bfhi(a.z), bflo(a.w), bfhi(a.w), bflo(c.x), bfhi(c.x), bflo(c.y), bfhi(c.y), bflo(c.z), bfhi(c.z), bflo(c.w), bfhi(c.w)};
            float ss = 0.f;
#pragma unroll
            for (int i = 0; i < 16; ++i) ss += x[i] * x[i];
            ss += __shfl_xor(ss, 16); ss += __shfl_xor(ss, 32);
            const float rs = rsqrtf(ss * (1.f / 64.f) + EPS) * 0.125f * LOG2E;
            const f32x4 w0 = qw0, w1 = qw1, w2 = qw2, w3 = qw3;
            const v4u f0 = (v4u){pk2(x[0] * rs * w0.x, x[1] * rs * w0.y), pk2(x[2] * rs * w0.z, x[3] * rs * w0.w), pk2(x[4] * rs * w1.x, x[5] * rs * w1.y), pk2(x[6] * rs * w1.z, x[7] * rs * w1.w)};
            const v4u f1 = (v4u){pk2(x[8] * rs * w2.x, x[9] * rs * w2.y), pk2(x[10] * rs * w2.z, x[11] * rs * w2.w), pk2(x[12] * rs * w3.x, x[13] * rs * w3.y), pk2(x[14] * rs * w3.z, x[15] * rs * w3.w)};
            qf[0] = __builtin_bit_cast(bf16x8, f0); qf[1] = __builtin_bit_cast(bf16x8, f1);
        }
        const int kt0 = 2 * (2 * qh + (m >> 1));
        f32x4 st[10]; float mx = sink2;
#pragma unroll
        for (int kk = 0; kk < 10; ++kk) {
            const int kt = kt0 + kk;
            f32x4 a4 = (f32x4){0.f, 0.f, 0.f, 0.f};
#pragma unroll
            for (int ks = 0; ks < 2; ++ks) { const bf16x8 kf = *(const LAS bf16x8*)(Ks + (16 * kt + r16) * SWK_STRIDE + 32 * ks + 8 * q4); a4 = __builtin_amdgcn_mfma_f32_16x16x32_bf16(kf, qf[ks], a4, 0, 0, 0); }
#pragma unroll
            for (int i = 0; i < 4; ++i) { const int j = 16 * kt + 4 * q4 + i, dlt = j - iq;
                const bool ok = (dlt >= 1) && (dlt <= 128) && (nb > 0 || j >= 128);
                const float v = ok ? a4[i] - slope2 * (float)(128 - dlt) : -3.0e38f;
                a4[i] = v; mx = fmaxf(mx, v); }
            st[kk] = a4;
        }
        mx = fmaxf(mx, __shfl_xor(mx, 16)); mx = fmaxf(mx, __shfl_xor(mx, 32));
        float sum = 0.f;
#pragma unroll
        for (int kk = 0; kk < 10; ++kk)
#pragma unroll
            for (int i = 0; i < 4; ++i) { const float p = __builtin_amdgcn_exp2f(st[kk][i] - mx); st[kk][i] = p; sum += p; }
        sum += __shfl_xor(sum, 16); sum += __shfl_xor(sum, 32);
        const float inv = 1.f / (sum + __builtin_amdgcn_exp2f(sink2 - mx));
        f32x4 o[4];
#pragma unroll
        for (int dt = 0; dt < 4; ++dt) o[dt] = (f32x4){0.f, 0.f, 0.f, 0.f};
#pragma unroll
        for (int s2 = 0; s2 < 5; ++s2) { const bf16x8 pf = pack_frag(st[2 * s2], st[2 * s2 + 1]);
#pragma unroll
            for (int dt = 0; dt < 4; ++dt) { const bf16x8 vf = lda_frag((const LAS unsigned char*)(Vt + (16 * dt + r16) * SWV_STRIDE + 16 * kt0 + 32 * s2 + 4 * q4)); o[dt] = __builtin_amdgcn_mfma_f32_16x16x32_bf16(vf, pf, o[dt], 0, 0, 0); } }
        bf16* op = F.MIXED() + (size_t)(b * SEQ + t) * D + 512 + hq * 64 + 4 * q4;
#pragma unroll
        for (int dt = 0; dt < 4; ++dt) *(v2u*)(op + 16 * dt) = (v2u){pk2(o[dt][0] * inv, o[dt][1] * inv), pk2(o[dt][2] * inv, o[dt][3] * inv)};
    }
}
constexpr int SCAN_NCW = 4;
__device__ __forceinline__ void scan_step(const int n, const LAS unsigned char* cur, f32x4 (&S)[8], bf16* op, const int ulo, const int c16, const int q4) {
#define SCB() __builtin_amdgcn_sched_barrier(0)
#define LD_WQ(F_, mt_) do { _Pragma("unroll") for (int s2 = 0; s2 < 4; ++s2) { F_[s2] = lda_frag(cur + IMG_W + (16 * (mt_) + c16) * 272 + (32 * s2 + 4 * q4) * 2); F_[4 + s2] = lda_frag(cur + IMG_Q + (16 * (mt_) + c16) * 272 + (32 * s2 + 4 * q4) * 2); } } while (0)
#define MM_WQ(F_, mt_) do { _Pragma("unroll") for (int s2 = 0; s2 < 4; ++s2) { Pm[mt_] = __builtin_amdgcn_mfma_f32_16x16x32_bf16(F_[s2], sf[s2], Pm[mt_], 0, 0, 0); Om[mt_] = __builtin_amdgcn_mfma_f32_16x16x32_bf16(F_[4 + s2], sf[s2], Om[mt_], 0, 0, 0); } } while (0)
    bf16x8 sf[4];
#pragma unroll
    for (int s2 = 0; s2 < 4; ++s2) sf[s2] = pack_frag(S[2 * s2], S[2 * s2 + 1]);
    f32x4 Pm[4], Om[4];
#pragma unroll
    for (int mt = 0; mt < 4; ++mt) { Pm[mt] = (f32x4){0.f, 0.f, 0.f, 0.f}; Om[mt] = (f32x4){0.f, 0.f, 0.f, 0.f}; }
    bf16x8 FA[8], FB[8];
    LD_WQ(FA, 0); SCB();
    LD_WQ(FB, 1); SCB();
    MM_WQ(FA, 0); SCB();
    LD_WQ(FA, 2); SCB();
    MM_WQ(FB, 1); SCB();
    LD_WQ(FB, 3); SCB();
    MM_WQ(FA, 2); SCB();
#pragma unroll
    for (int mt = 0; mt < 4; ++mt)
#pragma unroll
        for (int s2 = 0; s2 < 2; ++s2) FA[2 * mt + s2] = lda_frag(cur + IMG_A + (16 * mt + c16) * IMG_KS + (32 * s2 + 4 * q4) * 2);
    const float dec = *(const LAS float*)(cur + IMG_U + 128);
    v2u uc[4];
#pragma unroll
    for (int mt = 0; mt < 4; ++mt) uc[mt] = *(const LAS v2u*)(cur + ulo + 32 * mt);
    SCB();
    MM_WQ(FB, 3); SCB();
#pragma unroll
    for (int m8 = 0; m8 < 4; ++m8)
#pragma unroll
        for (int s2 = 0; s2 < 2; ++s2) FB[2 * m8 + s2] = lda_frag(cur + IMG_K + (16 * m8 + c16) * IMG_KS + (32 * s2 + 4 * q4) * 2);
    SCB();
    f32x4 Vm[4];
#pragma unroll
    for (int mt = 0; mt < 4; ++mt) { const f32x4 u4 = (f32x4){bflo(uc[mt].x), bfhi(uc[mt].x), bflo(uc[mt].y), bfhi(uc[mt].y)}; Vm[mt] = u4 - Pm[mt] * (1.f / IMG_SC); }
    bf16x8 vf[2], vg[2];
    vf[0] = pack_frag(Vm[0], Vm[1]); vf[1] = pack_frag(Vm[2], Vm[3]);
    vg[0] = pack_frag(Vm[0] * (1.f / IMG_SC), Vm[1] * (1.f / IMG_SC)); vg[1] = pack_frag(Vm[2] * (1.f / IMG_SC), Vm[3] * (1.f / IMG_SC));
    SCB();
#pragma unroll
    for (int mt = 0; mt < 4; ++mt)
#pragma unroll
        for (int s2 = 0; s2 < 2; ++s2) Om[mt] = __builtin_amdgcn_mfma_f32_16x16x32_bf16(FA[2 * mt + s2], vf[s2], Om[mt], 0, 0, 0);
    SCB();
#pragma unroll
    for (int m8 = 4; m8 < 8; ++m8)
#pragma unroll
        for (int s2 = 0; s2 < 2; ++s2) FA[2 * (m8 - 4) + s2] = lda_frag(cur + IMG_K + (16 * m8 + c16) * IMG_KS + (32 * s2 + 4 * q4) * 2);
    SCB();
#pragma unroll
    for (int m8 = 0; m8 < 4; ++m8) { S[m8] = S[m8] * dec;
#pragma unroll
        for (int s2 = 0; s2 < 2; ++s2) S[m8] = __builtin_amdgcn_mfma_f32_16x16x32_bf16(FB[2 * m8 + s2], vg[s2], S[m8], 0, 0, 0); }
    SCB();
    bf16* o2 = op + (size_t)n * CH * 512;
#pragma unroll
    for (int mt = 0; mt < 4; ++mt)
#pragma unroll
        for (int i = 0; i < 4; ++i) o2[(size_t)(16 * mt + i) * 512] = (bf16)f2bf(Om[mt][i] * (1.f / IMG_SC));
    SCB();
#pragma unroll
    for (int m8 = 4; m8 < 8; ++m8) { S[m8] = S[m8] * dec;
#pragma unroll
        for (int s2 = 0; s2 < 2; ++s2) S[m8] = __builtin_amdgcn_mfma_f32_16x16x32_bf16(FA[2 * (m8 - 4) + s2], vg[s2], S[m8], 0, 0, 0); }
#undef SCB
#undef LD_WQ
#undef MM_WQ
    asm volatile("s_waitcnt lgkmcnt(0)" ::: "memory"); __builtin_amdgcn_s_barrier(); asm volatile("" ::: "memory");
}
constexpr int SC_NP = 11;
#define SC_LD(R, nn) do { const int n_ = ((nn) < NCH) ? (nn) : NCH - 1; const unsigned char* q_ = img + (size_t)n_ * istep; \
    { unsigned sp_ = 0; while (n_ >= ready) { const unsigned long long m_ = __ballot(__hip_atomic_load(flagp + lane * 4, RLX_AGENT) != 0u); ready = (m_ == ~0ull) ? 64 : __builtin_ctzll(~m_); \
        if (n_ >= ready) { __builtin_amdgcn_s_sleep(8); if (++sp_ > (1u << 20)) break; } } } \
    _Pragma("unroll") for (int p_ = 0; p_ < SC_NP; ++p_) { if (p_ < 8) asm volatile("global_load_dwordx4 %0, %1, %2" : "=v"(R[p_]) : "v"(vmain), "s"(q_ + p_ * 4096) : "memory"); \
        else asm volatile("global_load_dwordx4 %0, %1, %2" : "=v"(R[p_]) : "v"(vmain), "s"(q_ + GI_U + upart + (p_ - 8) * 4096) : "memory"); } } while (0)
#define SC_WAITR(R, CNT) asm volatile("s_waitcnt vmcnt(" #CNT ")" : "+v"(R[0]), "+v"(R[1]), "+v"(R[2]), "+v"(R[3]), "+v"(R[4]), "+v"(R[5]), "+v"(R[6]), "+v"(R[7]), "+v"(R[8]), "+v"(R[9]), "+v"(R[10]) :: "memory")
__device__ __forceinline__ void sc_cvt_store(LAS unsigned char* dst, const v4u q) {
    const unsigned qq[4] = {q.x, q.y, q.z, q.w}; unsigned o[8];
#pragma unroll
    for (int j = 0; j < 4; ++j) { const f32x2_t p0 = __builtin_amdgcn_cvt_pk_f32_fp8(qq[j], false), p1 = __builtin_amdgcn_cvt_pk_f32_fp8(qq[j], true); o[2 * j] = pk2(p0[0], p0[1]); o[2 * j + 1] = pk2(p1[0], p1[1]); }
    *(LAS v4u*)dst = (v4u){o[0], o[1], o[2], o[3]}; *(LAS v4u*)(dst + 16) = (v4u){o[4], o[5], o[6], o[7]};
}
#define SC_ST(R, buf) do { LAS unsigned char* b_ = (buf); _Pragma("unroll") for (int p_ = 0; p_ < 8; ++p_) if (p_ < 7 || hl * 16 < IMG_U / 2 - 7 * 4096) sc_cvt_store(b_ + 2 * (p_ * 4096 + hl * 16), R[p_]); \
    _Pragma("unroll") for (int p_ = 8; p_ < SC_NP; ++p_) if (p_ < 10 || hl * 16 < IMG_UHALF - 2 * 4096) *(LAS v4u*)(b_ + IMG_U + (p_ - 8) * 4096 + hl * 16) = R[p_]; \
    asm volatile("s_waitcnt lgkmcnt(0)" ::: "memory"); } while (0)
#define SC_BAR() do { __builtin_amdgcn_s_barrier(); asm volatile("" ::: "memory"); } while (0)
__device__ __forceinline__ void scan_item(Frame& F, int item) {
    static_assert(SCAN_NCW == 4 && 2 * IMG_LDS <= SCRATCH_BYTES && 8 * 4096 >= IMG_U / 2 && 7 * 4096 < IMG_U / 2 && GI_U + 2 * IMG_UHALF + 4096 <= IMG_BYTES, "scan geometry");
    constexpr int NSPLIT = 8 / SCAN_NCW;
    const int bh = item / NSPLIT, part = item % NSPLIT, b = bh >> 2, h = bh & 3, tid = F.tid, lane = F.lane, c16 = lane & 15, q4 = lane >> 4;
    const bool comp = F.wave < SCAN_NCW;
    LAS unsigned char* bufs = F.lds;
    const size_t istep = (size_t)4 * IMG_BYTES;
    const unsigned char* img = F.dnimg() + (size_t)((b * 64) * 4 + h) * IMG_BYTES;
    __syncthreads();
    if (comp) {
        const int dv0 = (part * SCAN_NCW + F.wave) * 16;
        const int ulo = IMG_U + (F.wave * 16 + c16) * 136 + 8 * q4;
        bf16* op = F.odn() + (size_t)(b * SEQ + 4 * q4) * 512 + h * 128 + dv0 + c16;
        f32x4 S[8];
#pragma unroll
        for (int i = 0; i < 8; ++i) S[i] = (f32x4){0.f, 0.f, 0.f, 0.f};
        SC_BAR();
        for (int n = 0; n < NCH; n += 2) { scan_step(n, bufs, S, op, ulo, c16, q4); scan_step(n + 1, bufs + IMG_LDS, S, op, ulo, c16, q4); }
    } else {
        const int hl = tid - 256;
        gu32* flagp = F.ctl + CW_FLAG + (b * 64) * 4 + h;
        int ready = 0;
        const unsigned vmain = (unsigned)hl * 16u; const int upart = part * IMG_UHALF;
        v4u R0[SC_NP], R1[SC_NP];
        SC_LD(R0, 0); SC_LD(R1, 1);
        SC_WAITR(R0, 11); SC_ST(R0, bufs); SC_LD(R0, 2); SC_BAR();
        for (int n = 0; n < NCH - 2; n += 2) {
            SC_WAITR(R1, 11); SC_ST(R1, bufs + IMG_LDS); SC_LD(R1, n + 3); SC_BAR();
            SC_WAITR(R0, 11); SC_ST(R0, bufs); SC_LD(R0, n + 4); SC_BAR();
        }
        SC_WAITR(R1, 11); SC_ST(R1, bufs + IMG_LDS); SC_LD(R1, NCH + 1); SC_BAR();
        SC_BAR();
        SC_WAITR(R0, 0); SC_WAITR(R1, 0);
    }
}
__device__ __forceinline__ void p34_mix(Frame& F, const XcdBarrier& bar) {
    constexpr int NSCAN = 16 * (8 / SCAN_NCW);
    if (F.G > NSCAN + 32) {
        if ((int)blockIdx.x < NSCAN) {
#ifndef NO_SCAN
            scan_item(F, (int)blockIdx.x);
#endif
        } else {
            const int pb = (int)blockIdx.x - NSCAN, npool = F.G - NSCAN, nW = npool / 3, nP = npool - nW; const bool isW = (pb % 3) == 2;
            const int rank = isW ? pb / 3 : pb - (pb + 1) / 3;
            const int upW = W_SHARE, dnW = W_SHARE * 8;
            if (isW) {
#ifndef NO_TR
                expert_transposes(F, rank, nW, 0, upW, 0, dnW);
#endif
            } else {
#ifndef NO_PREP
                int lasth = -1;
                for (int k = rank; k < 1024; k += nP) { const int n = k >> 4, bh = k & 15; dn_prep_item(F, ((bh >> 2) * 64 + n) * 4 + (bh & 3), (bh & 3) != lasth); lasth = bh & 3; }
#endif
            }
        }
#ifndef NO_SWA
        for (;;) { __syncthreads(); if (F.tid == 0) F.MISC[20] = __hip_atomic_fetch_add(F.ctl + CW_SWAQ, 1u, RLX_AGENT); __syncthreads(); const int it = (int)F.MISC[20]; if (it >= 256) break; swa_item(F, it); }
#ifndef NO_TR
        { const int nup = 32 * 32 - W_SHARE, ndn = (32 * 256 - W_SHARE * 8) / 8; LAS float* scr = (LAS float*)(F.lds + F.wave * 16640);
          for (;;) { __syncthreads(); if (F.tid == 0) F.MISC[21] = __hip_atomic_fetch_add(F.ctl + CW_SWAQ + 64, 1u, RLX_AGENT); __syncthreads(); const int tk = (int)F.MISC[21]; if (tk >= nup + ndn) break;
              if (tk < nup) quant_up_item(F, W_SHARE + tk);
              else { const int r = W_SHARE * 8 + 8 * (tk - nup) + F.wave, e = r >> 8, rr = r & 255, kb = rr >> 4, nb = rr & 15;
                  transpose64_fp8_item(F.w_down + (size_t)e * 1024 * 1024, 1024, (unsigned char*)F.Wdn_t() + (size_t)e * 1024 * 1024, 64 * nb, 64 * nb, 64 * kb, scr, F.lane); } } }
#endif
#endif
    }
}

template <bool WT> __device__ __forceinline__ void p5_rows(Frame& F, const int gw, const int NGW, const int tend) {
    const int lane = F.lane, d0 = (lane & 15) * 8;
    const f32x4 w0 = *(const f32x4*)(F.dn_norm_w + d0), w1 = *(const f32x4*)(F.dn_norm_w + d0 + 4);
    constexpr int NB = 4;
    for (int tb = gw; tb < tend; tb += NGW * NB) {
        f32x4 a[NB], c[NB]; v4u zz[NB], sw[NB];
#pragma unroll
        for (int i = 0; i < NB; ++i) { const int t = tb + i * NGW;
            if (t < tend) { const v4u ow = *(const v4u*)(F.odn() + (size_t)t * 512 + lane * 8); a[i] = (f32x4){bflo(ow.x), bfhi(ow.x), bflo(ow.y), bfhi(ow.y)}; c[i] = (f32x4){bflo(ow.z), bfhi(ow.z), bflo(ow.w), bfhi(ow.w)}; zz[i] = *(const v4u*)(F.PROJ() + (size_t)t * NPROJ + PC_Z + lane * 8);
                sw[i] = *(const v4u*)(F.MIXED() + (size_t)t * D + 512 + lane * 8); } }
#pragma unroll
        for (int i = 0; i < NB; ++i) { const int t = tb + i * NGW;
            if (t < tend) {
                float ss = (a[i].x * a[i].x + a[i].y * a[i].y) + (a[i].z * a[i].z + a[i].w * a[i].w) + (c[i].x * c[i].x + c[i].y * c[i].y) + (c[i].z * c[i].z + c[i].w * c[i].w);
                ss += __shfl_xor(ss, 1); ss += __shfl_xor(ss, 2); ss += __shfl_xor(ss, 4); ss += __shfl_xor(ss, 8);
                const float rs = rsqrtf(ss * (1.f / 128.f) + EPS);
                float r[16] = {a[i].x * rs * w0.x, a[i].y * rs * w0.y, a[i].z * rs * w0.z, a[i].w * rs * w0.w, c[i].x * rs * w1.x, c[i].y * rs * w1.y, c[i].z * rs * w1.z, c[i].w * rs * w1.w,
                               bflo(sw[i].x), bfhi(sw[i].x), bflo(sw[i].y), bfhi(sw[i].y), bflo(sw[i].z), bfhi(sw[i].z), bflo(sw[i].w), bfhi(sw[i].w)};
                const float z[8] = {bflo(zz[i].x), bfhi(zz[i].x), bflo(zz[i].y), bfhi(zz[i].y), bflo(zz[i].z), bfhi(zz[i].z), bflo(zz[i].w), bfhi(zz[i].w)};
                float am = 0.f;
#pragma unroll
                for (int k = 0; k < 8; ++k) r[k] *= siluf(z[k]);
#pragma unroll
                for (int k = 0; k < 16; ++k) am = fmaxf(am, fabsf(r[k]));
#pragma unroll
                for (int o = 1; o < 64; o <<= 1) am = fmaxf(am, __shfl_xor(am, o));
                am = fmaxf(am, 1e-30f); const float qs = 127.f / am; if (lane == 0) { if (WT) st_wt4(F.mscale() + t, __float_as_uint(am * (1.f / 127.f))); else F.mscale()[t] = am * (1.f / 127.f); }
                int q[16];
#pragma unroll
                for (int k = 0; k < 16; ++k) q[k] = (int)rintf(r[k] * qs);
                const v2u d = (v2u){(unsigned)(q[0] & 255) | ((unsigned)(q[1] & 255) << 8) | ((unsigned)(q[2] & 255) << 16) | ((unsigned)(q[3] & 255) << 24), (unsigned)(q[4] & 255) | ((unsigned)(q[5] & 255) << 8) | ((unsigned)(q[6] & 255) << 16) | ((unsigned)(q[7] & 255) << 24)};
                const v2u e = (v2u){(unsigned)(q[8] & 255) | ((unsigned)(q[9] & 255) << 8) | ((unsigned)(q[10] & 255) << 16) | ((unsigned)(q[11] & 255) << 24), (unsigned)(q[12] & 255) | ((unsigned)(q[13] & 255) << 8) | ((unsigned)(q[14] & 255) << 16) | ((unsigned)(q[15] & 255) << 24)};
                if (WT) { st_wt8(F.MIXQ() + (size_t)t * D + lane * 8, d.x, d.y); st_wt8(F.MIXQ() + (size_t)t * D + 512 + lane * 8, e.x, e.y); }
                else { *(v2u*)(F.MIXQ() + (size_t)t * D + lane * 8) = d; *(v2u*)(F.MIXQ() + (size_t)t * D + 512 + lane * 8) = e; } } }
    }
}
__device__ __forceinline__ void p5_dnnorm(Frame& F) { p5_rows<false>(F, F.vcu * NWAVES + F.wave, F.G * NWAVES, T); }

__device__ __forceinline__ void p7_router(Frame& F) {
    LAS bf16* Wh = (LAS bf16*)F.lds; LAS bf16* Wl = Wh + 32 * WR_STRIDE; LAS float* LG = (LAS float*)(F.lds + 2 * 32 * WR_STRIDE * 2);
    const int lane = F.lane, r16 = lane & 15, q4 = lane >> 4, wq = F.wave & 3, eh = F.wave >> 2;
    __syncthreads();
    { const v4u* src = (const v4u*)F.wrimg(); LAS v4u* dst = (LAS v4u*)Wh;
      constexpr int NPC = (2 * 32 * WR_STRIDE / 8 + NWAVES * 64 - 1) / (NWAVES * 64);
      v4u pc[NPC];
#pragma unroll
      for (int j = 0; j < NPC; ++j) { const int i = F.tid + j * NWAVES * 64; if (i < 2 * 32 * WR_STRIDE / 8) pc[j] = src[i]; }
#pragma unroll
      for (int j = 0; j < NPC; ++j) { const int i = F.tid + j * NWAVES * 64; if (i < 2 * 32 * WR_STRIDE / 8) dst[i] = pc[j]; } }
    for (int rg = blockIdx.x; rg < 256; rg += F.G) {
        const int b = rg >> 6, t = rg * 64 + wq * 16 + r16;
        const float* m2a = F.modf() + 32768 + b * 1024; const float* m2b = F.modf() + 32768 + 4096 + b * 1024;
        __syncthreads();
        for (int i = F.tid; i < 64 * 33; i += NWAVES * 64) LG[i] = 0.f;
        float mB2;
        { float m = fmaxf(fabsf(m2b[F.tid]), fabsf(m2b[F.tid + 512]));
#pragma unroll
          for (int o = 1; o < 64; o <<= 1) m = fmaxf(m, __shfl_xor(m, o));
          LAS float* red = (LAS float*)(LG + 64 * 33 + 64);
          if (lane == 0) red[F.wave] = m;
          __syncthreads();
          mB2 = fmaxf(fmaxf(fmaxf(red[0], red[1]), fmaxf(red[2], red[3])), fmaxf(fmaxf(red[4], red[5]), fmaxf(red[6], red[7])));
          __syncthreads(); }
        const bf16* xr = F.X1B() + (size_t)t * D + 8 * q4;
        float ss = 0.f, ma = 0.f;
        { const f32x4* rp = (const f32x4*)(F.rstat() + (size_t)t * 32);
#pragma unroll
          for (int i = 0; i < 8; ++i) { const f32x4 q = rp[i]; ss += q.x + q.z; ma = fmaxf(ma, fmaxf(q.y, q.w)); } }
        const float rstd = rsqrtf(ss * (1.f / D) + EPS);
        const float amax = fmaxf(rstd * ma + mB2, 1e-30f), qs = 127.f / amax;
        if (eh == 0 && q4 == 0) { F.hscale()[t] = amax * (1.f / 127.f); ((LAS float*)(LG + 64 * 33 + 96))[wq * 16 + r16] = amax * (1.f / 127.f); }
        f32x4 acc0 = (f32x4){0.f, 0.f, 0.f, 0.f}, acc1 = acc0;
        const LAS bf16* whp = Wh + r16 * WR_STRIDE + 8 * q4; const LAS bf16* wlp = Wl + r16 * WR_STRIDE + 8 * q4;
        signed char* qrow = F.H8() + (size_t)t * D + 8 * q4;
#pragma unroll 4
        for (int s3 = 0; s3 < 16; ++s3) { const int s2 = 16 * eh + s3;
            const v4u xw = *(const v4u*)(xr + 32 * s2); const f32x4 a = (f32x4){bflo(xw.x), bfhi(xw.x), bflo(xw.y), bfhi(xw.y)}, c = (f32x4){bflo(xw.z), bfhi(xw.z), bflo(xw.w), bfhi(xw.w)};
            const f32x4 a0 = *(const f32x4*)(m2a + 32 * s2 + 8 * q4), a1 = *(const f32x4*)(m2a + 32 * s2 + 8 * q4 + 4), b0 = *(const f32x4*)(m2b + 32 * s2 + 8 * q4), b1 = *(const f32x4*)(m2b + 32 * s2 + 8 * q4 + 4);
            const f32x4 h0 = a * rstd * a0 + b0, h1 = c * rstd * a1 + b1;
            float hv[8] = {h0.x, h0.y, h0.z, h0.w, h1.x, h1.y, h1.z, h1.w}; unsigned hw[4], lw[4];
#pragma unroll
            for (int i = 0; i < 4; ++i) { hw[i] = pk2(hv[2 * i], hv[2 * i + 1]); lw[i] = pk2(hv[2 * i] - bflo(hw[i]), hv[2 * i + 1] - bfhi(hw[i])); }
            const v4u xhw = (v4u){hw[0], hw[1], hw[2], hw[3]};
            const v4u xlw = (v4u){lw[0], lw[1], lw[2], lw[3]};
            { int q[8];
#pragma unroll
              for (int i = 0; i < 8; ++i) q[i] = (int)rintf(hv[i] * qs);
              const unsigned lo = (unsigned)(q[0] & 255) | ((unsigned)(q[1] & 255) << 8) | ((unsigned)(q[2] & 255) << 16) | ((unsigned)(q[3] & 255) << 24);
              const unsigned hi = (unsigned)(q[4] & 255) | ((unsigned)(q[5] & 255) << 8) | ((unsigned)(q[6] & 255) << 16) | ((unsigned)(q[7] & 255) << 24);
              *(v2u*)(qrow + 32 * s2) = (v2u){lo, hi}; }
            const bf16x8 xh = __builtin_bit_cast(bf16x8, xhw), xl = __builtin_bit_cast(bf16x8, xlw);
            const bf16x8 wh0 = *(const LAS bf16x8*)(whp + 32 * s2), wl0 = *(const LAS bf16x8*)(wlp + 32 * s2), wh1 = *(const LAS bf16x8*)(whp + 16 * WR_STRIDE + 32 * s2), wl1 = *(const LAS bf16x8*)(wlp + 16 * WR_STRIDE + 32 * s2);
            acc0 = __builtin_amdgcn_mfma_f32_16x16x32_bf16(wh0, xh, acc0, 0, 0, 0); acc1 = __builtin_amdgcn_mfma_f32_16x16x32_bf16(wh1, xh, acc1, 0, 0, 0);
            acc0 = __builtin_amdgcn_mfma_f32_16x16x32_bf16(wh0, xl, acc0, 0, 0, 0); acc1 = __builtin_amdgcn_mfma_f32_16x16x32_bf16(wh1, xl, acc1, 0, 0, 0);
            acc0 = __builtin_amdgcn_mfma_f32_16x16x32_bf16(wl0, xh, acc0, 0, 0, 0); acc1 = __builtin_amdgcn_mfma_f32_16x16x32_bf16(wl1, xh, acc1, 0, 0, 0);
        }
#pragma unroll
        for (int i = 0; i < 4; ++i) { atomicAdd((float*)(LG + (wq * 16 + r16) * 33 + 4 * q4 + i), acc0[i] + (eh == 0 ? F.b_router[4 * q4 + i] : 0.f)); atomicAdd((float*)(LG + (wq * 16 + r16) * 33 + 16 + 4 * q4 + i), acc1[i] + (eh == 0 ? F.b_router[16 + 4 * q4 + i] : 0.f)); }
        __syncthreads();
        LAS unsigned* lc = (LAS unsigned*)(LG + 64 * 33); LAS unsigned* lbase = lc + 32;
        if (F.tid < 32) lc[F.tid] = 0u;
        __syncthreads();
        float tv[4]; int ti[4]; unsigned rk[4];
        if (F.wave == 0) {
            float lg[32];
#pragma unroll
            for (int e = 0; e < 32; ++e) lg[e] = LG[lane * 33 + e];
#pragma unroll
            for (int r = 0; r < 4; ++r) { float bv = -3.0e38f; int bi = 0;
#pragma unroll
                for (int e = 0; e < 32; ++e) { const float v = lg[e]; const bool taken = (r > 0 && ti[0] == e) || (r > 1 && ti[1] == e) || (r > 2 && ti[2] == e); if (!taken && v > bv) { bv = v; bi = e; } }
                tv[r] = bv; ti[r] = bi; rk[r] = atomicAdd((unsigned*)(lc + bi), 1u); }
        }
        __syncthreads();
        if (F.tid < 32) lbase[F.tid] = atomicAdd((unsigned*)(F.ctl + CW_CNT + 64 * F.tid), lc[F.tid]);
        __syncthreads();
        if (F.wave == 0) {
            const int tt = rg * 64 + lane;
            const float e1 = __expf(tv[1] - tv[0]), e2 = __expf(tv[2] - tv[0]), e3 = __expf(tv[3] - tv[0]), inv = 1.f / (1.f + e1 + e2 + e3);
            const float gts[4] = {inv, e1 * inv, e2 * inv, e3 * inv}; const float hsr = ((const LAS float*)(LG + 64 * 33 + 96))[lane];
#pragma unroll
            for (int r = 0; r < 4; ++r) { const unsigned pos = lbase[ti[r]] + rk[r]; F.lslot()[ti[r] * T + pos] = tt * 4 + r; F.lgate()[ti[r] * T + pos] = gts[r]; F.lhs()[ti[r] * T + pos] = hsr; }
        }
    }
}

__device__ __forceinline__ void moe_plan(Frame& F) {
    LAS int* P = (LAS int*)(F.lds + CTRL_OFF + 256);
    __syncthreads();
    if (F.tid < NE) { const int c = (int)__hip_atomic_load(F.ctl + CW_CNT + 64 * F.tid, RLX_AGENT); P[PL_CNT + F.tid] = c; P[PL_NT + F.tid] = (c + 255) >> 8; }
    if (F.tid < 8) P[PL_GN + F.tid] = NE / 8;
    __syncthreads();
    if (F.tid < NE) { const int e = F.tid, k = P[PL_NT + e]; int rank = 0, ts = 0;
#pragma unroll
        for (int o = 0; o < NE; ++o) { const int ko = P[PL_NT + o]; rank += (ko > k || (ko == k && o < e)) ? 1 : 0; ts += (o < e) ? ko : 0; }
        P[PL_TS + e] = ts;
        const int row = rank >> 3, col = rank & 7, g = (row & 1) ? 7 - col : col;
        P[PL_GE + g * 16 + row] = e; }
    __syncthreads();
}

__device__ __forceinline__ void p2_proj(Frame& F) {
    pg8::Gemm g{(const bf16*)F.Hq(), (const bf16*)F.Win8(), T, NPROJ, D / 2}; DenseOrder S; S.init(T, NPROJ, D / 2, F.G, (int)blockIdx.x, F.tid);
    EpiProjI8 E{F.PROJ(), F.hscale1(), F.inscale()};
    pg8::gemm_phase<EpiProjI8, DenseOrder, true, true>(F.lds, g, S, E, F.wave, F.lane);
}
__device__ __forceinline__ void p6_outproj(Frame& F, bool fused) {
    pg8::Gemm g{(const bf16*)F.MIXQ(), (const bf16*)F.Wout8(), T, D, D / 2}; DenseOrder S; S.init(T, D, D / 2, F.G, (int)blockIdx.x, F.tid);
    if (fused) {
        pg8::Unit u0; if (S.next(0, u0)) {
            p5_rows<true>(F, u0.pm * 256 + u0.pn * 64 + F.wave, NWAVES, u0.pm * 256 + u0.pn * 64 + 64);
            asm volatile("s_waitcnt vmcnt(0)" ::: "memory"); __syncthreads();
            if (F.tid == 0) (void)__hip_atomic_fetch_add(F.ctl + CW_MQ + 64 * u0.pm, 1u, __ATOMIC_RELAXED, __HIP_MEMORY_SCOPE_AGENT);
            unsigned sp = 0u;
            for (;;) { const unsigned v = __builtin_amdgcn_readfirstlane(__hip_atomic_load(F.ctl + CW_MQ + 64 * u0.pm, __ATOMIC_RELAXED, __HIP_MEMORY_SCOPE_AGENT)); if (v >= 4u) break;
                __builtin_amdgcn_s_sleep(2); if (++sp > (1u << 22)) break; } } }
    EpiX1 E{F.x, F.X1B(), F.modf(), F.rstat(), F.mscale(), F.outscale()};
    pg8::gemm_phase<EpiX1, DenseOrder, true, true>(F.lds, g, S, E, F.wave, F.lane);
}
__device__ __forceinline__ void p9_up(Frame& F) {
    moe_plan(F);
    pg8::Gemm g{(const bf16*)F.H8(), (const bf16*)F.Wup8(), 0, 0, D / 2};
    MoeOrder S{8, F.G / 8, (int)blockIdx.x / 8, (int)blockIdx.x % 8, 2048, 1024, (const LAS int*)(F.lds + CTRL_OFF + 256), F.lslot(), true, F.tid, (const LAS int*)(F.lds + CTRL_OFF + 2048)};
    S.fill((LAS int*)(F.lds + CTRL_OFF + 2048));
    EpiSwiglu E{(unsigned char*)F.ACT(), F.b_up, F.upscale(), F.lhs(), (const LAS int*)(F.lds + CTRL_OFF + 256)};
    pg8::gemm_phase<EpiSwiglu, MoeOrder, true, true>(F.lds, g, S, E, F.wave, F.lane);
}
__device__ __forceinline__ void p10_down(Frame& F, bool have_plan) {
    if (!have_plan) moe_plan(F);
    pg8::Gemm g{F.ACT(), F.Wdn_t(), 0, 0, DFF / 2};
    MoeOrder S{4, F.G / 8, (int)blockIdx.x / 8, (int)blockIdx.x % 8, 1024, 1024, (const LAS int*)(F.lds + CTRL_OFF + 256), F.lslot(), false, F.tid, (const LAS int*)(F.lds + CTRL_OFF + 3072)};
    S.fill((LAS int*)(F.lds + CTRL_OFF + 3072));
    EpiDown E{(unsigned char*)F.SLOT(), F.lslot(), F.lgate(), F.b_down, (const LAS int*)(F.lds + CTRL_OFF + 256)};
    pg8::gemm_phase<EpiDown, MoeOrder, true, true>(F.lds, g, S, E, F.wave, F.lane);
}
__device__ __forceinline__ void p11_combine(Frame& F) {
    const int gw = F.vcu * NWAVES + F.wave, NGW = F.G * NWAVES, lane = F.lane;
    for (int t0 = gw * 2; t0 < T; t0 += NGW * 2) {
        v2u w[2][2][4]; f32x4 x[2][2][2];
#pragma unroll
        for (int tt = 0; tt < 2; ++tt)
#pragma unroll
            for (int j = 0; j < 2; ++j) { const int col = j * 512 + lane * 8;
#pragma unroll
                for (int k = 0; k < 4; ++k) w[tt][j][k] = *(const v2u*)((const unsigned char*)F.SLOT() + (size_t)((t0 + tt) * 4 + k) * D + col);
                { const v4u xw = *(const v4u*)(F.X1B() + (size_t)(t0 + tt) * D + col); x[tt][j][0] = (f32x4){bflo(xw.x), bfhi(xw.x), bflo(xw.y), bfhi(xw.y)}; x[tt][j][1] = (f32x4){bflo(xw.z), bfhi(xw.z), bflo(xw.w), bfhi(xw.w)}; } }
        const float* g2 = F.modf() + (t0 >> 12) * 6144 + 5120;
#pragma unroll
        for (int j = 0; j < 2; ++j) { const int col = j * 512 + lane * 8;
            const f32x4 g0 = *(const f32x4*)(g2 + col), g1 = *(const f32x4*)(g2 + col + 4);
#pragma unroll
            for (int tt = 0; tt < 2; ++tt) { float sm[8];
#pragma unroll
                for (int i = 0; i < 8; ++i) sm[i] = 0.f;
#pragma unroll
                for (int k = 0; k < 4; ++k) { const v2u q = w[tt][j][k];
                    const f32x2_t p0 = __builtin_amdgcn_cvt_pk_f32_fp8(q.x, false), p1 = __builtin_amdgcn_cvt_pk_f32_fp8(q.x, true), p2 = __builtin_amdgcn_cvt_pk_f32_fp8(q.y, false), p3 = __builtin_amdgcn_cvt_pk_f32_fp8(q.y, true);
                    sm[0] += p0[0]; sm[1] += p0[1]; sm[2] += p1[0]; sm[3] += p1[1]; sm[4] += p2[0]; sm[5] += p2[1]; sm[6] += p3[0]; sm[7] += p3[1]; }
#pragma unroll
                for (int i = 0; i < 8; ++i) sm[i] *= (1.f / 16.f);
                f32x4 x0 = x[tt][j][0], x1 = x[tt][j][1];
                x0.x += g0.x * sm[0]; x0.y += g0.y * sm[1]; x0.z += g0.z * sm[2]; x0.w += g0.w * sm[3]; x1.x += g1.x * sm[4]; x1.y += g1.y * sm[5]; x1.z += g1.z * sm[6]; x1.w += g1.w * sm[7];
                if (PROBE_A >= 0) { const float dtus = (float)(__hip_atomic_load(F.ctl + CW_TS + PROBE_A + 1, RLX_AGENT) - __hip_atomic_load(F.ctl + CW_TS + PROBE_A, RLX_AGENT)) * 0.01f; const float sc = 1.f + sqrtf(dtus * PROBE_SCALE); x0 = x0 * sc; x1 = x1 * sc; }
                if (PROBE_B >= 0 && t0 + tt == 0 && lane == 0 && j == 0) { const float dtus = (float)(__hip_atomic_load(F.ctl + CW_TS + PROBE_B + 1, RLX_AGENT) - __hip_atomic_load(F.ctl + CW_TS + PROBE_B, RLX_AGENT)) * 0.01f; x0.x += 1.f + dtus * 0.01f; }
                f32x4* op = (f32x4*)(F.out + (size_t)(t0 + tt) * D + col); op[0] = x0; op[1] = x1; } }
    }
}

__global__ void __launch_bounds__(NWAVES * 64, 2) fwd_kernel(Args args) {
    extern __shared__ __attribute__((aligned(16))) unsigned char lds[];
    Frame F;
    F.lds = (LAS unsigned char*)lds;
    F.MISC = (volatile LAS unsigned*)(F.lds + CTRL_OFF);
    F.wave = __builtin_amdgcn_readfirstlane((int)threadIdx.x >> 6); F.refresh();
    F.G = gridDim.x; { const int bx = blockIdx.x; F.vcu = (F.G % 8 == 0) ? (bx % 8) * (F.G / 8) + bx / 8 : bx; }
    for (int u = F.tid; u < 32; u += NWAVES * 64) ((LAS unsigned*)(F.lds + CTRL_OFF))[u] = 0u;
    __syncthreads();
    XcdBarrier bar; bar.bar = (unsigned*)(F.ctl + CW_BAR); bar.x = 0; bar.st = nullptr;
    if (N_LAUNCHES == 1) bar = xcd_barrier_post((unsigned*)(F.ctl + CW_BAR), F.MISC + 8, (unsigned)F.wave);
    const int lo = args.ph_lo, hi = args.ph_hi;
#ifndef PHASE_MASK
#define PHASE_MASK 0xFFFu
#endif
#define IN(k) (((PHASE_MASK >> (k)) & 1u) && lo <= (k) && (k) < hi)
#define SEAM(k) do { if (IN(k) && IN((k) + 1)) xcd_barrier(bar); if ((PROBE_A >= 0 || PROBE_B >= 0) && blockIdx.x == 0 && F.tid == 0) __hip_atomic_store(F.ctl + CW_TS + (k) + 1, (unsigned)rt(), RLX_AGENT); } while (0)

#ifndef DUP_MASK
#define DUP_MASK 0u
#endif
#define DUP(k) ((DUP_MASK >> (k)) & 1u)
    if ((PROBE_A >= 0 || PROBE_B >= 0) && blockIdx.x == 0 && F.tid == 0) __hip_atomic_store(F.ctl + CW_TS, (unsigned)rt(), RLX_AGENT);
    if (IN(0)) { F.refresh(); for (int st = blockIdx.x; st < 256; st += F.G) {
            const bool isin = st < 192; const int dr = 16 * (isin ? st : st - 192), sc = dr < 2048 ? dr : (dr < 2816 ? dr + 8 : dr - 2816 + 2048);
            quant_strip<16>(F, isin ? F.w_in + sc : F.w_out + dr, isin ? IN_COLS : D, (isin ? F.Win8() : F.Wout8()) + (size_t)dr * 1024, (isin ? F.inscale() : F.outscale()) + dr); }
        __syncthreads(); p0_prologue(F); if (DUP(0)) { xcd_barrier(bar); p0_prologue(F); } SEAM(0); }
    if (IN(1)) { F.refresh(); p1_hrows(F); if (DUP(1)) { xcd_barrier(bar); p1_hrows(F); } SEAM(1); }
    if (IN(2)) { F.refresh(); p2_proj(F); if (DUP(2)) { xcd_barrier(bar); p2_proj(F); } SEAM(2); }
    if (IN(3)) { F.refresh(); p34_mix(F, bar); if (IN(3) && IN(5)) xcd_barrier(bar); if ((PROBE_A >= 0 || PROBE_B >= 0) && blockIdx.x == 0 && F.tid == 0) { __hip_atomic_store(F.ctl + CW_TS + 4, (unsigned)rt(), RLX_AGENT); __hip_atomic_store(F.ctl + CW_TS + 5, (unsigned)rt(), RLX_AGENT); } }
    const bool fuse56 = FUSE56 && IN(5) && IN(6) && F.G == 256;
    if (IN(5) && !fuse56) { F.refresh(); p5_dnnorm(F); SEAM(5); }
    if (IN(6)) { F.refresh(); p6_outproj(F, fuse56); SEAM(6); }
    if (IN(7)) { F.refresh(); p7_router(F); if (IN(7) && IN(9)) xcd_barrier(bar); if ((PROBE_A >= 0 || PROBE_B >= 0) && blockIdx.x == 0 && F.tid == 0) { __hip_atomic_store(F.ctl + CW_TS + 8, (unsigned)rt(), RLX_AGENT); __hip_atomic_store(F.ctl + CW_TS + 9, (unsigned)rt(), RLX_AGENT); } }
    if (IN(9)) { F.refresh(); p9_up(F); if (DUP(9)) { xcd_barrier(bar); p9_up(F); } SEAM(9); }
    if (IN(10)) { F.refresh(); p10_down(F, IN(9)); SEAM(10); }
    if (IN(11)) { F.refresh(); p11_combine(F); }
#undef IN
#undef SEAM
}

extern "C" void kernel_launch(void* const* d_in, const int* in_sizes, int n_in, void* d_out, int out_size, void* d_ws, size_t ws_size, hipStream_t stream) {
    static int grid = 0;
    if (grid == 0) {
        if (n_in != 21 || out_size != T * D || ws_size < WS_END) { fprintf(stderr, "kernel_launch: unexpected shapes (n_in %d out %d ws %zu)\n", n_in, out_size, ws_size); grid = -1; return; }
        int dev = 0, cus = 0;
        if (hipGetDevice(&dev) != hipSuccess || hipDeviceGetAttribute(&cus, hipDeviceAttributeMultiprocessorCount, dev) != hipSuccess) { grid = -1; return; }
        if (hipFuncSetAttribute((const void*)fwd_kernel, hipFuncAttributeMaxDynamicSharedMemorySize, LDS_BYTES) != hipSuccess) { fprintf(stderr, "kernel_launch: hipFuncSetAttribute failed\n"); grid = -1; return; }
        int per_cu = 0;
        if (hipOccupancyMaxActiveBlocksPerMultiprocessor(&per_cu, (const void*)fwd_kernel, NWAVES * 64, LDS_BYTES) != hipSuccess || per_cu < 1) fprintf(stderr, "kernel_launch: occupancy query reports %d\n", per_cu);
        (void)hipGetLastError();
        grid = cus;
    }
    if (grid < 0) return;
    if (hipMemsetAsync((char*)d_ws + WS_CTL, 0, CTL_ZERO_BYTES, stream) != hipSuccess) { fprintf(stderr, "kernel_launch: memset failed\n"); return; }
    Args a{};
    for (int i = 0; i < 21; ++i) a.in[i] = (const float*)d_in[i];
    a.out = (float*)d_out; a.ws = (unsigned char*)d_ws;
    for (int li = 0; li < N_LAUNCHES; ++li) {
        a.ph_lo = (N_LAUNCHES == 1) ? 0 : li; a.ph_hi = (N_LAUNCHES == 1) ? NPH : li + 1; a.li = li;
        hipLaunchKernelGGL(fwd_kernel, dim3(grid), dim3(NWAVES * 64), LDS_BYTES, stream, a);
        const hipError_t le = hipPeekAtLastError();
        if (le != hipSuccess) { fprintf(stderr, "kernel_launch: launch %d failed: %s\n", li, hipGetErrorName(le)); break; }
    }
}
```
